# Optimizing an MI355X kernel written in HIP

```python
import jax, jax.numpy as jnp
from jax import lax
import numpy as np

D_MODEL = 2048
BATCH = 4
SEQ = 4096
DEPTH = 2

SWA_Q_HEADS = 16
SWA_KV_HEADS = 2
SWA_HEAD_DIM = 64
SWA_WINDOW = 128
SWA_BLOCK = 128
MLA_HEADS = 16
MLA_Q_RANK = 512
MLA_KV_RANK = 512
MLA_NOPE_DIM = 128
MLA_ROPE_DIM = 64
MLA_V_DIM = 128
MLA_BLOCK = 128
ROPE_THETA = 10000.0
SGU_GROUPS = 8
SGU_GROUP_DIM = 128
SGU_CHUNK = 128
SGU_WIDTH = SGU_GROUPS * SGU_GROUP_DIM
D_FF = 5632
CONV_WIDTH = 3
N_BRANCHES = 3
EPS = 1e-5
MASK_VALUE = -1e30
DN_ALPHA = (2 * DEPTH) ** 0.25
DN_BETA = (8 * DEPTH) ** -0.25

A_Q = SWA_Q_HEADS * SWA_HEAD_DIM
A_KV = SWA_KV_HEADS * SWA_HEAD_DIM
B_OUT = MLA_HEADS * MLA_V_DIM
N_IN = A_Q + 2 * A_KV + MLA_Q_RANK + MLA_KV_RANK + MLA_ROPE_DIM + 2 * SGU_WIDTH + N_BRANCHES * D_MODEL

kernel_name = "hybrid_swa_mla_sgu_deepnorm"


def _layer_norm(x, g, b):
    xf = x.astype(jnp.float32)
    mu = xf.mean(-1, keepdims=True)
    var = jnp.mean(jnp.square(xf - mu), -1, keepdims=True)
    y = (xf - mu) * lax.rsqrt(var + EPS) * g.astype(jnp.float32) + b.astype(jnp.float32)
    return y.astype(x.dtype)


def _rms_norm(x, g):
    xf = x.astype(jnp.float32)
    y = xf * lax.rsqrt(jnp.mean(jnp.square(xf), -1, keepdims=True) + EPS) * g.astype(jnp.float32)
    return y.astype(x.dtype)


def _rope(x, cos, sin):
    x1, x2 = jnp.split(x, 2, axis=-1)
    return jnp.concatenate([x1 * cos - x2 * sin, x2 * cos + x1 * sin], axis=-1)


def _sliding_window_gqa(q, k, v, sinks):
    B, S = q.shape[:2]
    nb = S // SWA_BLOCK
    G = SWA_Q_HEADS // SWA_KV_HEADS
    qb = q.reshape(B, nb, SWA_BLOCK, SWA_KV_HEADS, G, SWA_HEAD_DIM)
    kb = k.reshape(B, nb, SWA_BLOCK, SWA_KV_HEADS, SWA_HEAD_DIM)
    vb = v.reshape(B, nb, SWA_BLOCK, SWA_KV_HEADS, SWA_HEAD_DIM)

    def with_prev(t):
        prev = jnp.pad(t[:, :-1], ((0, 0), (1, 0), (0, 0), (0, 0), (0, 0)))
        return jnp.concatenate([prev, t], axis=2)

    kw, vw = with_prev(kb), with_prev(vb)
    scores = jnp.einsum('bnqhgd,bnkhd->bnhgqk', qb, kw,
                        preferred_element_type=jnp.float32) * (SWA_HEAD_DIM ** -0.5)
    q_off = jnp.arange(SWA_BLOCK)[:, None] + SWA_BLOCK
    k_off = jnp.arange(2 * SWA_BLOCK)[None, :]
    rel = q_off - k_off
    band = (rel >= 0) & (rel < SWA_WINDOW)
    not_first = (jnp.arange(nb) > 0)[:, None, None]
    valid = band[None] & (not_first | (k_off >= SWA_BLOCK)[None])
    scores = jnp.where(valid[None, :, None, None], scores, MASK_VALUE)
    sink = sinks.astype(jnp.float32).reshape(SWA_KV_HEADS, G)[None, None, :, :, None, None]
    m = jnp.maximum(scores.max(-1, keepdims=True), sink)
    p = jnp.exp(scores - m)
    p = (p / (p.sum(-1, keepdims=True) + jnp.exp(sink - m))).astype(v.dtype)
    out = jnp.einsum('bnhgqk,bnkhd->bnqhgd', p, vw)
    return out.reshape(B, S, A_Q)


def _mla(c_q, c_kv, k_rope, cos, sin, q_norm_g, kv_norm_g, w_uq, w_ukv):
    B, S = c_q.shape[:2]
    q = (_rms_norm(c_q, q_norm_g) @ w_uq).reshape(B, S, MLA_HEADS, MLA_NOPE_DIM + MLA_ROPE_DIM)
    q_nope = q[..., :MLA_NOPE_DIM]
    q_rope = _rope(q[..., MLA_NOPE_DIM:], cos[:, :, None], sin[:, :, None])
    kv = (_rms_norm(c_kv, kv_norm_g) @ w_ukv).reshape(B, S, MLA_HEADS, MLA_NOPE_DIM + MLA_V_DIM)
    k_nope, v = kv[..., :MLA_NOPE_DIM], kv[..., MLA_NOPE_DIM:]
    k_r = _rope(k_rope, cos, sin)
    nb = S // MLA_BLOCK
    scale = (MLA_NOPE_DIM + MLA_ROPE_DIM) ** -0.5
    qn_b = q_nope.reshape(B, nb, MLA_BLOCK, MLA_HEADS, MLA_NOPE_DIM).transpose(1, 0, 2, 3, 4)
    qr_b = q_rope.reshape(B, nb, MLA_BLOCK, MLA_HEADS, MLA_ROPE_DIM).transpose(1, 0, 2, 3, 4)
    key_idx = jnp.arange(S)

    def block(args):
        qn, qr, i = args
        s = (jnp.einsum('bqhd,bkhd->bhqk', qn, k_nope, preferred_element_type=jnp.float32)
             + jnp.einsum('bqhr,bkr->bhqk', qr, k_r, preferred_element_type=jnp.float32)) * scale
        q_idx = i * MLA_BLOCK + jnp.arange(MLA_BLOCK)
        s = jnp.where((key_idx[None, :] <= q_idx[:, None])[None, None], s, MASK_VALUE)
        p = jax.nn.softmax(s, axis=-1).astype(v.dtype)
        return jnp.einsum('bhqk,bkhd->bqhd', p, v)

    out = lax.map(block, (qn_b, qr_b, jnp.arange(nb)))
    return out.transpose(1, 0, 2, 3, 4).reshape(B, S, B_OUT)


def _chunked_sgu(u, v, ln_g, ln_b, w_s, b_s):
    B, S = u.shape[:2]
    nc = S // SGU_CHUNK
    vn = _layer_norm(v, ln_g, ln_b).reshape(B, nc, SGU_CHUNK, SGU_GROUPS, SGU_GROUP_DIM)
    causal = jnp.tril(jnp.ones((SGU_CHUNK, SGU_CHUNK), dtype=bool))
    w = jnp.where(causal[None], w_s, 0.0)
    mixed = jnp.einsum('gts,bnsgc->bntgc', w, vn) + b_s.T[None, None, :, :, None]
    return u * mixed.reshape(B, S, SGU_WIDTH)


def setup_inputs(seed: int = 0) -> dict:
    key = jax.random.key(seed)
    ks = jax.random.split(key, 26)
    L, D = DEPTH, D_MODEL
    f32 = jnp.float32
    nrm = lambda k, shape, s: jax.random.normal(k, shape, f32) * s
    x = jax.random.normal(ks[0], (BATCH, SEQ, D), f32)
    offset = jax.random.randint(ks[1], (BATCH, 1), 0, 1024, dtype=jnp.int32)
    positions = (offset + jnp.arange(SEQ, dtype=jnp.int32)[None, :]).astype(jnp.int32)
    return {
        "x": x,
        "positions": positions,
        "w_in": nrm(ks[2], (L, D, N_IN), D ** -0.5),
        "b_gate": nrm(ks[3], (L, N_BRANCHES, D), 0.1),
        "sinks": nrm(ks[4], (L, SWA_Q_HEADS), 0.5),
        "q_norm_g": 1.0 + nrm(ks[5], (L, MLA_Q_RANK), 0.02),
        "kv_norm_g": 1.0 + nrm(ks[6], (L, MLA_KV_RANK), 0.02),
        "w_uq": nrm(ks[7], (L, MLA_Q_RANK, MLA_HEADS * (MLA_NOPE_DIM + MLA_ROPE_DIM)), MLA_Q_RANK ** -0.5),
        "w_ukv": nrm(ks[8], (L, MLA_KV_RANK, MLA_HEADS * (MLA_NOPE_DIM + MLA_V_DIM)), MLA_KV_RANK ** -0.5),
        "sgu_ln_g": 1.0 + nrm(ks[9], (L, SGU_WIDTH), 0.02),
        "sgu_ln_b": nrm(ks[10], (L, SGU_WIDTH), 0.02),
        "sgu_w": nrm(ks[11], (L, SGU_GROUPS, SGU_CHUNK, SGU_CHUNK), SGU_CHUNK ** -0.5),
        "sgu_b": 1.0 + nrm(ks[12], (L, SGU_GROUPS, SGU_CHUNK), 0.02),
        "w_proj_a": nrm(ks[13], (L, A_Q, D), A_Q ** -0.5),
        "w_proj_b": nrm(ks[14], (L, B_OUT, D), B_OUT ** -0.5),
        "w_proj_c": nrm(ks[15], (L, SGU_WIDTH, D), SGU_WIDTH ** -0.5),
        "w_o": nrm(ks[16], (L, D, D), DN_BETA * D ** -0.5),
        "ln1_g": 1.0 + nrm(ks[17], (L, D), 0.02),
        "ln1_b": nrm(ks[18], (L, D), 0.02),
        "w_up": nrm(ks[19], (L, D, 2 * D_FF), D ** -0.5),
        "conv_w": nrm(ks[20], (L, CONV_WIDTH, 2 * D_FF), CONV_WIDTH ** -0.5),
        "conv_b": nrm(ks[21], (L, 2 * D_FF), 0.02),
        "w_down": nrm(ks[22], (L, D_FF, D), DN_BETA * D_FF ** -0.5),
        "ln2_g": 1.0 + nrm(ks[23], (L, D), 0.02),
        "ln2_b": nrm(ks[24], (L, D), 0.02),
    }


def reference(x, positions, w_in, b_gate, sinks, q_norm_g, kv_norm_g, w_uq, w_ukv,
              sgu_ln_g, sgu_ln_b, sgu_w, sgu_b, w_proj_a, w_proj_b, w_proj_c, w_o,
              ln1_g, ln1_b, w_up, conv_w, conv_b, w_down, ln2_g, ln2_b):
    B, S, D = x.shape
    inv_freq = ROPE_THETA ** (-jnp.arange(0, MLA_ROPE_DIM, 2, dtype=jnp.float32) / MLA_ROPE_DIM)
    ang = positions.astype(jnp.float32)[..., None] * inv_freq
    cos, sin = jnp.cos(ang).astype(x.dtype), jnp.sin(ang).astype(x.dtype)
    split_at = [A_Q, A_Q + A_KV, A_Q + 2 * A_KV]
    split_at += [split_at[-1] + MLA_Q_RANK]
    split_at += [split_at[-1] + MLA_KV_RANK]
    split_at += [split_at[-1] + MLA_ROPE_DIM]
    split_at += [split_at[-1] + SGU_WIDTH]
    split_at += [split_at[-1] + SGU_WIDTH]

    for l in range(DEPTH):
        h = x @ w_in[l]
        qa, ka, va, c_q, c_kv, k_rope, hu, hv, g_logit = jnp.split(h, split_at, axis=-1)
        y_a = _sliding_window_gqa(qa, ka, va, sinks[l])
        y_b = _mla(c_q, c_kv, k_rope, cos, sin, q_norm_g[l], kv_norm_g[l], w_uq[l], w_ukv[l])
        y_c = _chunked_sgu(jax.nn.gelu(hu, approximate=False), jax.nn.gelu(hv, approximate=False),
                           sgu_ln_g[l], sgu_ln_b[l], sgu_w[l], sgu_b[l])
        gates = jax.nn.sigmoid((g_logit.reshape(B, S, N_BRANCHES, D) + b_gate[l]).astype(jnp.float32)).astype(x.dtype)
        merged = (gates[:, :, 0] * (y_a @ w_proj_a[l])
                  + gates[:, :, 1] * (y_b @ w_proj_b[l])
                  + gates[:, :, 2] * (y_c @ w_proj_c[l]))
        x = _layer_norm(DN_ALPHA * x + merged @ w_o[l], ln1_g[l], ln1_b[l])

        up = x @ w_up[l]
        up_pad = jnp.pad(up, ((0, 0), (CONV_WIDTH - 1, 0), (0, 0)))
        conv = conv_b[l] + sum(up_pad[:, j:j + S] * conv_w[l, j] for j in range(CONV_WIDTH))
        gate, val = jnp.split(conv, 2, axis=-1)
        x = _layer_norm(DN_ALPHA * x + (jax.nn.silu(gate) * val) @ w_down[l], ln2_g[l], ln2_b[l])
    return x
```

```cpp
#include <hip/hip_runtime.h>
#include <hip/hip_cooperative_groups.h>
#include <cstdio>
namespace cg = cooperative_groups;

#define LAS __attribute__((address_space(3)))
typedef unsigned short bf16_t;
typedef short bf16x8 __attribute__((ext_vector_type(8)));
typedef short v4i16_t __attribute__((ext_vector_type(4)));
typedef float f32x4 __attribute__((ext_vector_type(4)));
typedef float f32x2 __attribute__((ext_vector_type(2)));
typedef float f32x16 __attribute__((ext_vector_type(16)));
typedef unsigned u32x4 __attribute__((ext_vector_type(4)));
typedef unsigned u32x2 __attribute__((ext_vector_type(2)));

constexpr int NTOK = 16384, SEQ = 4096, DM = 2048;
constexpr int LDH = 4416, NHP = 4608;
constexpr int C_QA = 0, C_KA = 1024, C_VA = 1152, C_KR = 1280, C_HU = 1344, C_CQ = 2368, C_CKV = 2880, C_HV = 3392;
constexpr int NG = 6144, NQ = 3072, NKV = 4096, NUP = 11264, DFF = 5632, NIN = 10560;
constexpr float LOG2E = 1.4426950408889634f;
constexpr float ALPHA = 1.4142135623730951f;
constexpr float EPS = 1e-5f;
constexpr float SWA_QSCALE = 0.125f * LOG2E;
constexpr float MLA_QSCALE = 0.07216878364870322f * LOG2E;

__device__ const float INV_FREQ[32] = {1.000000000e+00f, 7.498942018e-01f, 5.623413324e-01f, 4.216965139e-01f, 3.162277639e-01f, 2.371373773e-01f, 1.778279394e-01f, 1.333521456e-01f, 1.000000015e-01f, 7.498942316e-02f, 5.623413250e-02f, 4.216964915e-02f, 3.162277490e-02f, 2.371373773e-02f, 1.778279431e-02f, 1.333521400e-02f, 9.999999776e-03f, 7.498942316e-03f, 5.623413250e-03f, 4.216964822e-03f, 3.162277630e-03f, 2.371373819e-03f, 1.778279431e-03f, 1.333521446e-03f, 1.000000047e-03f, 7.498941850e-04f, 5.623413017e-04f, 4.216965172e-04f, 3.162277571e-04f, 2.371373703e-04f, 1.778279402e-04f, 1.333521504e-04f};

constexpr size_t SZ_W = 76546048;
constexpr size_t O_WMAIN = 0, O_WG = 18874368, O_WUQ = O_WG + 25165824, O_WUKV = O_WUQ + 3145728, O_PA = O_WUKV + 4194304, O_PB = O_PA + 4194304, O_PC = O_PB + 8388608, O_WO = O_PC + 4194304;
constexpr size_t O_WUP = 0, O_WDN = 46137344;
constexpr size_t O_XB = SZ_W;
constexpr size_t O_XA = O_XB + 67108864;
constexpr size_t O_BIG = O_XA + 134217728;
constexpr size_t O_H = O_BIG, O_Q = O_H + 144703488, O_KV = O_Q + 100663296;
constexpr size_t O_ACT = O_BIG, O_SIDE = O_BIG + 184549376;
constexpr size_t O_CS = O_BIG + 379584512;
constexpr size_t O_ST = O_CS + 4194304;
constexpr size_t O_BAR = O_ST + 262144;
constexpr size_t WS_NEED = O_BAR + 16384;

struct Params {
  const float* x; const int* pos; const float* w_in; const float* b_gate; const float* sinks; const float* q_norm_g; const float* kv_norm_g;
  const float* w_uq; const float* w_ukv; const float* sgu_ln_g; const float* sgu_ln_b; const float* sgu_w; const float* sgu_b;
  const float* w_proj_a; const float* w_proj_b; const float* w_proj_c; const float* w_o; const float* ln1_g; const float* ln1_b;
  const float* w_up; const float* conv_w; const float* conv_b; const float* w_down; const float* ln2_g; const float* ln2_b;
  float* out; unsigned char* ws;
};

typedef const Params __attribute__((address_space(4)))* KP;
__device__ __forceinline__ int olane() { unsigned m = ~0u; asm volatile("" : "+s"(m)); return (int)__builtin_amdgcn_mbcnt_hi(m, __builtin_amdgcn_mbcnt_lo(m, 0u)); }
__device__ __forceinline__ int otid(int wv0) { int t = (wv0 << 6) | olane(); asm volatile("" : "+v"(t)); return t; }
__device__ __forceinline__ int obid() { int b = blockIdx.x; asm volatile("" : "+s"(b)); return b; }
__device__ __forceinline__ int ogrid() { int g = gridDim.x; asm volatile("" : "+s"(g)); return g; }
__device__ __forceinline__ unsigned pk2(float lo, float hi) {
  typedef __bf16 b2 __attribute__((ext_vector_type(2)));
  b2 r = __builtin_convertvector((f32x2){lo, hi}, b2);
  return __builtin_bit_cast(unsigned, r);
}
__device__ __forceinline__ float bf_lo(unsigned u) { return __uint_as_float(u << 16); }
__device__ __forceinline__ float bf_hi(unsigned u) { return __uint_as_float(u & 0xffff0000u); }
__device__ __forceinline__ float bf1(bf16_t u) { return __uint_as_float(((unsigned)u) << 16); }
__device__ __forceinline__ float fexp2(float x) { return __builtin_amdgcn_exp2f(x); }
__device__ __forceinline__ float frcp(float x) { return __builtin_amdgcn_rcpf(x); }
__device__ __forceinline__ float wave_sum(float v) {
#pragma unroll
  for (int o = 32; o > 0; o >>= 1) v += __shfl_xor(v, o);
  return v;
}
__device__ __forceinline__ float gelu1(float v) {
  const float av = __builtin_fabsf(v), d = av * 0.2316418882f + 1.0f;
  const float t = frcp(d);
  float q = t * 0.5307027145f + (-0.7265760135f); q = q * t + 0.7107068705f; q = q * t + (-0.142248368f); q = q * t + 0.127414796f; q = q * t;
  const float s = (v * v) * (-0.72134752044f);
  const float e = fexp2(s);
  const float m = v * (q * e), r = v - m;
  return v < 0.f ? m : r;
}
__device__ __forceinline__ f32x16 mfma32(bf16x8 a, bf16x8 b, f32x16 c) { return __builtin_amdgcn_mfma_f32_32x32x16_bf16(a, b, c, 0, 0, 0); }
__device__ __forceinline__ v4i16_t vtr(const LAS unsigned char* p) { return __builtin_amdgcn_ds_read_tr16_b64_v4i16((LAS v4i16_t*)p); }

namespace pg8 {
constexpr int BM = 256, BK = 64, HALF = 128, HTB = HALF * BK * 2, STAGE_BYTES = 8 * HTB, NXCD = 8, WGM = 8;
__device__ __forceinline__ int lds_byte(int r, int c) { const int st = (r >> 4) * 2 + (c >> 5), rr = r & 15, cc = c & 31, ob = rr * 64 + cc * 2; return st * 1024 + (ob ^ (((ob >> 9) & 1) << 5)); }
__device__ __forceinline__ void stage_rc(int b, int& R, int& C) { const int st = b / 1024, sb = b % 1024, swz = sb ^ (((sb >> 9) & 1) << 5); R = (st >> 1) * 16 + swz / 64; C = (st & 1) * 32 + (swz % 64) / 2; }
__device__ __forceinline__ int perm32(int rho) { const int n = rho >> 4, i = rho & 15; return 8 * (i >> 2) + 4 * n + (i & 3); }
struct Unit { int pm, pn; };
struct Gemm { const bf16_t* A; const bf16_t* Bt; int M, N, K, lda; };
struct StaticOrder {
  int nM, nN, nwg, G, c;
  __device__ void init(int M, int N, int G_, int c_) { nM = M / BM; nN = N / BM; nwg = nM * nN; G = G_; c = c_; }
  __device__ bool next(int i, Unit& u) const {
    const long L = (long)i * G + c; if (L >= nwg) return false;
    int wgid = (int)L; { const int q = nwg / NXCD, r = nwg % NXCD, xcd = wgid % NXCD, off = wgid / NXCD; wgid = (xcd < r ? xcd * (q + 1) : r * (q + 1) + (xcd - r) * q) + off; }
    const int nig = WGM * nN, gid = wgid / nig, fm = gid * WGM, gsz = (nM - fm) < WGM ? (nM - fm) : WGM;
    u.pm = fm + ((wgid % nig) % gsz); u.pn = (wgid % nig) / gsz; return true;
  }
};

template <class Epi>
__device__ __forceinline__ void gemm_phase(LAS unsigned char* lds, const Gemm g, const StaticOrder& S, const Epi& E, int wv0) {
  const int tid = otid(wv0), wid = __builtin_amdgcn_readfirstlane(tid >> 6), lane = tid & 63, wr = wid >> 2, wc = wid & 3, fr = lane & 15, fq = lane >> 4;
  const int K = g.K, nt = K / BK, lda = g.lda;
  unsigned voffA[2], voffB[2];
#pragma unroll
  for (int i = 0; i < 2; ++i) { int R, C; stage_rc(tid * 16 + i * 8192, R, C); const int Rb = (R & ~31) + perm32(R & 31);
    voffA[i] = (unsigned)(R * lda + C) * 2u; voffB[i] = (unsigned)(Rb * K + C) * 2u; }
  const size_t kstep = (size_t)(BK * 2);
  const size_t hstepA = (size_t)HALF * lda * 2, hstepB = (size_t)HALF * K * 2;
  const size_t tstepA = 2 * hstepA, tstepB = 2 * hstepB;
  const unsigned ldsw = (unsigned)wid * 1024u;
  const int aoff = lds_byte(wr * 64 + fr, fq * 8), boff = lds_byte(wc * 32 + fr, fq * 8);
#define PG8_SA(b, h) (((b) * 2 + (h)) * HTB)
#define PG8_SB(b, h) ((4 + (b) * 2 + (h)) * HTB)
#define PG8_STAGE(bufoff, gbase, voff) do { _Pragma("unroll") for (int _i = 0; _i < 2; ++_i) \
    __builtin_amdgcn_global_load_lds((const unsigned*)((const char*)(gbase) + (voff)[_i]), (LAS unsigned*)(lds + (bufoff) + ldsw + _i * 8192), 16, 0, 0); } while (0)
#define PG8_LDA(dst, b, h) do { _Pragma("unroll") for (int m = 0; m < 4; ++m) _Pragma("unroll") for (int k = 0; k < 2; ++k) dst[m][k] = *(const LAS bf16x8*)(lds + PG8_SA(b, h) + aoff + m * 2048 + k * 1024); } while (0)
#define PG8_LDB(dst, b, h) do { _Pragma("unroll") for (int n = 0; n < 2; ++n) _Pragma("unroll") for (int k = 0; k < 2; ++k) dst[n][k] = *(const LAS bf16x8*)(lds + PG8_SB(b, h) + boff + n * 2048 + k * 1024); } while (0)
#define PG8_MMA(ai, bj, At, Bt) do { __builtin_amdgcn_s_setprio(1); _Pragma("unroll") for (int m = 0; m < 4; ++m) _Pragma("unroll") for (int n = 0; n < 2; ++n) _Pragma("unroll") for (int k = 0; k < 2; ++k) \
    acc[ai][bj][m][n] = __builtin_amdgcn_mfma_f32_16x16x32_bf16(Bt[n][k], At[m][k], acc[ai][bj][m][n], 0, 0, 0); __builtin_amdgcn_s_setprio(0); } while (0)
#define PG8_WAIT_V(n) asm volatile("s_waitcnt vmcnt(" #n ")" ::: "memory")
#define PG8_WAIT_L(n) asm volatile("s_waitcnt lgkmcnt(" #n ")" ::: "memory")
#define PG8_BAR __builtin_amdgcn_s_barrier()
#define PG8_SCHED __builtin_amdgcn_sched_barrier(0)
  Unit cur, nxt; int ui = 0;
  if (!S.next(0, cur)) return;
  f32x4 acc[2][2][4][2];
#pragma unroll
  for (int a = 0; a < 2; ++a)
#pragma unroll
    for (int b = 0; b < 2; ++b)
#pragma unroll
      for (int m = 0; m < 4; ++m)
#pragma unroll
        for (int n = 0; n < 2; ++n) acc[a][b][m][n] = (f32x4){0.f, 0.f, 0.f, 0.f};
  bf16x8 At[4][2], B0[2][2], B1[2][2];
  const char* cA = (const char*)g.A + (size_t)cur.pm * tstepA; const char* cB = (const char*)g.Bt + (size_t)cur.pn * tstepB;
  PG8_STAGE(PG8_SB(0, 0), cB, voffB); PG8_STAGE(PG8_SA(0, 0), cA, voffA); PG8_STAGE(PG8_SB(0, 1), cB + hstepB, voffB); PG8_STAGE(PG8_SA(0, 1), cA + hstepA, voffA);
  if (wr == 1) PG8_BAR;
  PG8_WAIT_V(4); PG8_BAR;
  PG8_STAGE(PG8_SB(1, 0), cB + kstep, voffB); PG8_STAGE(PG8_SA(1, 0), cA + kstep, voffA); PG8_STAGE(PG8_SB(1, 1), cB + hstepB + kstep, voffB);
  PG8_WAIT_V(6); PG8_BAR;
  for (;;) {
    const bool has_next = S.next(ui + 1, nxt);
    const char* nA = has_next ? (const char*)g.A + (size_t)nxt.pm * tstepA : cA; const char* nB = has_next ? (const char*)g.Bt + (size_t)nxt.pn * tstepB : cB;
    for (int t = 0; t < nt; t += 2) {
      const bool last = (t == nt - 2);
      const char* a1 = cA + (size_t)(t + 1) * kstep;
      const char* a2 = last ? nA : cA + (size_t)(t + 2) * kstep; const char* b2 = last ? nB : cB + (size_t)(t + 2) * kstep;
      const char* a3 = a2 + kstep; const char* b3 = b2 + kstep;
      PG8_LDB(B0, 0, 0); PG8_SCHED; PG8_LDA(At, 0, 0); PG8_STAGE(PG8_SA(1, 1), a1 + hstepA, voffA);
      PG8_WAIT_L(8); PG8_BAR; PG8_WAIT_L(0); PG8_MMA(0, 0, At, B0); PG8_BAR; PG8_SCHED;
      PG8_LDB(B1, 0, 1); PG8_STAGE(PG8_SB(0, 0), b2, voffB);
      PG8_BAR; PG8_WAIT_L(0); PG8_MMA(0, 1, At, B1); PG8_BAR;
      PG8_LDA(At, 0, 1); PG8_STAGE(PG8_SA(0, 0), a2, voffA);
      PG8_BAR; PG8_WAIT_L(0); PG8_MMA(1, 0, At, B0); PG8_BAR; PG8_SCHED;
      PG8_STAGE(PG8_SB(0, 1), b2 + hstepB, voffB);
      PG8_WAIT_V(6); PG8_BAR; PG8_MMA(1, 1, At, B1); PG8_BAR;
      PG8_LDB(B0, 1, 0); PG8_SCHED; PG8_LDA(At, 1, 0); PG8_STAGE(PG8_SA(0, 1), a2 + hstepA, voffA);
      PG8_WAIT_L(8); PG8_BAR; PG8_WAIT_L(0); PG8_MMA(0, 0, At, B0); PG8_BAR; PG8_SCHED;
      PG8_LDB(B1, 1, 1); PG8_STAGE(PG8_SB(1, 0), b3, voffB);
      PG8_BAR; PG8_WAIT_L(0); PG8_MMA(0, 1, At, B1); PG8_BAR;
      PG8_LDA(At, 1, 1); PG8_STAGE(PG8_SA(1, 0), a3, voffA);
      PG8_BAR; PG8_WAIT_L(0); PG8_MMA(1, 0, At, B0); PG8_BAR; PG8_SCHED;
      PG8_STAGE(PG8_SB(1, 1), b3 + hstepB, voffB);
      PG8_WAIT_V(6); PG8_BAR; PG8_MMA(1, 1, At, B1); PG8_BAR;
    }
    E(acc, cur, wr, wc, fr, fq);
    if (!has_next) break;
#pragma unroll
    for (int a = 0; a < 2; ++a)
#pragma unroll
      for (int b = 0; b < 2; ++b)
#pragma unroll
        for (int m = 0; m < 4; ++m)
#pragma unroll
          for (int n = 0; n < 2; ++n) acc[a][b][m][n] = (f32x4){0.f, 0.f, 0.f, 0.f};
    cur = nxt; cA = nA; cB = nB; ++ui;
  }
  PG8_WAIT_V(0);
  if (wr == 0) PG8_BAR;
  PG8_BAR;
#undef PG8_SA
#undef PG8_SB
#undef PG8_STAGE
#undef PG8_LDA
#undef PG8_LDB
#undef PG8_MMA
#undef PG8_WAIT_V
#undef PG8_WAIT_L
#undef PG8_BAR
#undef PG8_SCHED
}
}

struct EpiP { void* out; int ldo; const float* f0; const bf16_t* b0; float* facc; int aux; const float* f1; LAS unsigned char* ex; };
enum { E_MAIN = 0, E_GATE = 1, E_UQ = 2, E_UKV = 3, E_PROJ = 4, E_RES = 5, E_UP = 6, E_UPC = 7 };

__device__ __forceinline__ void rope8(float (&v)[8], const f32x2* cs) {
#pragma unroll
  for (int i = 0; i < 4; ++i) { const f32x2 c = cs[i]; const float x1 = v[2 * i], x2 = v[2 * i + 1]; v[2 * i] = x1 * c.x - x2 * c.y; v[2 * i + 1] = x2 * c.x + x1 * c.y; }
}
__device__ __forceinline__ void store8bf(bf16_t* dst, const float (&v)[8]) {
  u32x4 w; w.x = pk2(v[0], v[1]); w.y = pk2(v[2], v[3]); w.z = pk2(v[4], v[5]); w.w = pk2(v[6], v[7]);
  *(u32x4*)dst = w;
}


__device__ __forceinline__ float dpp_shr1(float x) { return __int_as_float(__builtin_amdgcn_update_dpp(0, __float_as_int(x), 0x111, 0xF, 0xF, true)); }
__device__ __forceinline__ float dpp_shr2(float x) { return __int_as_float(__builtin_amdgcn_update_dpp(0, __float_as_int(x), 0x112, 0xF, 0xF, true)); }
__device__ __forceinline__ float dpp_prev1(float prev, float cur) {
  const int t = __builtin_amdgcn_update_dpp(0, __float_as_int(prev), 0x121, 0xF, 0xF, false);
  return __int_as_float(__builtin_amdgcn_update_dpp(t, __float_as_int(cur), 0x111, 0xF, 0xF, false)); }
__device__ __forceinline__ float dpp_prev2(float prev, float cur) {
  const int t = __builtin_amdgcn_update_dpp(0, __float_as_int(prev), 0x122, 0xF, 0xF, false);
  return __int_as_float(__builtin_amdgcn_update_dpp(t, __float_as_int(cur), 0x112, 0xF, 0xF, false)); }
__device__ __forceinline__ float silu_mul(float g, float v) { return g * frcp(1.0f + fexp2(-g * LOG2E)) * v; }
__device__ __forceinline__ void epi_upc(const EpiP& e, const f32x4 (&acc)[2][2][4][2], const pg8::Unit& u, int wr, int wc, int fr, int fq) {
  LAS unsigned char* ex = e.ex;
  bf16_t* side = (bf16_t*)e.b0;
  const int lc0 = 32 * wc + 8 * fq;
#pragma unroll
  for (int ai = 0; ai < 2; ++ai)
#pragma unroll
    for (int m = 0; m < 4; ++m) {
      const int g = ai * 8 + wr * 4 + m;
#pragma unroll
      for (int bj = 0; bj < 2; ++bj) {
        u32x4 w; w.x = pk2(acc[ai][bj][m][0][0], acc[ai][bj][m][0][1]); w.y = pk2(acc[ai][bj][m][0][2], acc[ai][bj][m][0][3]);
        w.z = pk2(acc[ai][bj][m][1][0], acc[ai][bj][m][1][1]); w.w = pk2(acc[ai][bj][m][1][2], acc[ai][bj][m][1][3]);
        if (m == 3 && fr >= 14) *(LAS u32x4*)(ex + ((g * 2 + (fr - 14)) * 256 + bj * 128 + lc0) * 2) = w;
        const int ucol = bj * DFF + 128 * u.pn + lc0;
        if (g == 15 && fr >= 14) *(u32x4*)(side + ((size_t)u.pm * 4 + 2 + (fr - 14)) * NUP + ucol) = w;
        if (g == 0 && fr < 2) *(u32x4*)(side + ((size_t)u.pm * 4 + fr) * NUP + ucol) = w;
      }
    }
  asm volatile("s_waitcnt lgkmcnt(0)" ::: "memory");
  __builtin_amdgcn_s_barrier();
  __builtin_amdgcn_s_barrier();
  asm volatile("" ::: "memory");
  const float* cw = e.f0; const float* cb = e.f1;
  bf16_t* act = (bf16_t*)e.out;
#pragma unroll
  for (int n = 0; n < 2; ++n) {
    const int ch = 128 * u.pn + lc0 + 4 * n;
    const f32x4 wg0 = *(const f32x4*)(cw + ch), wg1 = *(const f32x4*)(cw + NUP + ch), wg2 = *(const f32x4*)(cw + 2 * NUP + ch), bg = *(const f32x4*)(cb + ch);
    const f32x4 wv0 = *(const f32x4*)(cw + DFF + ch), wv1 = *(const f32x4*)(cw + NUP + DFF + ch), wv2 = *(const f32x4*)(cw + 2 * NUP + DFF + ch), bv = *(const f32x4*)(cb + DFF + ch);
#pragma unroll
    for (int ai = 0; ai < 2; ++ai)
#pragma unroll
      for (int m = 0; m < 4; ++m) {
        const int g = ai * 8 + wr * 4 + m, gp = g > 0 ? g - 1 : 0;
        const f32x4 xg = acc[ai][0][m][n], xv = acc[ai][1][m][n];
        float y[4];
        if (m > 0) {
          const f32x4 pg = acc[ai][0][m - 1][n], pv = acc[ai][1][m - 1][n];
#pragma unroll
          for (int k = 0; k < 4; ++k) {
            const float g1 = dpp_prev1(pg[k], xg[k]), g2 = dpp_prev2(pg[k], xg[k]), v1 = dpp_prev1(pv[k], xv[k]), v2 = dpp_prev2(pv[k], xv[k]);
            const float cg = bg[k] + wg0[k] * g2 + wg1[k] * g1 + wg2[k] * xg[k];
            const float cv = bv[k] + wv0[k] * v2 + wv1[k] * v1 + wv2[k] * xv[k];
            y[k] = silu_mul(cg, cv);
          }
        } else {
          const LAS unsigned char* hp = ex + (gp * 2 * 256 + lc0 + 4 * n) * 2;
          const u32x2 hg14 = *(const LAS u32x2*)hp, hg15 = *(const LAS u32x2*)(hp + 512), hv14 = *(const LAS u32x2*)(hp + 256), hv15 = *(const LAS u32x2*)(hp + 512 + 256);
          const float h14g[4] = {bf_lo(hg14.x), bf_hi(hg14.x), bf_lo(hg14.y), bf_hi(hg14.y)}, h15g[4] = {bf_lo(hg15.x), bf_hi(hg15.x), bf_lo(hg15.y), bf_hi(hg15.y)};
          const float h14v[4] = {bf_lo(hv14.x), bf_hi(hv14.x), bf_lo(hv14.y), bf_hi(hv14.y)}, h15v[4] = {bf_lo(hv15.x), bf_hi(hv15.x), bf_lo(hv15.y), bf_hi(hv15.y)};
#pragma unroll
          for (int k = 0; k < 4; ++k) {
            float g1 = dpp_shr1(xg[k]), g2 = dpp_shr2(xg[k]), v1 = dpp_shr1(xv[k]), v2 = dpp_shr2(xv[k]);
            if (fr == 0) { g1 = h15g[k]; g2 = h14g[k]; v1 = h15v[k]; v2 = h14v[k]; }
            if (fr == 1) { g2 = h15g[k]; v2 = h15v[k]; }
            const float cg = bg[k] + wg0[k] * g2 + wg1[k] * g1 + wg2[k] * xg[k];
            const float cv = bv[k] + wv0[k] * v2 + wv1[k] * v1 + wv2[k] * xv[k];
            y[k] = silu_mul(cg, cv);
          }
        }
        const int row = u.pm * 256 + ai * 128 + wr * 64 + m * 16 + fr;
        if (!(g == 0 && fr < 2)) { u32x2 w; w.x = pk2(y[0], y[1]); w.y = pk2(y[2], y[3]); *(u32x2*)(act + (size_t)row * DFF + ch) = w; }
      }
    asm volatile("" ::: "memory");
  }
}
struct EpiPre { f32x4 a0, a1; u32x4 u0, u1; float s; };
__device__ __forceinline__ void rope8v(float (&v)[8], f32x4 c0, f32x4 c1) {
  const float cs[8] = {c0[0], c0[1], c0[2], c0[3], c1[0], c1[1], c1[2], c1[3]};
#pragma unroll
  for (int i = 0; i < 4; ++i) { const float x1 = v[2 * i], x2 = v[2 * i + 1]; v[2 * i] = x1 * cs[2 * i] - x2 * cs[2 * i + 1]; v[2 * i + 1] = x2 * cs[2 * i] + x1 * cs[2 * i + 1]; }
}
template <int MODE> struct Epi {
  EpiP e;
  __device__ __forceinline__ void preload(EpiPre& q, int row, int col) const {
    if (MODE == E_GATE || MODE == E_UKV) return;
    if (MODE == E_MAIN) {
      if (col >= C_KR && col < C_HU) { const float* cs = e.f0 + ((size_t)row * 32 + ((col - C_KR) >> 1)) * 2; q.a0 = *(const f32x4*)cs; q.a1 = *(const f32x4*)(cs + 4); }
    } else if (MODE == E_GATE) {
      q.a0 = *(const f32x4*)(e.f0 + col); q.a1 = *(const f32x4*)(e.f0 + col + 4);
    } else if (MODE == E_UQ) {
      const int c192 = col % 192;
      if (c192 >= 128) { const float* cs = e.facc + ((size_t)row * 32 + ((c192 - 128) >> 1)) * 2; q.a0 = *(const f32x4*)cs; q.a1 = *(const f32x4*)(cs + 4); }
    } else if (MODE == E_UKV) {
      q.s = ((const f32x4*)e.f0)[row].y;
    } else if (MODE == E_PROJ) {
      q.u0 = *(const u32x4*)(e.b0 + (size_t)row * NG + e.aux * DM + col);
      if (e.aux > 0) q.u1 = *(const u32x4*)((const bf16_t*)e.facc + (size_t)row * DM + col);
    } else if (MODE == E_RES) {
      const float* rs = e.f0 + (size_t)row * DM + col; q.a0 = *(const f32x4*)rs; q.a1 = *(const f32x4*)(rs + 4);
    }
  }
  __device__ __forceinline__ void emit(const EpiPre& q0, int row, int col, f32x4 a, f32x4 b, const f32x4 (&hb)[2][2], const float (&hs)[2][4], int ai_, int m_, int bj_) const {
    EpiPre q = q0;
    if (MODE == E_GATE) { q.a0 = hb[bj_][0]; q.a1 = hb[bj_][1]; }
    if (MODE == E_UQ || MODE == E_UKV) q.s = hs[ai_][m_];
    float v[8] = {a[0], a[1], a[2], a[3], b[0], b[1], b[2], b[3]};
    if (MODE == E_MAIN) {
      if (col >= LDH) return;
      if (col < C_KA) {
#pragma unroll
        for (int j = 0; j < 8; ++j) v[j] *= SWA_QSCALE;
      } else if (col >= C_KR && col < C_HU) {
        rope8v(v, q.a0, q.a1);
      } else if ((col >= C_HU && col < C_CQ) || col >= C_HV) {
#pragma unroll
        for (int j = 0; j < 8; ++j) v[j] = gelu1(v[j]);
      }
      store8bf((bf16_t*)e.out + (size_t)row * LDH + col, v);
    } else if (MODE == E_GATE) {
      const float bb[8] = {q.a0[0], q.a0[1], q.a0[2], q.a0[3], q.a1[0], q.a1[1], q.a1[2], q.a1[3]};
#pragma unroll
      for (int j = 0; j < 8; ++j) v[j] = frcp(1.0f + fexp2(-(v[j] + bb[j]) * LOG2E));
      store8bf((bf16_t*)e.out + (size_t)row * NG + col, v);
    } else if (MODE == E_UQ) {
#pragma unroll
      for (int j = 0; j < 8; ++j) v[j] *= q.s;
      if (col % 192 >= 128) rope8v(v, q.a0, q.a1);
      store8bf((bf16_t*)e.out + (size_t)row * NQ + col, v);
    } else if (MODE == E_UKV) {
#pragma unroll
      for (int j = 0; j < 8; ++j) v[j] *= q.s;
      store8bf((bf16_t*)e.out + (size_t)row * NKV + col, v);
    } else if (MODE == E_PROJ) {
      const int br = e.aux; const u32x4 gw = q.u0;
      v[0] *= bf_lo(gw.x); v[1] *= bf_hi(gw.x); v[2] *= bf_lo(gw.y); v[3] *= bf_hi(gw.y);
      v[4] *= bf_lo(gw.z); v[5] *= bf_hi(gw.z); v[6] *= bf_lo(gw.w); v[7] *= bf_hi(gw.w);
      bf16_t* fa = (bf16_t*)e.facc + (size_t)row * DM + col;
      if (br > 0) { const u32x4 pw = q.u1;
        v[0] += bf_lo(pw.x); v[1] += bf_hi(pw.x); v[2] += bf_lo(pw.y); v[3] += bf_hi(pw.y); v[4] += bf_lo(pw.z); v[5] += bf_hi(pw.z); v[6] += bf_lo(pw.w); v[7] += bf_hi(pw.w); }
      if (br == 2) store8bf((bf16_t*)e.out + (size_t)row * DM + col, v);
      else store8bf(fa, v);
    } else if (MODE == E_RES) {
      const f32x4 r0 = q.a0, r1 = q.a1;
      float* o = (float*)e.out + (size_t)row * DM + col;
      *(f32x4*)o = (f32x4){ALPHA * r0[0] + v[0], ALPHA * r0[1] + v[1], ALPHA * r0[2] + v[2], ALPHA * r0[3] + v[3]};
      *(f32x4*)(o + 4) = (f32x4){ALPHA * r1[0] + v[4], ALPHA * r1[1] + v[5], ALPHA * r1[2] + v[6], ALPHA * r1[3] + v[7]};
    } else {
      store8bf((bf16_t*)e.out + (size_t)row * e.ldo + col, v);
    }
  }
  __device__ __forceinline__ void operator()(const f32x4 (&acc)[2][2][4][2], const pg8::Unit& u, int wr, int wc, int fr, int fq) const {
    if (MODE == E_UPC) { epi_upc(e, acc, u, wr, wc, fr, fq); return; }
    const int row0 = u.pm * 256 + wr * 64 + fr, col0 = u.pn * 256 + wc * 32 + 8 * fq;
    f32x4 hb[2][2]; float hs[2][4];
#pragma unroll
    for (int bj = 0; bj < 2; ++bj) { hb[bj][0] = (f32x4){0.f, 0.f, 0.f, 0.f}; hb[bj][1] = hb[bj][0];
      if (MODE == E_GATE) { hb[bj][0] = *(const f32x4*)(e.f0 + col0 + bj * 128); hb[bj][1] = *(const f32x4*)(e.f0 + col0 + bj * 128 + 4); } }
#pragma unroll
    for (int ai = 0; ai < 2; ++ai)
#pragma unroll
      for (int m = 0; m < 4; ++m) { hs[ai][m] = 0.f;
        if (MODE == E_UQ) hs[ai][m] = ((const f32x4*)e.f0)[row0 + ai * 128 + m * 16].x * MLA_QSCALE;
        if (MODE == E_UKV) hs[ai][m] = ((const f32x4*)e.f0)[row0 + ai * 128 + m * 16].y; }
    EpiPre q[2][4];
#pragma unroll
    for (int i = 0; i < 4; ++i) preload(q[0][i], row0 + (i >> 1) * 16, col0 + (i & 1) * 128);
#pragma unroll
    for (int gi = 0; gi < 4; ++gi) {
      const int ai = gi >> 1, mp = gi & 1;
      if (gi + 1 < 4) { const int ai2 = (gi + 1) >> 1, mp2 = (gi + 1) & 1;
#pragma unroll
        for (int i = 0; i < 4; ++i) preload(q[(gi + 1) & 1][i], row0 + ai2 * 128 + (2 * mp2 + (i >> 1)) * 16, col0 + (i & 1) * 128); }
      asm volatile("" ::: "memory");
#pragma unroll
      for (int i = 0; i < 4; ++i) { const int m = 2 * mp + (i >> 1), bj = i & 1; emit(q[gi & 1][i], row0 + ai * 128 + m * 16, col0 + bj * 128, acc[ai][bj][m][0], acc[ai][bj][m][1], hb, hs, ai, m, bj); }
      asm volatile("" ::: "memory");
    }
  }
};

template <int MODE>
__device__ __forceinline__ void run_gemm(LAS unsigned char* lds, const bf16_t* A, int lda, const bf16_t* Bt, int M, int N, int K, const EpiP& ep, int wv0) {
  pg8::Gemm g; g.A = A; g.Bt = Bt; g.M = M; g.N = N; g.K = K; g.lda = lda;
  pg8::StaticOrder S; S.init(M, N, ogrid(), obid());
  Epi<MODE> E; E.e = ep;
  pg8::gemm_phase(lds, g, S, E, wv0);
}

__device__ __forceinline__ int rope_src(int j) { return (j & 1) ? 32 + (j >> 1) : (j >> 1); }
__device__ __forceinline__ int srcmap(int kind, int n) {
  if (kind == 0) return n;
  if (kind == 1) {
    if (n < C_KR) return n;
    if (n < C_HU) return 2304 + rope_src(n - C_KR);
    if (n < C_CQ) return n - C_HU + 2368;
    if (n < C_CKV) return n - C_CQ + 1280;
    if (n < C_HV) return n - C_CKV + 1792;
    if (n < LDH) return n;
    return -1;
  }
  if (kind == 2) return 4416 + n;
  if (kind == 4) { const int pn = n >> 8, lc = n & 255; return lc < 128 ? 128 * pn + lc : DFF + 128 * pn + (lc - 128); }
  { const int hd = n / 192, c = n % 192; if (c < 128) return n; return hd * 192 + 128 + rope_src(c - 128); }
}
__device__ __forceinline__ void cvt_job(LAS unsigned char* lds, const float* src, bf16_t* dst, const float* kscale, int K, int Nsrc, int Ndst, int kind, int wv0, int bid_, int grd_) {
  LAS float* tile = (LAS float*)lds;
  const int tid = otid(wv0), nkt = K / 64, ntile = (Ndst / 64) * nkt;
  if (bid_ < 0) return;
  const int nl = tid & 63, kb = tid >> 6;
  float v[8];
#define CVT_LOAD(t_) do { const int k0_ = ((t_) % nkt) * 64, n0_ = ((t_) / nkt) * 64; const int sn = srcmap(kind, n0_ + nl); \
    _Pragma("unroll") for (int i = 0; i < 8; ++i) { const int kl = kb + 8 * i; v[i] = 0.f; \
      if (sn >= 0) { v[i] = src[(size_t)(k0_ + kl) * Nsrc + sn]; if (kscale) v[i] *= kscale[k0_ + kl]; } } } while (0)
  if (bid_ < ntile) CVT_LOAD(bid_);
  for (int t = bid_; t < ntile; t += grd_) {
    const int k0 = (t % nkt) * 64, n0 = (t / nkt) * 64;
#pragma unroll
    for (int i = 0; i < 8; ++i) tile[(kb + 8 * i) * 65 + nl] = v[i];
    __syncthreads();
    if (t + grd_ < ntile) CVT_LOAD(t + grd_);
    { const int nl2 = tid >> 3, kc = (tid & 7) * 8; float w[8];
#pragma unroll
      for (int j = 0; j < 8; ++j) w[j] = tile[(kc + j) * 65 + nl2];
      store8bf(dst + (size_t)(n0 + nl2) * K + k0 + kc, w); }
    __syncthreads();
  }
#undef CVT_LOAD
}
__device__ __forceinline__ void cvt_mixer_a(KP p, int l, LAS unsigned char* lds, int wv0) {
  unsigned char* W = p->ws; const int f = obid(), st = ogrid();
  cvt_job(lds, p->w_in + (size_t)l * DM * NIN, (bf16_t*)(W + O_WMAIN), nullptr, DM, NIN, NHP, 1, wv0, f, st);
  cvt_job(lds, p->w_in + (size_t)l * DM * NIN, (bf16_t*)(W + O_WG), nullptr, DM, NIN, NG, 2, wv0, f, st);
}
__device__ __forceinline__ void cvt_mixer_b(KP p, int l, LAS unsigned char* lds, int wv0, int f, int st) {
  unsigned char* W = p->ws;
  cvt_job(lds, p->w_uq + (size_t)l * 512 * NQ, (bf16_t*)(W + O_WUQ), p->q_norm_g + l * 512, 512, NQ, NQ, 3, wv0, f, st);
  cvt_job(lds, p->w_ukv + (size_t)l * 512 * NKV, (bf16_t*)(W + O_WUKV), p->kv_norm_g + l * 512, 512, NKV, NKV, 0, wv0, f, st);
  cvt_job(lds, p->w_proj_a + (size_t)l * 1024 * DM, (bf16_t*)(W + O_PA), nullptr, 1024, DM, DM, 0, wv0, f, st);
  cvt_job(lds, p->w_proj_b + (size_t)l * 2048 * DM, (bf16_t*)(W + O_PB), nullptr, 2048, DM, DM, 0, wv0, f, st);
  cvt_job(lds, p->w_proj_c + (size_t)l * 1024 * DM, (bf16_t*)(W + O_PC), nullptr, 1024, DM, DM, 0, wv0, f, st);
  cvt_job(lds, p->w_o + (size_t)l * DM * DM, (bf16_t*)(W + O_WO), nullptr, DM, DM, DM, 0, wv0, f, st);
}
__device__ __forceinline__ void cvt_ffn(KP p, int l, LAS unsigned char* lds, int wv0) {
  unsigned char* W = p->ws; const int f = obid(), st = ogrid();
  cvt_job(lds, p->w_up + (size_t)l * DM * NUP, (bf16_t*)(W + O_WUP), nullptr, DM, NUP, NUP, 4, wv0, f, st);
  cvt_job(lds, p->w_down + (size_t)l * DFF * DM, (bf16_t*)(W + O_WDN), nullptr, DFF, DM, DM, 0, wv0, f, st);
}

__device__ __forceinline__ void prologue(KP p, int wv0) {
  const size_t tid = (size_t)obid() * 512 + otid(wv0), nth = (size_t)ogrid() * 512;
  bf16_t* xb = (bf16_t*)(p->ws + O_XB);
  for (size_t i = tid; i < (size_t)NTOK * DM / 4; i += 4 * nth) {
    f32x4 v[4];
#pragma unroll
    for (int j = 0; j < 4; ++j) if (i + j * nth < (size_t)NTOK * DM / 4) v[j] = ((const f32x4*)p->x)[i + j * nth];
#pragma unroll
    for (int j = 0; j < 4; ++j) if (i + j * nth < (size_t)NTOK * DM / 4) { u32x2 w; w.x = pk2(v[j][0], v[j][1]); w.y = pk2(v[j][2], v[j][3]); ((u32x2*)xb)[i + j * nth] = w; } }
  f32x2* cs = (f32x2*)(p->ws + O_CS);
  for (size_t i = tid; i < (size_t)NTOK * 32; i += nth) {
    const int tok = (int)(i >> 5), f = (int)(i & 31);
    const float ang = (float)p->pos[tok] * INV_FREQ[f];
    double t = (double)ang * 0.15915494309189535; t -= __builtin_rint(t);
    const float tf = (float)t;
    cs[i] = (f32x2){__builtin_amdgcn_cosf(tf), __builtin_amdgcn_sinf(tf)};
  }
}

__device__ __forceinline__ void stats_phase(KP p, int wv0) {
  const bf16_t* h = (const bf16_t*)(p->ws + O_H); f32x4* st = (f32x4*)(p->ws + O_ST);
  const int tid_ = otid(wv0); const int lane = tid_ & 63, wv = obid() * 8 + (tid_ >> 6), nwv = ogrid() * 8;
  for (int row = wv; row < NTOK; row += nwv) {
    const bf16_t* hr = h + (size_t)row * LDH;
    const u32x4 a = *(const u32x4*)(hr + C_CQ + lane * 8), b = *(const u32x4*)(hr + C_CKV + lane * 8);
    const u32x4 v0 = *(const u32x4*)(hr + C_HV + lane * 16), v1 = *(const u32x4*)(hr + C_HV + lane * 16 + 8);
    float sa = 0.f, sb = 0.f, sv = 0.f;
#pragma unroll
    for (int j = 0; j < 4; ++j) { float x0 = bf_lo(a[j]), x1 = bf_hi(a[j]); sa += x0 * x0 + x1 * x1; x0 = bf_lo(b[j]); x1 = bf_hi(b[j]); sb += x0 * x0 + x1 * x1;
      sv += bf_lo(v0[j]) + bf_hi(v0[j]) + bf_lo(v1[j]) + bf_hi(v1[j]); }
    sa = wave_sum(sa); sb = wave_sum(sb); sv = wave_sum(sv);
    const float mu = sv * (1.0f / 1024.0f);
    float sq = 0.f;
#pragma unroll
    for (int j = 0; j < 4; ++j) { float d;
      d = bf_lo(v0[j]) - mu; sq += d * d; d = bf_hi(v0[j]) - mu; sq += d * d; d = bf_lo(v1[j]) - mu; sq += d * d; d = bf_hi(v1[j]) - mu; sq += d * d; }
    sq = wave_sum(sq);
    if (lane == 0) st[row] = (f32x4){__builtin_amdgcn_rsqf(sa * (1.0f / 512.0f) + EPS), __builtin_amdgcn_rsqf(sb * (1.0f / 512.0f) + EPS), mu, __builtin_amdgcn_rsqf(sq * (1.0f / 1024.0f) + EPS)};
  }
}

__device__ __forceinline__ void ln_phase(const float* in, float* outf, bf16_t* outb, const float* g, const float* b, int wv0) {
  const int tid_ = otid(wv0); const int lane = tid_ & 63, wv = obid() * 8 + (tid_ >> 6), nwv = ogrid() * 8;
  f32x4 gg[8], bb[8];
#pragma unroll
  for (int i = 0; i < 8; ++i) { gg[i] = ((const f32x4*)g)[i * 64 + lane]; bb[i] = ((const f32x4*)b)[i * 64 + lane]; }
  f32x4 vn[8];
  if (wv < NTOK) { const f32x4* ir = (const f32x4*)(in + (size_t)wv * DM);
#pragma unroll
    for (int i = 0; i < 8; ++i) vn[i] = ir[i * 64 + lane]; }
  for (int row = wv; row < NTOK; row += nwv) {
    f32x4 v[8]; float s = 0.f;
#pragma unroll
    for (int i = 0; i < 8; ++i) v[i] = vn[i];
    if (row + nwv < NTOK) { const f32x4* ir = (const f32x4*)(in + (size_t)(row + nwv) * DM);
#pragma unroll
      for (int i = 0; i < 8; ++i) vn[i] = ir[i * 64 + lane]; }
#pragma unroll
    for (int i = 0; i < 8; ++i) s += v[i][0] + v[i][1] + v[i][2] + v[i][3];
    s = wave_sum(s); const float mu = s * (1.0f / 2048.0f);
    float sq = 0.f;
#pragma unroll
    for (int i = 0; i < 8; ++i) { v[i] -= mu; sq += v[i][0] * v[i][0] + v[i][1] * v[i][1] + v[i][2] * v[i][2] + v[i][3] * v[i][3]; }
    sq = wave_sum(sq); const float rstd = __builtin_amdgcn_rsqf(sq * (1.0f / 2048.0f) + EPS);
#pragma unroll
    for (int i = 0; i < 8; ++i) {
      const f32x4 y = v[i] * rstd * gg[i] + bb[i];
      ((f32x4*)(outf + (size_t)row * DM))[i * 64 + lane] = y;
      if (outb) { u32x2 w; w.x = pk2(y[0], y[1]); w.y = pk2(y[2], y[3]); ((u32x2*)(outb + (size_t)row * DM))[i * 64 + lane] = w; } }
  }
}

template <int NQK, int NDV, int KSTR, int VSTR>
__device__ __forceinline__ void attn_tile(const bf16x8 (&qf)[NQK], f32x16 (&o)[NDV], float& m, float& l, const LAS unsigned char* Kt, const LAS unsigned char* Vt,
                                          int lane, int qpos, int kpos0, int window, bool domask) {
  const int c = lane & 31, h = lane >> 5;
  f32x16 s0, s1;
#pragma unroll
  for (int r = 0; r < 16; ++r) { s0[r] = 0.f; s1[r] = 0.f; }
  const LAS unsigned char* ka = Kt + c * KSTR + h * 16;
  bf16x8 kc0 = *(const LAS bf16x8*)(ka), kc1 = *(const LAS bf16x8*)(ka + 32 * KSTR);
  __builtin_amdgcn_s_setprio(1);
#pragma unroll
  for (int st = 0; st < NQK; ++st) {
    bf16x8 kn0 = kc0, kn1 = kc1;
    if (st + 1 < NQK) { kn0 = *(const LAS bf16x8*)(ka + (st + 1) * 32); kn1 = *(const LAS bf16x8*)(ka + 32 * KSTR + (st + 1) * 32); }
    s0 = mfma32(kc0, qf[st], s0);
    s1 = mfma32(kc1, qf[st], s1);
    if (st + 1 < NQK) __builtin_amdgcn_sched_group_barrier(0x100, 2, 0);
    __builtin_amdgcn_sched_group_barrier(0x008, 2, 0);
    __builtin_amdgcn_sched_barrier(0);
    kc0 = kn0; kc1 = kn1;
  }
  __builtin_amdgcn_s_setprio(0);
  __builtin_amdgcn_sched_barrier(0);
  if (domask) {
#pragma unroll
    for (int r = 0; r < 16; ++r) { const int kp = kpos0 + (r & 3) + 8 * (r >> 2) + 4 * h;
      const bool v0 = (kp <= qpos) && (kp > qpos - window) && (kp >= 0);
      const bool v1 = (kp + 32 <= qpos) && (kp + 32 > qpos - window) && (kp + 32 >= 0);
      s0[r] = v0 ? s0[r] : -1e30f; s1[r] = v1 ? s1[r] : -1e30f; }
  }
  float mx = fmaxf(s0[0], s1[0]);
#pragma unroll
  for (int r = 1; r < 16; ++r) mx = fmaxf(mx, fmaxf(s0[r], s1[r]));
  mx = fmaxf(mx, __shfl_xor(mx, 32));
  if (__builtin_amdgcn_ballot_w64(mx > m + 8.0f) != 0ull) {
    const float mn = fmaxf(m, mx), alpha = fexp2(m - mn);
    m = mn; l *= alpha;
#pragma unroll
    for (int d = 0; d < NDV; ++d) o[d] *= alpha;
  }
  float ps = 0.f;
#pragma unroll
  for (int r = 0; r < 16; ++r) { s0[r] = fexp2(s0[r] - m); s1[r] = fexp2(s1[r] - m); ps += s0[r] + s1[r]; }
  l += ps;
  bf16x8 pf[4];
#pragma unroll
  for (int s = 0; s < 2; ++s) {
    u32x4 w0, w1;
    w0.x = pk2(s0[8 * s + 0], s0[8 * s + 1]); w0.y = pk2(s0[8 * s + 2], s0[8 * s + 3]); w0.z = pk2(s0[8 * s + 4], s0[8 * s + 5]); w0.w = pk2(s0[8 * s + 6], s0[8 * s + 7]);
    w1.x = pk2(s1[8 * s + 0], s1[8 * s + 1]); w1.y = pk2(s1[8 * s + 2], s1[8 * s + 3]); w1.z = pk2(s1[8 * s + 4], s1[8 * s + 5]); w1.w = pk2(s1[8 * s + 6], s1[8 * s + 7]);
    pf[s] = __builtin_bit_cast(bf16x8, w0); pf[2 + s] = __builtin_bit_cast(bf16x8, w1);
  }
  __builtin_amdgcn_sched_barrier(0);
  const int i16 = lane & 15, g16 = (lane >> 4) & 1;
  const LAS unsigned char* va = Vt + (4 * h + (i16 >> 2)) * VSTR + (16 * g16 + 4 * (i16 & 3)) * 2;
  bf16x8 vc[NDV];
#pragma unroll
  for (int d = 0; d < NDV; ++d) { const v4i16_t lo = vtr(va + d * 64), hi = vtr(va + 8 * VSTR + d * 64); vc[d] = __builtin_shufflevector(lo, hi, 0, 1, 2, 3, 4, 5, 6, 7); }
  __builtin_amdgcn_s_setprio(1);
#pragma unroll
  for (int ks = 0; ks < 4; ++ks) {
    bf16x8 vn[NDV];
#pragma unroll
    for (int d = 0; d < NDV; ++d) { vn[d] = vc[d];
      if (ks + 1 < 4) { const v4i16_t lo = vtr(va + (16 * (ks + 1)) * VSTR + d * 64), hi = vtr(va + (16 * (ks + 1) + 8) * VSTR + d * 64); vn[d] = __builtin_shufflevector(lo, hi, 0, 1, 2, 3, 4, 5, 6, 7); } }
#pragma unroll
    for (int d = 0; d < NDV; ++d) o[d] = mfma32(vc[d], pf[ks], o[d]);
    if (ks + 1 < 4) __builtin_amdgcn_sched_group_barrier(0x100, 2 * NDV, 0);
    __builtin_amdgcn_sched_group_barrier(0x008, NDV, 0);
    __builtin_amdgcn_sched_barrier(0);
#pragma unroll
    for (int d = 0; d < NDV; ++d) vc[d] = vn[d];
  }
  __builtin_amdgcn_s_setprio(0);
}

__device__ __forceinline__ void mla_phase(KP p, LAS unsigned char* lds, int wv0) {
  constexpr int KSTR = 400, VSTR = 320, KB = 64 * KSTR, VB = 64 * VSTR;
  const bf16_t* q = (const bf16_t*)(p->ws + O_Q); const bf16_t* kv = (const bf16_t*)(p->ws + O_KV);
  bf16_t* h = (bf16_t*)(p->ws + O_H);
  const int tid = otid(wv0), wid = __builtin_amdgcn_readfirstlane(tid >> 6), lane = tid & 63, c = lane & 31, hh = lane >> 5;
  const int G = ogrid(), bid = obid();
  for (int k = 0; k * G < 1024; ++k) {
    const int idx = (k & 1) ? (G - 1 - bid) : bid, rank = k * G + idx;
    if (rank >= 1024) continue;
    const int qb = 15 - rank / 64, bh = rank % 64, b = bh >> 4, hd = bh & 15;
    const int tok0 = b * SEQ, q0 = qb * 256 + 32 * wid;
    bf16x8 qf[12];
    { const bf16_t* qrow = q + (size_t)(tok0 + q0 + c) * NQ + hd * 192 + 8 * hh;
#pragma unroll
      for (int st = 0; st < 12; ++st) qf[st] = *(const bf16x8*)(qrow + 16 * st); }
    f32x16 o[4];
#pragma unroll
    for (int d = 0; d < 4; ++d)
#pragma unroll
      for (int r = 0; r < 16; ++r) o[d][r] = 0.f;
    float m = -1e30f, l = 0.f;
    const int ntiles = qb * 4 + 4;
    unsigned ksrc[3]; int kdst[3];
    const unsigned char* wsb = p->ws;
#pragma unroll
    for (int i = 0; i < 3; ++i) { const int cid = tid + 512 * i, key = cid / 24, ch = cid % 24;
      ksrc[i] = (ch < 16) ? (unsigned)(O_KV + ((size_t)(tok0 + key) * NKV + hd * 256 + ch * 8) * 2) : (unsigned)(O_H + ((size_t)(tok0 + key) * LDH + C_KR + (ch - 16) * 8) * 2);
      kdst[i] = key * KSTR + ch * 16; }
    const unsigned kinc0 = 64u * NKV * 2u, kinc1 = 64u * LDH * 2u;
    const bool k2rope = ((tid + 1024) % 24) >= 16, k1rope = ((tid + 512) % 24) >= 16, k0rope = (tid % 24) >= 16;
    unsigned vsrc[2]; int vdst[2];
#pragma unroll
    for (int i = 0; i < 2; ++i) { const int cid = tid + 512 * i, key = cid >> 4, ch = cid & 15;
      vsrc[i] = (unsigned)(O_KV + ((size_t)(tok0 + key) * NKV + hd * 256 + 128 + ch * 8) * 2); vdst[i] = key * VSTR + ch * 16; }
    u32x4 kr0 = *(const u32x4*)(wsb + ksrc[0]), kr1 = *(const u32x4*)(wsb + ksrc[1]), kr2 = *(const u32x4*)(wsb + ksrc[2]), vr0 = *(const u32x4*)(wsb + vsrc[0]), vr1 = *(const u32x4*)(wsb + vsrc[1]);
    for (int kt = 0; kt < ntiles; ++kt) {
      LAS unsigned char* Kb = lds + (kt & 1) * KB; LAS unsigned char* Vb = lds + 2 * KB + (kt & 1) * VB;
      *(LAS u32x4*)(Kb + kdst[0]) = kr0; *(LAS u32x4*)(Kb + kdst[1]) = kr1; *(LAS u32x4*)(Kb + kdst[2]) = kr2;
      *(LAS u32x4*)(Vb + vdst[0]) = vr0; *(LAS u32x4*)(Vb + vdst[1]) = vr1;
      __syncthreads();
      if (kt + 1 < ntiles) {
        ksrc[0] += k0rope ? kinc1 : kinc0; ksrc[1] += k1rope ? kinc1 : kinc0; ksrc[2] += k2rope ? kinc1 : kinc0; vsrc[0] += kinc0; vsrc[1] += kinc0;
        kr0 = *(const u32x4*)(wsb + ksrc[0]); kr1 = *(const u32x4*)(wsb + ksrc[1]); kr2 = *(const u32x4*)(wsb + ksrc[2]); vr0 = *(const u32x4*)(wsb + vsrc[0]); vr1 = *(const u32x4*)(wsb + vsrc[1]);
      }
      const int k0 = kt * 64;
      if (k0 <= q0 + 31) attn_tile<12, 4, KSTR, VSTR>(qf, o, m, l, Kb, Vb, lane, q0 + c, k0, 1 << 30, k0 + 63 > q0);
    }
    const float inv = frcp(l + __shfl_xor(l, 32));
    bf16_t* yrow = h + (size_t)(tok0 + q0 + c) * LDH + C_CQ + hd * 128 + 4 * hh;
#pragma unroll
    for (int d = 0; d < 4; ++d)
#pragma unroll
      for (int g = 0; g < 4; ++g) { u32x2 w; w.x = pk2(o[d][4 * g] * inv, o[d][4 * g + 1] * inv); w.y = pk2(o[d][4 * g + 2] * inv, o[d][4 * g + 3] * inv);
        *(u32x2*)(yrow + 32 * d + 8 * g) = w; }
    __syncthreads();
  }
}

__device__ __forceinline__ void swa_phase(KP p, int l, LAS unsigned char* lds, int wv0, int dummy = 0) {
  constexpr int STR = 144, VST = 192, TB = 64 * VST;
  bf16_t* h = (bf16_t*)(p->ws + O_H);
  const int tid = otid(wv0), wid = __builtin_amdgcn_readfirstlane(tid >> 6), lane = tid & 63, c = lane & 31, hh = lane >> 5;
  const int bid_ = obid(), grd_ = ogrid();
  for (int it = bid_; it < 256; it += grd_) {
    const int b = it >> 6, r = it & 63, kvh = r >> 5, qblk = r & 31, t0 = qblk * 128, hq = kvh * 8 + wid;
    const size_t tokb = (size_t)b * SEQ;
    bf16x8 qf[4][4];
    bf16_t* qrow0 = h + (tokb + t0 + c) * LDH + C_QA + hq * 64;
#pragma unroll
    for (int sub = 0; sub < 4; ++sub)
#pragma unroll
      for (int st = 0; st < 4; ++st) qf[sub][st] = *(const bf16x8*)(qrow0 + (size_t)sub * 32 * LDH + 16 * st + 8 * hh);
    { const int key = tid >> 3, ch = tid & 7;
#pragma unroll
      for (int j = 0; j < 4; ++j) { int kp = t0 - 128 + 64 * j + key; kp = kp < 0 ? 0 : kp;
        const bf16_t* src = h + (tokb + kp) * LDH + C_KA + kvh * 64 + ch * 8;
        *(LAS u32x4*)(lds + j * 2 * TB + key * STR + ch * 16) = *(const u32x4*)src;
        *(LAS u32x4*)(lds + j * 2 * TB + TB + key * VST + ch * 16) = *(const u32x4*)(src + (C_VA - C_KA)); } }
    __syncthreads();
    const float sink2 = p->sinks[l * 16 + hq] * LOG2E;
#pragma unroll
    for (int sub = 0; sub < 4; ++sub) {
      float m = sink2, ls = 0.f;
      f32x16 o[2];
#pragma unroll
      for (int d = 0; d < 2; ++d)
#pragma unroll
        for (int rr = 0; rr < 16; ++rr) o[d][rr] = 0.f;
      const int qpos = t0 + 32 * sub + c;
#pragma unroll
      for (int j = 0; j < 4; ++j) { const int k0 = t0 - 128 + 64 * j;
        if (k0 + 63 >= 0 && k0 + 63 >= t0 + 32 * sub - 127 && k0 <= t0 + 32 * sub + 31)
          attn_tile<4, 2, STR, VST>(qf[sub], o, m, ls, lds + j * 2 * TB, lds + j * 2 * TB + TB, lane, qpos, k0, 128, true); }
      const float inv = frcp(ls + __shfl_xor(ls, 32) + fexp2(sink2 - m));
      bf16_t* qrow = qrow0 + (size_t)sub * 32 * LDH;
#pragma unroll
      for (int d = 0; d < 2; ++d)
#pragma unroll
        for (int g = 0; g < 4; ++g) { u32x2 w; w.x = pk2(o[d][4 * g] * inv, o[d][4 * g + 1] * inv); w.y = pk2(o[d][4 * g + 2] * inv, o[d][4 * g + 3] * inv);
          bf16_t* dst_ = dummy ? (bf16_t*)(p->ws + O_Q) + (tokb + t0 + 32 * sub + c) * 1024 + hq * 64 : qrow; *(u32x2*)(dst_ + 32 * d + 8 * g + 4 * hh) = w; }
    }
    __syncthreads();
  }
}

__device__ __forceinline__ void sgu_phase(KP p, int l, LAS unsigned char* lds, int wv0, int dummy = 0) {
  constexpr int STR = 272;
  bf16_t* h = (bf16_t*)(p->ws + O_H); const f32x4* st = (const f32x4*)(p->ws + O_ST);
  LAS unsigned char* Wl = lds; LAS unsigned char* Vl = lds + 128 * STR;
  const int tid = otid(wv0), wid = __builtin_amdgcn_readfirstlane(tid >> 6), lane = tid & 63, c = lane & 31, hh = lane >> 5;
  const int bid_ = obid(), grd_ = ogrid();
  for (int it = bid_; it < 1024; it += grd_) {
    const int cidx = it >> 3, g = it & 7, tb0 = cidx * 128;
    const float* wg = p->sgu_w + ((size_t)l * 8 + g) * 128 * 128;
#pragma unroll
    for (int i = 0; i < 8; ++i) { const int idx = tid + 512 * i, t = idx >> 5, s4 = (idx & 31) * 4;
      const f32x4 v = *(const f32x4*)(wg + t * 128 + s4);
      u32x2 w; w.x = pk2(s4 <= t ? v[0] : 0.f, s4 + 1 <= t ? v[1] : 0.f); w.y = pk2(s4 + 2 <= t ? v[2] : 0.f, s4 + 3 <= t ? v[3] : 0.f);
      *(LAS u32x2*)(Wl + t * STR + s4 * 2) = w; }
#pragma unroll
    for (int i = 0; i < 4; ++i) { const int cid = tid + 512 * i, s = cid >> 4, ch = cid & 15;
      const u32x4 hv = *(const u32x4*)(h + (size_t)(tb0 + s) * LDH + C_HV + g * 128 + ch * 8);
      const f32x4 sv = st[tb0 + s]; const float mu = sv.z, rstd = sv.w;
      const float* lg = p->sgu_ln_g + l * 1024 + g * 128 + ch * 8; const float* lb = p->sgu_ln_b + l * 1024 + g * 128 + ch * 8;
      const f32x4 g0 = *(const f32x4*)lg, g1 = *(const f32x4*)(lg + 4), b0 = *(const f32x4*)lb, b1 = *(const f32x4*)(lb + 4);
      u32x4 w;
      w.x = pk2((bf_lo(hv.x) - mu) * rstd * g0[0] + b0[0], (bf_hi(hv.x) - mu) * rstd * g0[1] + b0[1]);
      w.y = pk2((bf_lo(hv.y) - mu) * rstd * g0[2] + b0[2], (bf_hi(hv.y) - mu) * rstd * g0[3] + b0[3]);
      w.z = pk2((bf_lo(hv.z) - mu) * rstd * g1[0] + b1[0], (bf_hi(hv.z) - mu) * rstd * g1[1] + b1[1]);
      w.w = pk2((bf_lo(hv.w) - mu) * rstd * g1[2] + b1[2], (bf_hi(hv.w) - mu) * rstd * g1[3] + b1[3]);
      *(LAS u32x4*)(Vl + s * STR + ch * 16) = w; }
    __syncthreads();
    const int tblk = wid >> 1, cb0 = (wid & 1) * 2;
    f32x16 acc[2];
#pragma unroll
    for (int d = 0; d < 2; ++d)
#pragma unroll
      for (int r = 0; r < 16; ++r) acc[d][r] = 0.f;
    const int i16 = lane & 15, g16 = (lane >> 4) & 1;
    const LAS unsigned char* wa = Wl + (32 * tblk + c) * STR + hh * 16;
    const LAS unsigned char* va = Vl + (8 * hh + (i16 >> 2)) * STR + (32 * cb0 + 16 * g16 + 4 * (i16 & 3)) * 2;
#pragma unroll
    for (int s = 0; s < 8; ++s) {
      const bf16x8 a = *(const LAS bf16x8*)(wa + s * 32);
#pragma unroll
      for (int d = 0; d < 2; ++d) {
        const v4i16_t lo = vtr(va + (16 * s) * STR + d * 64);
        const v4i16_t hi = vtr(va + (16 * s + 4) * STR + d * 64);
        const bf16x8 bfr = __builtin_shufflevector(lo, hi, 0, 1, 2, 3, 4, 5, 6, 7);
        acc[d] = mfma32(a, bfr, acc[d]);
      }
    }
    const float* sb = p->sgu_b + ((size_t)l * 8 + g) * 128;
    float uu[2][16], sbv[16];
#pragma unroll
    for (int r = 0; r < 16; ++r) { const int t = 32 * tblk + (r & 3) + 8 * (r >> 2) + 4 * hh; sbv[r] = sb[t];
#pragma unroll
      for (int d = 0; d < 2; ++d) uu[d][r] = bf1(h[(size_t)(tb0 + t) * LDH + C_HU + g * 128 + 32 * (cb0 + d) + c]); }
    asm volatile("" ::: "memory");
#pragma unroll
    for (int d = 0; d < 2; ++d)
#pragma unroll
      for (int r = 0; r < 16; ++r) { const int t = 32 * tblk + (r & 3) + 8 * (r >> 2) + 4 * hh, cc = 32 * (cb0 + d) + c;
        bf16_t* up = h + (size_t)(tb0 + t) * LDH + C_HU + g * 128 + cc;
        const float y = uu[d][r] * (acc[d][r] + sbv[r]);
        bf16_t* dst_ = dummy ? (bf16_t*)p->out + (size_t)(tb0 + t) * 1024 + g * 128 + cc : up; *dst_ = (bf16_t)(pk2(y, 0.f) & 0xffffu); }
    __syncthreads();
  }
}

__device__ __forceinline__ void fixup_phase(KP p, int l, int wv0) {
  const bf16_t* side = (const bf16_t*)(p->ws + O_SIDE); bf16_t* act = (bf16_t*)(p->ws + O_ACT);
  const float* cw = p->conv_w + (size_t)l * 3 * NUP; const float* cb = p->conv_b + (size_t)l * NUP;
  const int ntask = 704 * 128;
  const int id0_ = obid() * 512 + otid(wv0), idst_ = ogrid() * 512;
  for (int id = id0_; id < ntask; id += idst_) {
    const int cgp = id % 704, rk = id / 704, k = rk >> 1, rr = rk & 1, c0 = cgp * 8, t = (k * 256 + rr) & (SEQ - 1);
    const bf16_t* s0p = side + ((size_t)k * 4 + rr) * NUP;
    const bf16_t* s1p = rr ? side + ((size_t)k * 4) * NUP : side + ((size_t)(k > 0 ? k - 1 : 0) * 4 + 3) * NUP;
    const bf16_t* s2p = side + ((size_t)(k > 0 ? k - 1 : 0) * 4 + (rr ? 3 : 2)) * NUP;
    const float m1 = (t >= 1) ? 1.f : 0.f, m2 = (t >= 2) ? 1.f : 0.f;
    float y[8];
#pragma unroll
    for (int hf = 0; hf < 2; ++hf) {
      const int c = c0 + 4 * hf;
      const u32x2 a0 = *(const u32x2*)(s0p + c), a1 = *(const u32x2*)(s1p + c), a2 = *(const u32x2*)(s2p + c);
      const u32x2 d0 = *(const u32x2*)(s0p + DFF + c), d1 = *(const u32x2*)(s1p + DFF + c), d2 = *(const u32x2*)(s2p + DFF + c);
      const f32x4 wg0 = *(const f32x4*)(cw + c), wg1 = *(const f32x4*)(cw + NUP + c), wg2 = *(const f32x4*)(cw + 2 * NUP + c), bg = *(const f32x4*)(cb + c);
      const f32x4 wv0_ = *(const f32x4*)(cw + DFF + c), wv1 = *(const f32x4*)(cw + NUP + DFF + c), wv2 = *(const f32x4*)(cw + 2 * NUP + DFF + c), bv = *(const f32x4*)(cb + DFF + c);
      const float g0[4] = {bf_lo(a0.x), bf_hi(a0.x), bf_lo(a0.y), bf_hi(a0.y)}, g1[4] = {bf_lo(a1.x), bf_hi(a1.x), bf_lo(a1.y), bf_hi(a1.y)}, g2[4] = {bf_lo(a2.x), bf_hi(a2.x), bf_lo(a2.y), bf_hi(a2.y)};
      const float v0[4] = {bf_lo(d0.x), bf_hi(d0.x), bf_lo(d0.y), bf_hi(d0.y)}, v1[4] = {bf_lo(d1.x), bf_hi(d1.x), bf_lo(d1.y), bf_hi(d1.y)}, v2[4] = {bf_lo(d2.x), bf_hi(d2.x), bf_lo(d2.y), bf_hi(d2.y)};
#pragma unroll
      for (int e = 0; e < 4; ++e) {
        const float cgv = bg[e] + wg0[e] * (g2[e] * m2) + wg1[e] * (g1[e] * m1) + wg2[e] * g0[e];
        const float cvv = bv[e] + wv0_[e] * (v2[e] * m2) + wv1[e] * (v1[e] * m1) + wv2[e] * v0[e];
        y[4 * hf + e] = silu_mul(cgv, cvv);
      }
    }
    store8bf(act + (size_t)(k * 256 + rr) * DFF + c0, y);
  }
}

#define XB_TMO      128
#define XB_XCNT(j)  (256  + 64 * (j))
#define XB_XSUB(j)  (1280 + 64 * (j))
#define XB_XGEN(j)  (2304 + 64 * (j))
#define XB_TOP      3328
#define XB_TOPGEN   3392
#define XCD_BAR_WORDS 3456
#define XB_SPIN_CAP (1u << 20)
__device__ __forceinline__ unsigned xb_ld(unsigned* p)              { return __hip_atomic_load(p, __ATOMIC_RELAXED, __HIP_MEMORY_SCOPE_AGENT); }
__device__ __forceinline__ unsigned xb_add(unsigned* p, unsigned v) { return __hip_atomic_fetch_add(p, v, __ATOMIC_RELAXED, __HIP_MEMORY_SCOPE_AGENT); }
__device__ __forceinline__ unsigned xb_xcc_id() { return (unsigned)__builtin_amdgcn_s_getreg((3 << 11) | 20) & 0xFu; }
#define XB_SPIN(cond, bar) do { unsigned _sp = 0; while (cond) { __builtin_amdgcn_s_sleep(1); \
    if ((++_sp & 255u) == 0u) { if (xb_ld(&(bar)[XB_TMO])) break; if (_sp > XB_SPIN_CAP) { atomicAdd(&(bar)[XB_TMO], 1u); break; } } } } while (0)
__device__ __forceinline__ void xcd_barrier_complete(unsigned* bar, unsigned x, unsigned& nloc, unsigned& nx) {
    const unsigned G = gridDim.x * gridDim.y * gridDim.z;
    unsigned sum, cnt, mine, sp = 0u;
    for (;;) {
        sum = 0u; cnt = 0u; mine = 0u;
#pragma unroll
        for (unsigned j = 0; j < 16; ++j) { const unsigned c = xb_ld(&bar[XB_XCNT(j)]); sum += c; cnt += (c > 0u) ? 1u : 0u; mine = (j == x) ? c : mine; }
        if (sum == G) break;
        __builtin_amdgcn_s_sleep(1);
        if ((++sp & 255u) == 0u) { if (xb_ld(&bar[XB_TMO])) break; if (sp > XB_SPIN_CAP) { atomicAdd(&bar[XB_TMO], 1u); break; } }
    }
    nloc = mine > 0u ? mine : 1u; nx = cnt > 0u ? cnt : 1u;
}
__device__ __forceinline__ void xcd_barrier(unsigned* bar, volatile LAS unsigned* st, int wv0) {
    asm volatile("s_waitcnt vmcnt(0)" ::: "memory");
    __syncthreads();
    if (otid(wv0) == 0) {
        const unsigned x = xb_xcc_id();
        __builtin_amdgcn_s_waitcnt(0);
        unsigned nloc = st[0], nx = st[1];
        if (nloc == 0u) { xcd_barrier_complete(bar, x, nloc, nx); st[0] = nloc; st[1] = nx; }
        const unsigned old = xb_add(&bar[XB_XSUB(x)], 1u);
        const unsigned gen = old / nloc;
        if (old + 1u == (gen + 1u) * nloc) {
            __builtin_amdgcn_fence(__ATOMIC_RELEASE, "agent");
            asm volatile("s_waitcnt vmcnt(0)" ::: "memory");
            const unsigned og = xb_add(&bar[XB_TOP], 1u);
            const unsigned tg = og / nx;
            if (og + 1u == (tg + 1u) * nx) xb_add(&bar[XB_TOPGEN], 1u);
            else XB_SPIN(xb_ld(&bar[XB_TOPGEN]) == tg, bar);
            __builtin_amdgcn_fence(__ATOMIC_ACQUIRE, "agent");
            xb_add(&bar[XB_XGEN(x)], 1u);
            asm volatile("s_waitcnt vmcnt(0)" ::: "memory");
        } else {
            XB_SPIN(xb_ld(&bar[XB_XGEN(x)]) == gen, bar);
            __builtin_amdgcn_fence(__ATOMIC_ACQUIRE, "agent");
            asm volatile("s_waitcnt vmcnt(0)" ::: "memory");
        }
    }
    __syncthreads();
}
#define GSYNC() xcd_barrier((unsigned*)(p->ws + O_BAR), (volatile LAS unsigned*)((LAS unsigned char*)shm + 131072), wv0)

#ifndef PH_MASK
#define PH_MASK 0xFFFFF
#endif
#ifndef REP_MASK
#define REP_MASK 0
#endif
#define PH(b) for (int rep_ = 0, nrep_ = (int)(((PH_MASK >> (b)) & 1) + ((REP_MASK >> (b)) & 1)); rep_ < nrep_; ++rep_)
#define LAUNDER() do { asm volatile("" : "+s"(p), "+s"(l), "+s"(wv0) :: "memory"); ws = p->ws; xb = (bf16_t*)(ws + O_XB); xa = (float*)(ws + O_XA); hbuf = (bf16_t*)(ws + O_H); qbuf = (bf16_t*)(ws + O_Q); kvbuf = (bf16_t*)(ws + O_KV); gbuf = qbuf; mb = xb; cs = (const float*)(ws + O_CS); st = (const float*)(ws + O_ST); } while (0)
__global__ void __launch_bounds__(512, 2) mega(Params p_unused) {
  KP p = (KP)__builtin_amdgcn_kernarg_segment_ptr();
  int wv0 = __builtin_amdgcn_readfirstlane((int)threadIdx.x >> 6);
  extern __shared__ __attribute__((aligned(16))) unsigned char shm[];
  LAS unsigned char* lds = (LAS unsigned char*)shm;
  cg::grid_group grid = cg::this_grid();
  unsigned char* ws;
  bf16_t* xb; float* xa; bf16_t* hbuf; bf16_t* qbuf; bf16_t* kvbuf;
  bf16_t* gbuf;
  bf16_t* mb;
  const float* cs; const float* st; int l = 0;
  LAUNDER();

  if (otid(wv0) == 0) { volatile LAS unsigned* bst = (volatile LAS unsigned*)(lds + 131072); bst[0] = 0u; bst[1] = 0u; }
  { unsigned* bar0 = (unsigned*)(p->ws + O_BAR); for (int i = obid() * 512 + otid(wv0); i < XCD_BAR_WORDS; i += ogrid() * 512) bar0[i] = 0u; }
  PH(0) cvt_mixer_a(p, 0, lds, wv0);
  PH(1) prologue(p, wv0);
  grid.sync(); LAUNDER();
  if (otid(wv0) == 0) (void)xb_add((unsigned*)(ws + O_BAR) + XB_XCNT(xb_xcc_id()), 1u);
  for (l = 0; l < 2; ++l) {
    LAUNDER();
    PH(2) { EpiP e{}; e.out = hbuf; e.f0 = cs; run_gemm<E_MAIN>(lds, xb, DM, (const bf16_t*)(ws + O_WMAIN), NTOK, NHP, DM, e, wv0); }
    PH(18) { const int G_ = ogrid(), b_ = obid(), extra = ((NTOK / 256) * (NHP / 256)) % G_;
      cvt_mixer_b(p, l, lds, wv0, extra ? b_ - extra : b_, extra ? G_ - extra : G_); }
    GSYNC(); LAUNDER();
    PH(3) stats_phase(p, wv0);
    PH(4) swa_phase(p, l, lds, wv0, rep_ + 1 < nrep_);
    GSYNC(); LAUNDER();
    PH(5) { EpiP e{}; e.out = qbuf; e.f0 = st; e.facc = (float*)cs; run_gemm<E_UQ>(lds, hbuf + C_CQ, LDH, (const bf16_t*)(ws + O_WUQ), NTOK, NQ, 512, e, wv0); }
    PH(6) { EpiP e{}; e.out = kvbuf; e.f0 = st; run_gemm<E_UKV>(lds, hbuf + C_CKV, LDH, (const bf16_t*)(ws + O_WUKV), NTOK, NKV, 512, e, wv0); }
    PH(7) sgu_phase(p, l, lds, wv0, rep_ + 1 < nrep_);
    GSYNC(); LAUNDER();
    PH(8) mla_phase(p, lds, wv0);
    GSYNC(); LAUNDER();
    PH(9) { EpiP e{}; e.out = gbuf; e.f0 = p->b_gate + (size_t)l * NG; run_gemm<E_GATE>(lds, xb, DM, (const bf16_t*)(ws + O_WG), NTOK, NG, DM, e, wv0); }
    GSYNC(); LAUNDER();
    PH(10) { EpiP e{}; e.out = mb; e.b0 = gbuf; e.facc = p->out; e.aux = 0; run_gemm<E_PROJ>(lds, hbuf + C_QA, LDH, (const bf16_t*)(ws + O_PA), NTOK, DM, 1024, e, wv0); }
    PH(10) { EpiP e{}; e.out = mb; e.b0 = gbuf; e.facc = p->out; e.aux = 1; run_gemm<E_PROJ>(lds, hbuf + C_CQ, LDH, (const bf16_t*)(ws + O_PB), NTOK, DM, 2048, e, wv0); }
    PH(10) { EpiP e{}; e.out = mb; e.b0 = gbuf; e.facc = p->out; e.aux = 2; run_gemm<E_PROJ>(lds, hbuf + C_HU, LDH, (const bf16_t*)(ws + O_PC), NTOK, DM, 1024, e, wv0); }
    GSYNC(); LAUNDER();
    PH(11) { EpiP e{}; e.out = xa; e.f0 = (l == 0) ? p->x : xa; run_gemm<E_RES>(lds, mb, DM, (const bf16_t*)(ws + O_WO), NTOK, DM, DM, e, wv0); }
    GSYNC(); LAUNDER();
    PH(12) ln_phase(xa, xa, xb, p->ln1_g + l * DM, p->ln1_b + l * DM, wv0);
    PH(13) cvt_ffn(p, l, lds, wv0);
    GSYNC(); LAUNDER();
    PH(14) { EpiP e{}; e.out = ws + O_ACT; e.b0 = (const bf16_t*)(ws + O_SIDE); e.f0 = p->conv_w + (size_t)l * 3 * NUP; e.f1 = p->conv_b + (size_t)l * NUP; e.ex = lds + 131072 + 64;
      run_gemm<E_UPC>(lds, xb, DM, (const bf16_t*)(ws + O_WUP), NTOK, NUP, DM, e, wv0); }
    GSYNC(); LAUNDER();
    PH(15) fixup_phase(p, l, wv0);
    GSYNC(); LAUNDER();
    PH(16) { EpiP e{}; e.out = xa; e.f0 = xa; run_gemm<E_RES>(lds, (const bf16_t*)(ws + O_ACT), DFF, (const bf16_t*)(ws + O_WDN), NTOK, DM, DFF, e, wv0); }
    GSYNC(); LAUNDER();
    PH(17) ln_phase(xa, (l == 1) ? p->out : xa, (l == 1) ? nullptr : xb, p->ln2_g + l * DM, p->ln2_b + l * DM, wv0);
    if (l == 0) { PH(0) cvt_mixer_a(p, 1, lds, wv0); GSYNC(); }
  }
}

extern "C" void kernel_launch(void* const* d_in, const int* in_sizes, int n_in, void* d_out, int out_size, void* d_ws, size_t ws_size, hipStream_t stream) {
  constexpr size_t kDynLds = 131072 + 64 + 16384;
  static int grid_blocks = 0;
  if (!grid_blocks) {
    (void)hipFuncSetAttribute((const void*)mega, hipFuncAttributeMaxDynamicSharedMemorySize, (int)kDynLds);
    int dev = 0, cus = 0, per_cu = 0;
    (void)hipGetDevice(&dev);
    (void)hipDeviceGetAttribute(&cus, hipDeviceAttributeMultiprocessorCount, dev);
    (void)hipOccupancyMaxActiveBlocksPerMultiprocessor(&per_cu, mega, 512, kDynLds);
    if (per_cu > 1) per_cu = 1;
    if (per_cu < 1) per_cu = 1;
    grid_blocks = cus * per_cu;
  }
  if (ws_size < WS_NEED) { fprintf(stderr, "workspace too small: %zu < %zu\n", ws_size, (size_t)WS_NEED); return; }
  Params p{};
  p.x = (const float*)d_in[0]; p.pos = (const int*)d_in[1]; p.w_in = (const float*)d_in[2]; p.b_gate = (const float*)d_in[3]; p.sinks = (const float*)d_in[4];
  p.q_norm_g = (const float*)d_in[5]; p.kv_norm_g = (const float*)d_in[6]; p.w_uq = (const float*)d_in[7]; p.w_ukv = (const float*)d_in[8];
  p.sgu_ln_g = (const float*)d_in[9]; p.sgu_ln_b = (const float*)d_in[10]; p.sgu_w = (const float*)d_in[11]; p.sgu_b = (const float*)d_in[12];
  p.w_proj_a = (const float*)d_in[13]; p.w_proj_b = (const float*)d_in[14]; p.w_proj_c = (const float*)d_in[15]; p.w_o = (const float*)d_in[16];
  p.ln1_g = (const float*)d_in[17]; p.ln1_b = (const float*)d_in[18]; p.w_up = (const float*)d_in[19]; p.conv_w = (const float*)d_in[20]; p.conv_b = (const float*)d_in[21];
  p.w_down = (const float*)d_in[22]; p.ln2_g = (const float*)d_in[23]; p.ln2_b = (const float*)d_in[24];
  p.out = (float*)d_out; p.ws = (unsigned char*)d_ws;
  void* args[] = {&p};
  hipError_t e = hipLaunchCooperativeKernel((void*)mega, dim3(grid_blocks), dim3(512), args, kDynLds, stream);
  if (e != hipSuccess) fprintf(stderr, "cooperative launch failed: %s (grid %d)\n", hipGetErrorString(e), grid_blocks);
}
```

```cpp
#include <hip/hip_runtime.h>
#include <hip/hip_cooperative_groups.h>
#include <cstdio>
namespace cg = cooperative_groups;

#define LAS __attribute__((address_space(3)))
typedef unsigned short bf16_t;
typedef short bf16x8 __attribute__((ext_vector_type(8)));
typedef short v4i16_t __attribute__((ext_vector_type(4)));
typedef float f32x4 __attribute__((ext_vector_type(4)));
typedef float f32x2 __attribute__((ext_vector_type(2)));
typedef float f32x16 __attribute__((ext_vector_type(16)));
typedef unsigned u32x4 __attribute__((ext_vector_type(4)));
typedef unsigned u32x2 __attribute__((ext_vector_type(2)));

constexpr int NTOK = 16384, SEQ = 4096, DM = 2048;
constexpr int LDH = 4416, NHP = 4608;
constexpr int C_QA = 0, C_KA = 1024, C_VA = 1152, C_KR = 1280, C_HU = 1344, C_CQ = 2368, C_CKV = 2880, C_HV = 3392;
constexpr int NG = 6144, NQ = 3072, NKV = 4096, NUP = 11264, DFF = 5632, NIN = 10560;
constexpr float LOG2E = 1.4426950408889634f;
constexpr float ALPHA = 1.4142135623730951f;
constexpr float EPS = 1e-5f;
constexpr float SWA_QSCALE = 0.125f * LOG2E;
constexpr float MLA_QSCALE = 0.07216878364870322f * LOG2E;

__device__ const float INV_FREQ[32] = {1.000000000e+00f, 7.498942018e-01f, 5.623413324e-01f, 4.216965139e-01f, 3.162277639e-01f, 2.371373773e-01f, 1.778279394e-01f, 1.333521456e-01f, 1.000000015e-01f, 7.498942316e-02f, 5.623413250e-02f, 4.216964915e-02f, 3.162277490e-02f, 2.371373773e-02f, 1.778279431e-02f, 1.333521400e-02f, 9.999999776e-03f, 7.498942316e-03f, 5.623413250e-03f, 4.216964822e-03f, 3.162277630e-03f, 2.371373819e-03f, 1.778279431e-03f, 1.333521446e-03f, 1.000000047e-03f, 7.498941850e-04f, 5.623413017e-04f, 4.216965172e-04f, 3.162277571e-04f, 2.371373703e-04f, 1.778279402e-04f, 1.333521504e-04f};

constexpr size_t SZ_W = 76546048;
constexpr size_t O_WMAIN = 0, O_WG = 18874368, O_WUQ = O_WG + 25165824, O_WUKV = O_WUQ + 3145728, O_PA = O_WUKV + 4194304, O_PB = O_PA + 4194304, O_PC = O_PB + 8388608, O_WO = O_PC + 4194304;
constexpr size_t O_WUP = 0, O_WDN = 46137344;
constexpr size_t O_XB = SZ_W;
constexpr size_t O_XA = O_XB + 67108864;
constexpr size_t O_BIG = O_XA + 134217728;
constexpr size_t O_H = O_BIG, O_Q = O_H + 144703488, O_KV = O_Q + 100663296;
constexpr size_t O_ACT = O_BIG, O_SIDE = O_BIG + 184549376;
constexpr size_t O_CS = O_BIG + 379584512;
constexpr size_t O_ST = O_CS + 4194304;
constexpr size_t O_BAR = O_ST + 262144;
constexpr size_t WS_NEED = O_BAR + 16384;

struct Params {
  const float* x; const int* pos; const float* w_in; const float* b_gate; const float* sinks; const float* q_norm_g; const float* kv_norm_g;
  const float* w_uq; const float* w_ukv; const float* sgu_ln_g; const float* sgu_ln_b; const float* sgu_w; const float* sgu_b;
  const float* w_proj_a; const float* w_proj_b; const float* w_proj_c; const float* w_o; const float* ln1_g; const float* ln1_b;
  const float* w_up; const float* conv_w; const float* conv_b; const float* w_down; const float* ln2_g; const float* ln2_b;
  float* out; unsigned char* ws;
};

typedef const Params __attribute__((address_space(4)))* KP;
__device__ __forceinline__ int olane() { unsigned m = ~0u; asm volatile("" : "+s"(m)); return (int)__builtin_amdgcn_mbcnt_hi(m, __builtin_amdgcn_mbcnt_lo(m, 0u)); }
__device__ __forceinline__ int otid(int wv0) { int t = (wv0 << 6) | olane(); asm volatile("" : "+v"(t)); return t; }
__device__ __forceinline__ int obid() { int b = blockIdx.x; asm volatile("" : "+s"(b)); return b; }
__device__ __forceinline__ int ogrid() { int g = gridDim.x; asm volatile("" : "+s"(g)); return g; }
__device__ __forceinline__ unsigned pk2(float lo, float hi) {
  typedef __bf16 b2 __attribute__((ext_vector_type(2)));
  b2 r = __builtin_convertvector((f32x2){lo, hi}, b2);
  return __builtin_bit_cast(unsigned, r);
}
__device__ __forceinline__ float bf_lo(unsigned u) { return __uint_as_float(u << 16); }
__device__ __forceinline__ float bf_hi(unsigned u) { return __uint_as_float(u & 0xffff0000u); }
__device__ __forceinline__ float bf1(bf16_t u) { return __uint_as_float(((unsigned)u) << 16); }
__device__ __forceinline__ float fexp2(float x) { return __builtin_amdgcn_exp2f(x); }
__device__ __forceinline__ float frcp(float x) { return __builtin_amdgcn_rcpf(x); }
__device__ __forceinline__ float wave_sum(float v) {
#pragma unroll
  for (int o = 32; o > 0; o >>= 1) v += __shfl_xor(v, o);
  return v;
}
__device__ __forceinline__ float gelu1(float v) {
  const float av = __builtin_fabsf(v), d = av * 0.2316418882f + 1.0f;
  const float t = frcp(d);
  float q = t * 0.5307027145f + (-0.7265760135f); q = q * t + 0.7107068705f; q = q * t + (-0.142248368f); q = q * t + 0.127414796f; q = q * t;
  const float s = (v * v) * (-0.72134752044f);
  const float e = fexp2(s);
  const float m = v * (q * e), r = v - m;
  return v < 0.f ? m : r;
}
__device__ __forceinline__ f32x16 mfma32(bf16x8 a, bf16x8 b, f32x16 c) { return __builtin_amdgcn_mfma_f32_32x32x16_bf16(a, b, c, 0, 0, 0); }
__device__ __forceinline__ v4i16_t vtr(const LAS unsigned char* p) { return __builtin_amdgcn_ds_read_tr16_b64_v4i16((LAS v4i16_t*)p); }

namespace pg8 {
constexpr int BM = 256, BK = 64, HALF = 128, HTB = HALF * BK * 2, STAGE_BYTES = 8 * HTB, NXCD = 8, WGM = 8;
__device__ __forceinline__ int lds_byte(int r, int c) { const int st = (r >> 4) * 2 + (c >> 5), rr = r & 15, cc = c & 31, ob = rr * 64 + cc * 2; return st * 1024 + (ob ^ (((ob >> 9) & 1) << 5)); }
__device__ __forceinline__ void stage_rc(int b, int& R, int& C) { const int st = b / 1024, sb = b % 1024, swz = sb ^ (((sb >> 9) & 1) << 5); R = (st >> 1) * 16 + swz / 64; C = (st & 1) * 32 + (swz % 64) / 2; }
__device__ __forceinline__ int perm32(int rho) { const int n = rho >> 4, i = rho & 15; return 8 * (i >> 2) + 4 * n + (i & 3); }
struct Unit { int pm, pn; };
struct Gemm { const bf16_t* A; const bf16_t* Bt; int M, N, K, lda; };
struct StaticOrder {
  int nM, nN, nwg, G, c;
  __device__ void init(int M, int N, int G_, int c_) { nM = M / BM; nN = N / BM; nwg = nM * nN; G = G_; c = c_; }
  __device__ bool next(int i, Unit& u) const {
    const long L = (long)i * G + c; if (L >= nwg) return false;
    int wgid = (int)L; { const int q = nwg / NXCD, r = nwg % NXCD, xcd = wgid % NXCD, off = wgid / NXCD; wgid = (xcd < r ? xcd * (q + 1) : r * (q + 1) + (xcd - r) * q) + off; }
    const int nig = WGM * nN, gid = wgid / nig, fm = gid * WGM, gsz = (nM - fm) < WGM ? (nM - fm) : WGM;
    u.pm = fm + ((wgid % nig) % gsz); u.pn = (wgid % nig) / gsz; return true;
  }
};

template <class Epi>
__device__ __forceinline__ void gemm_phase(LAS unsigned char* lds, const Gemm g, const StaticOrder& S, const Epi& E, int wv0) {
  const int tid = otid(wv0), wid = __builtin_amdgcn_readfirstlane(tid >> 6), lane = tid & 63, wr = wid >> 2, wc = wid & 3, fr = lane & 15, fq = lane >> 4;
  const int K = g.K, nt = K / BK, lda = g.lda;
  unsigned voffA[2], voffB[2];
#pragma unroll
  for (int i = 0; i < 2; ++i) { int R, C; stage_rc(tid * 16 + i * 8192, R, C); const int Rb = (R & ~31) + perm32(R & 31);
    voffA[i] = (unsigned)(R * lda + C) * 2u; voffB[i] = (unsigned)(Rb * K + C) * 2u; }
  const size_t kstep = (size_t)(BK * 2);
  const size_t hstepA = (size_t)HALF * lda * 2, hstepB = (size_t)HALF * K * 2;
  const size_t tstepA = 2 * hstepA, tstepB = 2 * hstepB;
  const unsigned ldsw = (unsigned)wid * 1024u;
  const int aoff = lds_byte(wr * 64 + fr, fq * 8), boff = lds_byte(wc * 32 + fr, fq * 8);
#define PG8_SA(b, h) (((b) * 2 + (h)) * HTB)
#define PG8_SB(b, h) ((4 + (b) * 2 + (h)) * HTB)
#define PG8_STAGE(bufoff, gbase, voff) do { _Pragma("unroll") for (int _i = 0; _i < 2; ++_i) \
    __builtin_amdgcn_global_load_lds((const unsigned*)((const char*)(gbase) + (voff)[_i]), (LAS unsigned*)(lds + (bufoff) + ldsw + _i * 8192), 16, 0, 0); } while (0)
#define PG8_LDA(dst, b, h) do { _Pragma("unroll") for (int m = 0; m < 4; ++m) _Pragma("unroll") for (int k = 0; k < 2; ++k) dst[m][k] = *(const LAS bf16x8*)(lds + PG8_SA(b, h) + aoff + m * 2048 + k * 1024); } while (0)
#define PG8_LDB(dst, b, h) do { _Pragma("unroll") for (int n = 0; n < 2; ++n) _Pragma("unroll") for (int k = 0; k < 2; ++k) dst[n][k] = *(const LAS bf16x8*)(lds + PG8_SB(b, h) + boff + n * 2048 + k * 1024); } while (0)
#define PG8_MMA(ai, bj, At, Bt) do { __builtin_amdgcn_s_setprio(1); _Pragma("unroll") for (int m = 0; m < 4; ++m) _Pragma("unroll") for (int n = 0; n < 2; ++n) _Pragma("unroll") for (int k = 0; k < 2; ++k) \
    acc[ai][bj][m][n] = __builtin_amdgcn_mfma_f32_16x16x32_bf16(Bt[n][k], At[m][k], acc[ai][bj][m][n], 0, 0, 0); __builtin_amdgcn_s_setprio(0); } while (0)
#define PG8_WAIT_V(n) asm volatile("s_waitcnt vmcnt(" #n ")" ::: "memory")
#define PG8_WAIT_L(n) asm volatile("s_waitcnt lgkmcnt(" #n ")" ::: "memory")
#define PG8_BAR __builtin_amdgcn_s_barrier()
#define PG8_SCHED __builtin_amdgcn_sched_barrier(0)
  Unit cur, nxt; int ui = 0;
  if (!S.next(0, cur)) return;
  f32x4 acc[2][2][4][2];
#pragma unroll
  for (int a = 0; a < 2; ++a)
#pragma unroll
    for (int b = 0; b < 2; ++b)
#pragma unroll
      for (int m = 0; m < 4; ++m)
#pragma unroll
        for (int n = 0; n < 2; ++n) acc[a][b][m][n] = (f32x4){0.f, 0.f, 0.f, 0.f};
  bf16x8 At[4][2], B0[2][2], B1[2][2];
  const char* cA = (const char*)g.A + (size_t)cur.pm * tstepA; const char* cB = (const char*)g.Bt + (size_t)cur.pn * tstepB;
  PG8_STAGE(PG8_SB(0, 0), cB, voffB); PG8_STAGE(PG8_SA(0, 0), cA, voffA); PG8_STAGE(PG8_SB(0, 1), cB + hstepB, voffB); PG8_STAGE(PG8_SA(0, 1), cA + hstepA, voffA);
  if (wr == 1) PG8_BAR;
  PG8_WAIT_V(4); PG8_BAR;
  PG8_STAGE(PG8_SB(1, 0), cB + kstep, voffB); PG8_STAGE(PG8_SA(1, 0), cA + kstep, voffA); PG8_STAGE(PG8_SB(1, 1), cB + hstepB + kstep, voffB);
  PG8_WAIT_V(6); PG8_BAR;
  for (;;) {
    const bool has_next = S.next(ui + 1, nxt);
    const char* nA = has_next ? (const char*)g.A + (size_t)nxt.pm * tstepA : cA; const char* nB = has_next ? (const char*)g.Bt + (size_t)nxt.pn * tstepB : cB;
    for (int t = 0; t < nt; t += 2) {
      const bool last = (t == nt - 2);
      const char* a1 = cA + (size_t)(t + 1) * kstep;
      const char* a2 = last ? nA : cA + (size_t)(t + 2) * kstep; const char* b2 = last ? nB : cB + (size_t)(t + 2) * kstep;
      const char* a3 = a2 + kstep; const char* b3 = b2 + kstep;
      PG8_LDB(B0, 0, 0); PG8_SCHED; PG8_LDA(At, 0, 0); PG8_STAGE(PG8_SA(1, 1), a1 + hstepA, voffA);
      PG8_WAIT_L(8); PG8_BAR; PG8_WAIT_L(0); PG8_MMA(0, 0, At, B0); PG8_BAR; PG8_SCHED;
      PG8_LDB(B1, 0, 1); PG8_STAGE(PG8_SB(0, 0), b2, voffB);
      PG8_BAR; PG8_WAIT_L(0); PG8_MMA(0, 1, At, B1); PG8_BAR;
      PG8_LDA(At, 0, 1); PG8_STAGE(PG8_SA(0, 0), a2, voffA);
      PG8_BAR; PG8_WAIT_L(0); PG8_MMA(1, 0, At, B0); PG8_BAR; PG8_SCHED;
      PG8_STAGE(PG8_SB(0, 1), b2 + hstepB, voffB);
      PG8_WAIT_V(6); PG8_BAR; PG8_MMA(1, 1, At, B1); PG8_BAR;
      PG8_LDB(B0, 1, 0); PG8_SCHED; PG8_LDA(At, 1, 0); PG8_STAGE(PG8_SA(0, 1), a2 + hstepA, voffA);
      PG8_WAIT_L(8); PG8_BAR; PG8_WAIT_L(0); PG8_MMA(0, 0, At, B0); PG8_BAR; PG8_SCHED;
      PG8_LDB(B1, 1, 1); PG8_STAGE(PG8_SB(1, 0), b3, voffB);
      PG8_BAR; PG8_WAIT_L(0); PG8_MMA(0, 1, At, B1); PG8_BAR;
      PG8_LDA(At, 1, 1); PG8_STAGE(PG8_SA(1, 0), a3, voffA);
      PG8_BAR; PG8_WAIT_L(0); PG8_MMA(1, 0, At, B0); PG8_BAR; PG8_SCHED;
      PG8_STAGE(PG8_SB(1, 1), b3 + hstepB, voffB);
      PG8_WAIT_V(6); PG8_BAR; PG8_MMA(1, 1, At, B1); PG8_BAR;
    }
    E(acc, cur, wr, wc, fr, fq);
    if (!has_next) break;
#pragma unroll
    for (int a = 0; a < 2; ++a)
#pragma unroll
      for (int b = 0; b < 2; ++b)
#pragma unroll
        for (int m = 0; m < 4; ++m)
#pragma unroll
          for (int n = 0; n < 2; ++n) acc[a][b][m][n] = (f32x4){0.f, 0.f, 0.f, 0.f};
    cur = nxt; cA = nA; cB = nB; ++ui;
  }
  PG8_WAIT_V(0);
  if (wr == 0) PG8_BAR;
  PG8_BAR;
#undef PG8_SA
#undef PG8_SB
#undef PG8_STAGE
#undef PG8_LDA
#undef PG8_LDB
#undef PG8_MMA
#undef PG8_WAIT_V
#undef PG8_WAIT_L
#undef PG8_BAR
#undef PG8_SCHED
}
}

struct EpiP { void* out; int ldo; const float* f0; const bf16_t* b0; float* facc; int aux; const float* f1; LAS unsigned char* ex; };
enum { E_MAIN = 0, E_GATE = 1, E_UQ = 2, E_UKV = 3, E_PROJ = 4, E_RES = 5, E_UP = 6, E_UPC = 7 };

__device__ __forceinline__ void rope8(float (&v)[8], const f32x2* cs) {
#pragma unroll
  for (int i = 0; i < 4; ++i) { const f32x2 c = cs[i]; const float x1 = v[2 * i], x2 = v[2 * i + 1]; v[2 * i] = x1 * c.x - x2 * c.y; v[2 * i + 1] = x2 * c.x + x1 * c.y; }
}
__device__ __forceinline__ void store8bf(bf16_t* dst, const float (&v)[8]) {
  u32x4 w; w.x = pk2(v[0], v[1]); w.y = pk2(v[2], v[3]); w.z = pk2(v[4], v[5]); w.w = pk2(v[6], v[7]);
  *(u32x4*)dst = w;
}


__device__ __forceinline__ float dpp_shr1(float x) { return __int_as_float(__builtin_amdgcn_update_dpp(0, __float_as_int(x), 0x111, 0xF, 0xF, true)); }
__device__ __forceinline__ float dpp_shr2(float x) { return __int_as_float(__builtin_amdgcn_update_dpp(0, __float_as_int(x), 0x112, 0xF, 0xF, true)); }
__device__ __forceinline__ float dpp_prev1(float prev, float cur) {
  const int t = __builtin_amdgcn_update_dpp(0, __float_as_int(prev), 0x121, 0xF, 0xF, false);
  return __int_as_float(__builtin_amdgcn_update_dpp(t, __float_as_int(cur), 0x111, 0xF, 0xF, false)); }
__device__ __forceinline__ float dpp_prev2(float prev, float cur) {
  const int t = __builtin_amdgcn_update_dpp(0, __float_as_int(prev), 0x122, 0xF, 0xF, false);
  return __int_as_float(__builtin_amdgcn_update_dpp(t, __float_as_int(cur), 0x112, 0xF, 0xF, false)); }
__device__ __forceinline__ float silu_mul(float g, float v) { return g * frcp(1.0f + fexp2(-g * LOG2E)) * v; }
__device__ __forceinline__ void epi_upc(const EpiP& e, const f32x4 (&acc)[2][2][4][2], const pg8::Unit& u, int wr, int wc, int fr, int fq) {
  LAS unsigned char* ex = e.ex;
  bf16_t* side = (bf16_t*)e.b0;
  const int lc0 = 32 * wc + 8 * fq;
#pragma unroll
  for (int ai = 0; ai < 2; ++ai)
#pragma unroll
    for (int m = 0; m < 4; ++m) {
      const int g = ai * 8 + wr * 4 + m;
#pragma unroll
      for (int bj = 0; bj < 2; ++bj) {
        u32x4 w; w.x = pk2(acc[ai][bj][m][0][0], acc[ai][bj][m][0][1]); w.y = pk2(acc[ai][bj][m][0][2], acc[ai][bj][m][0][3]);
        w.z = pk2(acc[ai][bj][m][1][0], acc[ai][bj][m][1][1]); w.w = pk2(acc[ai][bj][m][1][2], acc[ai][bj][m][1][3]);
        if (m == 3 && fr >= 14) *(LAS u32x4*)(ex + ((g * 2 + (fr - 14)) * 256 + bj * 128 + lc0) * 2) = w;
        const int ucol = bj * DFF + 128 * u.pn + lc0;
        if (g == 15 && fr >= 14) *(u32x4*)(side + ((size_t)u.pm * 4 + 2 + (fr - 14)) * NUP + ucol) = w;
        if (g == 0 && fr < 2) *(u32x4*)(side + ((size_t)u.pm * 4 + fr) * NUP + ucol) = w;
      }
    }
  asm volatile("s_waitcnt lgkmcnt(0)" ::: "memory");
  __builtin_amdgcn_s_barrier();
  __builtin_amdgcn_s_barrier();
  asm volatile("" ::: "memory");
  const float* cw = e.f0; const float* cb = e.f1;
  bf16_t* act = (bf16_t*)e.out;
#pragma unroll
  for (int n = 0; n < 2; ++n) {
    const int ch = 128 * u.pn + lc0 + 4 * n;
    const f32x4 wg0 = *(const f32x4*)(cw + ch), wg1 = *(const f32x4*)(cw + NUP + ch), wg2 = *(const f32x4*)(cw + 2 * NUP + ch), bg = *(const f32x4*)(cb + ch);
    const f32x4 wv0 = *(const f32x4*)(cw + DFF + ch), wv1 = *(const f32x4*)(cw + NUP + DFF + ch), wv2 = *(const f32x4*)(cw + 2 * NUP + DFF + ch), bv = *(const f32x4*)(cb + DFF + ch);
#pragma unroll
    for (int ai = 0; ai < 2; ++ai)
#pragma unroll
      for (int m = 0; m < 4; ++m) {
        const int g = ai * 8 + wr * 4 + m, gp = g > 0 ? g - 1 : 0;
        const f32x4 xg = acc[ai][0][m][n], xv = acc[ai][1][m][n];
        float y[4];
        if (m > 0) {
          const f32x4 pg = acc[ai][0][m - 1][n], pv = acc[ai][1][m - 1][n];
#pragma unroll
          for (int k = 0; k < 4; ++k) {
            const float g1 = dpp_prev1(pg[k], xg[k]), g2 = dpp_prev2(pg[k], xg[k]), v1 = dpp_prev1(pv[k], xv[k]), v2 = dpp_prev2(pv[k], xv[k]);
            const float cg = bg[k] + wg0[k] * g2 + wg1[k] * g1 + wg2[k] * xg[k];
            const float cv = bv[k] + wv0[k] * v2 + wv1[k] * v1 + wv2[k] * xv[k];
            y[k] = silu_mul(cg, cv);
          }
        } else {
          const LAS unsigned char* hp = ex + (gp * 2 * 256 + lc0 + 4 * n) * 2;
          const u32x2 hg14 = *(const LAS u32x2*)hp, hg15 = *(const LAS u32x2*)(hp + 512), hv14 = *(const LAS u32x2*)(hp + 256), hv15 = *(const LAS u32x2*)(hp + 512 + 256);
          const float h14g[4] = {bf_lo(hg14.x), bf_hi(hg14.x), bf_lo(hg14.y), bf_hi(hg14.y)}, h15g[4] = {bf_lo(hg15.x), bf_hi(hg15.x), bf_lo(hg15.y), bf_hi(hg15.y)};
          const float h14v[4] = {bf_lo(hv14.x), bf_hi(hv14.x), bf_lo(hv14.y), bf_hi(hv14.y)}, h15v[4] = {bf_lo(hv15.x), bf_hi(hv15.x), bf_lo(hv15.y), bf_hi(hv15.y)};
#pragma unroll
          for (int k = 0; k < 4; ++k) {
            float g1 = dpp_shr1(xg[k]), g2 = dpp_shr2(xg[k]), v1 = dpp_shr1(xv[k]), v2 = dpp_shr2(xv[k]);
            if (fr == 0) { g1 = h15g[k]; g2 = h14g[k]; v1 = h15v[k]; v2 = h14v[k]; }
            if (fr == 1) { g2 = h15g[k]; v2 = h15v[k]; }
            const float cg = bg[k] + wg0[k] * g2 + wg1[k] * g1 + wg2[k] * xg[k];
            const float cv = bv[k] + wv0[k] * v2 + wv1[k] * v1 + wv2[k] * xv[k];
            y[k] = silu_mul(cg, cv);
          }
        }
        const int row = u.pm * 256 + ai * 128 + wr * 64 + m * 16 + fr;
        if (!(g == 0 && fr < 2)) { u32x2 w; w.x = pk2(y[0], y[1]); w.y = pk2(y[2], y[3]); *(u32x2*)(act + (size_t)row * DFF + ch) = w; }
      }
    asm volatile("" ::: "memory");
  }
}
struct EpiPre { f32x4 a0, a1; u32x4 u0, u1; float s; };
__device__ __forceinline__ void rope8v(float (&v)[8], f32x4 c0, f32x4 c1) {
  const float cs[8] = {c0[0], c0[1], c0[2], c0[3], c1[0], c1[1], c1[2], c1[3]};
#pragma unroll
  for (int i = 0; i < 4; ++i) { const float x1 = v[2 * i], x2 = v[2 * i + 1]; v[2 * i] = x1 * cs[2 * i] - x2 * cs[2 * i + 1]; v[2 * i + 1] = x2 * cs[2 * i] + x1 * cs[2 * i + 1]; }
}
template <int MODE> struct Epi {
  EpiP e;
  __device__ __forceinline__ void preload(EpiPre& q, int row, int col) const {
    if (MODE == E_GATE || MODE == E_UKV) return;
    if (MODE == E_MAIN) {
      if (col >= C_KR && col < C_HU) { const float* cs = e.f0 + ((size_t)row * 32 + ((col - C_KR) >> 1)) * 2; q.a0 = *(const f32x4*)cs; q.a1 = *(const f32x4*)(cs + 4); }
    } else if (MODE == E_GATE) {
      q.a0 = *(const f32x4*)(e.f0 + col); q.a1 = *(const f32x4*)(e.f0 + col + 4);
    } else if (MODE == E_UQ) {
      const int c192 = col % 192;
      if (c192 >= 128) { const float* cs = e.facc + ((size_t)row * 32 + ((c192 - 128) >> 1)) * 2; q.a0 = *(const f32x4*)cs; q.a1 = *(const f32x4*)(cs + 4); }
    } else if (MODE == E_UKV) {
      q.s = ((const f32x4*)e.f0)[row].y;
    } else if (MODE == E_PROJ) {
      q.u0 = *(const u32x4*)(e.b0 + (size_t)row * NG + e.aux * DM + col);
      if (e.aux > 0) q.u1 = *(const u32x4*)((const bf16_t*)e.facc + (size_t)row * DM + col);
    } else if (MODE == E_RES) {
      const float* rs = e.f0 + (size_t)row * DM + col; q.a0 = *(const f32x4*)rs; q.a1 = *(const f32x4*)(rs + 4);
    }
  }
  __device__ __forceinline__ void emit(const EpiPre& q0, int row, int col, f32x4 a, f32x4 b, const f32x4 (&hb)[2][2], const float (&hs)[2][4], int ai_, int m_, int bj_) const {
    EpiPre q = q0;
    if (MODE == E_GATE) { q.a0 = hb[bj_][0]; q.a1 = hb[bj_][1]; }
    if (MODE == E_UQ || MODE == E_UKV) q.s = hs[ai_][m_];
    float v[8] = {a[0], a[1], a[2], a[3], b[0], b[1], b[2], b[3]};
    if (MODE == E_MAIN) {
      if (col >= LDH) return;
      if (col < C_KA) {
#pragma unroll
        for (int j = 0; j < 8; ++j) v[j] *= SWA_QSCALE;
      } else if (col >= C_KR && col < C_HU) {
        rope8v(v, q.a0, q.a1);
      } else if ((col >= C_HU && col < C_CQ) || col >= C_HV) {
#pragma unroll
        for (int j = 0; j < 8; ++j) v[j] = gelu1(v[j]);
      }
      store8bf((bf16_t*)e.out + (size_t)row * LDH + col, v);
    } else if (MODE == E_GATE) {
      const float bb[8] = {q.a0[0], q.a0[1], q.a0[2], q.a0[3], q.a1[0], q.a1[1], q.a1[2], q.a1[3]};
#pragma unroll
      for (int j = 0; j < 8; ++j) v[j] = frcp(1.0f + fexp2(-(v[j] + bb[j]) * LOG2E));
      store8bf((bf16_t*)e.out + (size_t)row * NG + col, v);
    } else if (MODE == E_UQ) {
#pragma unroll
      for (int j = 0; j < 8; ++j) v[j] *= q.s;
      if (col % 192 >= 128) rope8v(v, q.a0, q.a1);
      store8bf((bf16_t*)e.out + (size_t)row * NQ + col, v);
    } else if (MODE == E_UKV) {
#pragma unroll
      for (int j = 0; j < 8; ++j) v[j] *= q.s;
      store8bf((bf16_t*)e.out + (size_t)row * NKV + col, v);
    } else if (MODE == E_PROJ) {
      const int br = e.aux; const u32x4 gw = q.u0;
      v[0] *= bf_lo(gw.x); v[1] *= bf_hi(gw.x); v[2] *= bf_lo(gw.y); v[3] *= bf_hi(gw.y);
      v[4] *= bf_lo(gw.z); v[5] *= bf_hi(gw.z); v[6] *= bf_lo(gw.w); v[7] *= bf_hi(gw.w);
      bf16_t* fa = (bf16_t*)e.facc + (size_t)row * DM + col;
      if (br > 0) { const u32x4 pw = q.u1;
        v[0] += bf_lo(pw.x); v[1] += bf_hi(pw.x); v[2] += bf_lo(pw.y); v[3] += bf_hi(pw.y); v[4] += bf_lo(pw.z); v[5] += bf_hi(pw.z); v[6] += bf_lo(pw.w); v[7] += bf_hi(pw.w); }
      if (br == 2) store8bf((bf16_t*)e.out + (size_t)row * DM + col, v);
      else store8bf(fa, v);
    } else if (MODE == E_RES) {
      const f32x4 r0 = q.a0, r1 = q.a1;
      float* o = (float*)e.out + (size_t)row * DM + col;
      *(f32x4*)o = (f32x4){ALPHA * r0[0] + v[0], ALPHA * r0[1] + v[1], ALPHA * r0[2] + v[2], ALPHA * r0[3] + v[3]};
      *(f32x4*)(o + 4) = (f32x4){ALPHA * r1[0] + v[4], ALPHA * r1[1] + v[5], ALPHA * r1[2] + v[6], ALPHA * r1[3] + v[7]};
    } else {
      store8bf((bf16_t*)e.out + (size_t)row * e.ldo + col, v);
    }
  }
  __device__ __forceinline__ void operator()(const f32x4 (&acc)[2][2][4][2], const pg8::Unit& u, int wr, int wc, int fr, int fq) const {
    if (MODE == E_UPC) { epi_upc(e, acc, u, wr, wc, fr, fq); return; }
    const int row0 = u.pm * 256 + wr * 64 + fr, col0 = u.pn * 256 + wc * 32 + 8 * fq;
    f32x4 hb[2][2]; float hs[2][4];
#pragma unroll
    for (int bj = 0; bj < 2; ++bj) { hb[bj][0] = (f32x4){0.f, 0.f, 0.f, 0.f}; hb[bj][1] = hb[bj][0];
      if (MODE == E_GATE) { hb[bj][0] = *(const f32x4*)(e.f0 + col0 + bj * 128); hb[bj][1] = *(const f32x4*)(e.f0 + col0 + bj * 128 + 4); } }
#pragma unroll
    for (int ai = 0; ai < 2; ++ai)
#pragma unroll
      for (int m = 0; m < 4; ++m) { hs[ai][m] = 0.f;
        if (MODE == E_UQ) hs[ai][m] = ((const f32x4*)e.f0)[row0 + ai * 128 + m * 16].x * MLA_QSCALE;
        if (MODE == E_UKV) hs[ai][m] = ((const f32x4*)e.f0)[row0 + ai * 128 + m * 16].y; }
    EpiPre q[2][4];
#pragma unroll
    for (int i = 0; i < 4; ++i) preload(q[0][i], row0 + (i >> 1) * 16, col0 + (i & 1) * 128);
#pragma unroll
    for (int gi = 0; gi < 4; ++gi) {
      const int ai = gi >> 1, mp = gi & 1;
      if (gi + 1 < 4) { const int ai2 = (gi + 1) >> 1, mp2 = (gi + 1) & 1;
#pragma unroll
        for (int i = 0; i < 4; ++i) preload(q[(gi + 1) & 1][i], row0 + ai2 * 128 + (2 * mp2 + (i >> 1)) * 16, col0 + (i & 1) * 128); }
      asm volatile("" ::: "memory");
#pragma unroll
      for (int i = 0; i < 4; ++i) { const int m = 2 * mp + (i >> 1), bj = i & 1; emit(q[gi & 1][i], row0 + ai * 128 + m * 16, col0 + bj * 128, acc[ai][bj][m][0], acc[ai][bj][m][1], hb, hs, ai, m, bj); }
      asm volatile("" ::: "memory");
    }
  }
};

template <int MODE>
__device__ __forceinline__ void run_gemm(LAS unsigned char* lds, const bf16_t* A, int lda, const bf16_t* Bt, int M, int N, int K, const EpiP& ep, int wv0) {
  pg8::Gemm g; g.A = A; g.Bt = Bt; g.M = M; g.N = N; g.K = K; g.lda = lda;
  pg8::StaticOrder S; S.init(M, N, ogrid(), obid());
  Epi<MODE> E; E.e = ep;
  pg8::gemm_phase(lds, g, S, E, wv0);
}

__device__ __forceinline__ int rope_src(int j) { return (j & 1) ? 32 + (j >> 1) : (j >> 1); }
__device__ __forceinline__ int srcmap(int kind, int n) {
  if (kind == 0) return n;
  if (kind == 1) {
    if (n < C_KR) return n;
    if (n < C_HU) return 2304 + rope_src(n - C_KR);
    if (n < C_CQ) return n - C_HU + 2368;
    if (n < C_CKV) return n - C_CQ + 1280;
    if (n < C_HV) return n - C_CKV + 1792;
    if (n < LDH) return n;
    return -1;
  }
  if (kind == 2) return 4416 + n;
  if (kind == 4) { const int pn = n >> 8, lc = n & 255; return lc < 128 ? 128 * pn + lc : DFF + 128 * pn + (lc - 128); }
  { const int hd = n / 192, c = n % 192; if (c < 128) return n; return hd * 192 + 128 + rope_src(c - 128); }
}
__device__ __forceinline__ void cvt_job(LAS unsigned char* lds, const float* src, bf16_t* dst, const float* kscale, int K, int Nsrc, int Ndst, int kind, int wv0, int bid_, int grd_) {
  LAS float* tile = (LAS float*)lds;
  const int tid = otid(wv0), nkt = K / 64, ntile = (Ndst / 64) * nkt;
  if (bid_ < 0) return;
  const int nl = tid & 63, kb = tid >> 6;
  float v[8];
#define CVT_LOAD(t_) do { const int k0_ = ((t_) % nkt) * 64, n0_ = ((t_) / nkt) * 64; const int sn = srcmap(kind, n0_ + nl); \
    _Pragma("unroll") for (int i = 0; i < 8; ++i) { const int kl = kb + 8 * i; v[i] = 0.f; \
      if (sn >= 0) { v[i] = src[(size_t)(k0_ + kl) * Nsrc + sn]; if (kscale) v[i] *= kscale[k0_ + kl]; } } } while (0)
  if (bid_ < ntile) CVT_LOAD(bid_);
  for (int t = bid_; t < ntile; t += grd_) {
    const int k0 = (t % nkt) * 64, n0 = (t / nkt) * 64;
#pragma unroll
    for (int i = 0; i < 8; ++i) tile[(kb + 8 * i) * 65 + nl] = v[i];
    __syncthreads();
    if (t + grd_ < ntile) CVT_LOAD(t + grd_);
    { const int nl2 = tid >> 3, kc = (tid & 7) * 8; float w[8];
#pragma unroll
      for (int j = 0; j < 8; ++j) w[j] = tile[(kc + j) * 65 + nl2];
      store8bf(dst + (size_t)(n0 + nl2) * K + k0 + kc, w); }
    __syncthreads();
  }
#undef CVT_LOAD
}
__device__ __forceinline__ void cvt_mixer_a(KP p, int l, LAS unsigned char* lds, int wv0) {
  unsigned char* W = p->ws; const int f = obid(), st = ogrid();
  cvt_job(lds, p->w_in + (size_t)l * DM * NIN, (bf16_t*)(W + O_WMAIN), nullptr, DM, NIN, NHP, 1, wv0, f, st);
  cvt_job(lds, p->w_in + (size_t)l * DM * NIN, (bf16_t*)(W + O_WG), nullptr, DM, NIN, NG, 2, wv0, f, st);
}
__device__ __forceinline__ void cvt_mixer_b(KP p, int l, LAS unsigned char* lds, int wv0, int f, int st) {
  unsigned char* W = p->ws;
  cvt_job(lds, p->w_uq + (size_t)l * 512 * NQ, (bf16_t*)(W + O_WUQ), p->q_norm_g + l * 512, 512, NQ, NQ, 3, wv0, f, st);
  cvt_job(lds, p->w_ukv + (size_t)l * 512 * NKV, (bf16_t*)(W + O_WUKV), p->kv_norm_g + l * 512, 512, NKV, NKV, 0, wv0, f, st);
  cvt_job(lds, p->w_proj_a + (size_t)l * 1024 * DM, (bf16_t*)(W + O_PA), nullptr, 1024, DM, DM, 0, wv0, f, st);
  cvt_job(lds, p->w_proj_b + (size_t)l * 2048 * DM, (bf16_t*)(W + O_PB), nullptr, 2048, DM, DM, 0, wv0, f, st);
  cvt_job(lds, p->w_proj_c + (size_t)l * 1024 * DM, (bf16_t*)(W + O_PC), nullptr, 1024, DM, DM, 0, wv0, f, st);
  cvt_job(lds, p->w_o + (size_t)l * DM * DM, (bf16_t*)(W + O_WO), nullptr, DM, DM, DM, 0, wv0, f, st);
}
__device__ __forceinline__ void cvt_ffn(KP p, int l, LAS unsigned char* lds, int wv0) {
  unsigned char* W = p->ws; const int f = obid(), st = ogrid();
  cvt_job(lds, p->w_up + (size_t)l * DM * NUP, (bf16_t*)(W + O_WUP), nullptr, DM, NUP, NUP, 4, wv0, f, st);
  cvt_job(lds, p->w_down + (size_t)l * DFF * DM, (bf16_t*)(W + O_WDN), nullptr, DFF, DM, DM, 0, wv0, f, st);
}

__device__ __forceinline__ void prologue(KP p, int wv0) {
  const size_t tid = (size_t)obid() * 512 + otid(wv0), nth = (size_t)ogrid() * 512;
  bf16_t* xb = (bf16_t*)(p->ws + O_XB);
  for (size_t i = tid; i < (size_t)NTOK * DM / 4; i += 4 * nth) {
    f32x4 v[4];
#pragma unroll
    for (int j = 0; j < 4; ++j) if (i + j * nth < (size_t)NTOK * DM / 4) v[j] = ((const f32x4*)p->x)[i + j * nth];
#pragma unroll
    for (int j = 0; j < 4; ++j) if (i + j * nth < (size_t)NTOK * DM / 4) { u32x2 w; w.x = pk2(v[j][0], v[j][1]); w.y = pk2(v[j][2], v[j][3]); ((u32x2*)xb)[i + j * nth] = w; } }
  f32x2* cs = (f32x2*)(p->ws + O_CS);
  for (size_t i = tid; i < (size_t)NTOK * 32; i += nth) {
    const int tok = (int)(i >> 5), f = (int)(i & 31);
    const float ang = (float)p->pos[tok] * INV_FREQ[f];
    double t = (double)ang * 0.15915494309189535; t -= __builtin_rint(t);
    const float tf = (float)t;
    cs[i] = (f32x2){__builtin_amdgcn_cosf(tf), __builtin_amdgcn_sinf(tf)};
  }
}

__device__ __forceinline__ void stats_phase(KP p, int wv0) {
  const bf16_t* h = (const bf16_t*)(p->ws + O_H); f32x4* st = (f32x4*)(p->ws + O_ST);
  const int tid_ = otid(wv0); const int lane = tid_ & 63, wv = obid() * 8 + (tid_ >> 6), nwv = ogrid() * 8;
  for (int row0 = wv; row0 < NTOK; row0 += 4 * nwv) {
    u32x4 a[4], b[4], v0[4], v1[4];
#pragma unroll
    for (int k = 0; k < 4; ++k) { const int row = row0 + k * nwv < NTOK ? row0 + k * nwv : row0; const bf16_t* hr = h + (size_t)row * LDH;
      a[k] = *(const u32x4*)(hr + C_CQ + lane * 8); b[k] = *(const u32x4*)(hr + C_CKV + lane * 8);
      v0[k] = *(const u32x4*)(hr + C_HV + lane * 16); v1[k] = *(const u32x4*)(hr + C_HV + lane * 16 + 8); }
    float sa[4], sb[4], sv[4], sq[4], mu[4];
#pragma unroll
    for (int k = 0; k < 4; ++k) { sa[k] = 0.f; sb[k] = 0.f; sv[k] = 0.f;
#pragma unroll
      for (int j = 0; j < 4; ++j) { float x0 = bf_lo(a[k][j]), x1 = bf_hi(a[k][j]); sa[k] += x0 * x0 + x1 * x1; x0 = bf_lo(b[k][j]); x1 = bf_hi(b[k][j]); sb[k] += x0 * x0 + x1 * x1;
        sv[k] += bf_lo(v0[k][j]) + bf_hi(v0[k][j]) + bf_lo(v1[k][j]) + bf_hi(v1[k][j]); } }
#pragma unroll
    for (int o = 32; o > 0; o >>= 1)
#pragma unroll
      for (int k = 0; k < 4; ++k) { sa[k] += __shfl_xor(sa[k], o); sb[k] += __shfl_xor(sb[k], o); sv[k] += __shfl_xor(sv[k], o); }
#pragma unroll
    for (int k = 0; k < 4; ++k) { mu[k] = sv[k] * (1.0f / 1024.0f); sq[k] = 0.f;
#pragma unroll
      for (int j = 0; j < 4; ++j) { float d;
        d = bf_lo(v0[k][j]) - mu[k]; sq[k] += d * d; d = bf_hi(v0[k][j]) - mu[k]; sq[k] += d * d; d = bf_lo(v1[k][j]) - mu[k]; sq[k] += d * d; d = bf_hi(v1[k][j]) - mu[k]; sq[k] += d * d; } }
#pragma unroll
    for (int o = 32; o > 0; o >>= 1)
#pragma unroll
      for (int k = 0; k < 4; ++k) sq[k] += __shfl_xor(sq[k], o);
#pragma unroll
    for (int k = 0; k < 4; ++k) if (lane == 0 && row0 + k * nwv < NTOK)
      st[row0 + k * nwv] = (f32x4){__builtin_amdgcn_rsqf(sa[k] * (1.0f / 512.0f) + EPS), __builtin_amdgcn_rsqf(sb[k] * (1.0f / 512.0f) + EPS), mu[k], __builtin_amdgcn_rsqf(sq[k] * (1.0f / 1024.0f) + EPS)};
  }
}

__device__ __forceinline__ void ln_phase(const float* in, float* outf, bf16_t* outb, const float* g, const float* b, int wv0) {
  const int tid_ = otid(wv0); const int lane = tid_ & 63, wv = obid() * 8 + (tid_ >> 6), nwv = ogrid() * 8;
  f32x4 gg[8], bb[8];
#pragma unroll
  for (int i = 0; i < 8; ++i) { gg[i] = ((const f32x4*)g)[i * 64 + lane]; bb[i] = ((const f32x4*)b)[i * 64 + lane]; }
  f32x4 vn[8];
  if (wv < NTOK) { const f32x4* ir = (const f32x4*)(in + (size_t)wv * DM);
#pragma unroll
    for (int i = 0; i < 8; ++i) vn[i] = ir[i * 64 + lane]; }
  for (int row = wv; row < NTOK; row += nwv) {
    f32x4 v[8]; float s = 0.f;
#pragma unroll
    for (int i = 0; i < 8; ++i) v[i] = vn[i];
    if (row + nwv < NTOK) { const f32x4* ir = (const f32x4*)(in + (size_t)(row + nwv) * DM);
#pragma unroll
      for (int i = 0; i < 8; ++i) vn[i] = ir[i * 64 + lane]; }
#pragma unroll
    for (int i = 0; i < 8; ++i) s += v[i][0] + v[i][1] + v[i][2] + v[i][3];
    s = wave_sum(s); const float mu = s * (1.0f / 2048.0f);
    float sq = 0.f;
#pragma unroll
    for (int i = 0; i < 8; ++i) { v[i] -= mu; sq += v[i][0] * v[i][0] + v[i][1] * v[i][1] + v[i][2] * v[i][2] + v[i][3] * v[i][3]; }
    sq = wave_sum(sq); const float rstd = __builtin_amdgcn_rsqf(sq * (1.0f / 2048.0f) + EPS);
#pragma unroll
    for (int i = 0; i < 8; ++i) {
      const f32x4 y = v[i] * rstd * gg[i] + bb[i];
      ((f32x4*)(outf + (size_t)row * DM))[i * 64 + lane] = y;
      if (outb) { u32x2 w; w.x = pk2(y[0], y[1]); w.y = pk2(y[2], y[3]); ((u32x2*)(outb + (size_t)row * DM))[i * 64 + lane] = w; } }
  }
}

template <int NQK, int NDV, int KSTR, int VSTR>
__device__ __forceinline__ void attn_tile(const bf16x8 (&qf)[NQK], f32x16 (&o)[NDV], float& m, float& l, const LAS unsigned char* Kt, const LAS unsigned char* Vt,
                                          int lane, int qpos, int kpos0, int window, bool domask) {
  const int c = lane & 31, h = lane >> 5;
  f32x16 s0, s1;
#pragma unroll
  for (int r = 0; r < 16; ++r) { s0[r] = 0.f; s1[r] = 0.f; }
  const LAS unsigned char* ka = Kt + c * KSTR + h * 16;
  bf16x8 kc0 = *(const LAS bf16x8*)(ka), kc1 = *(const LAS bf16x8*)(ka + 32 * KSTR);
  __builtin_amdgcn_s_setprio(1);
#pragma unroll
  for (int st = 0; st < NQK; ++st) {
    bf16x8 kn0 = kc0, kn1 = kc1;
    if (st + 1 < NQK) { kn0 = *(const LAS bf16x8*)(ka + (st + 1) * 32); kn1 = *(const LAS bf16x8*)(ka + 32 * KSTR + (st + 1) * 32); }
    s0 = mfma32(kc0, qf[st], s0);
    s1 = mfma32(kc1, qf[st], s1);
    if (st + 1 < NQK) __builtin_amdgcn_sched_group_barrier(0x100, 2, 0);
    __builtin_amdgcn_sched_group_barrier(0x008, 2, 0);
    __builtin_amdgcn_sched_barrier(0);
    kc0 = kn0; kc1 = kn1;
  }
  __builtin_amdgcn_s_setprio(0);
  __builtin_amdgcn_sched_barrier(0);
  if (domask) {
#pragma unroll
    for (int r = 0; r < 16; ++r) { const int kp = kpos0 + (r & 3) + 8 * (r >> 2) + 4 * h;
      const bool v0 = (kp <= qpos) && (kp > qpos - window) && (kp >= 0);
      const bool v1 = (kp + 32 <= qpos) && (kp + 32 > qpos - window) && (kp + 32 >= 0);
      s0[r] = v0 ? s0[r] : -1e30f; s1[r] = v1 ? s1[r] : -1e30f; }
  }
  float mx = fmaxf(s0[0], s1[0]);
#pragma unroll
  for (int r = 1; r < 16; ++r) mx = fmaxf(mx, fmaxf(s0[r], s1[r]));
  mx = fmaxf(mx, __shfl_xor(mx, 32));
  if (__builtin_amdgcn_ballot_w64(mx > m + 8.0f) != 0ull) {
    const float mn = fmaxf(m, mx), alpha = fexp2(m - mn);
    m = mn; l *= alpha;
#pragma unroll
    for (int d = 0; d < NDV; ++d) o[d] *= alpha;
  }
  float ps = 0.f;
#pragma unroll
  for (int r = 0; r < 16; ++r) { s0[r] = fexp2(s0[r] - m); s1[r] = fexp2(s1[r] - m); ps += s0[r] + s1[r]; }
  l += ps;
  bf16x8 pf[4];
#pragma unroll
  for (int s = 0; s < 2; ++s) {
    u32x4 w0, w1;
    w0.x = pk2(s0[8 * s + 0], s0[8 * s + 1]); w0.y = pk2(s0[8 * s + 2], s0[8 * s + 3]); w0.z = pk2(s0[8 * s + 4], s0[8 * s + 5]); w0.w = pk2(s0[8 * s + 6], s0[8 * s + 7]);
    w1.x = pk2(s1[8 * s + 0], s1[8 * s + 1]); w1.y = pk2(s1[8 * s + 2], s1[8 * s + 3]); w1.z = pk2(s1[8 * s + 4], s1[8 * s + 5]); w1.w = pk2(s1[8 * s + 6], s1[8 * s + 7]);
    pf[s] = __builtin_bit_cast(bf16x8, w0); pf[2 + s] = __builtin_bit_cast(bf16x8, w1);
  }
  __builtin_amdgcn_sched_barrier(0);
  const int i16 = lane & 15, g16 = (lane >> 4) & 1;
  const LAS unsigned char* va = Vt + (4 * h + (i16 >> 2)) * VSTR + (16 * g16 + 4 * (i16 & 3)) * 2;
  bf16x8 vc[NDV];
#pragma unroll
  for (int d = 0; d < NDV; ++d) { const v4i16_t lo = vtr(va + d * 64), hi = vtr(va + 8 * VSTR + d * 64); vc[d] = __builtin_shufflevector(lo, hi, 0, 1, 2, 3, 4, 5, 6, 7); }
  __builtin_amdgcn_s_setprio(1);
#pragma unroll
  for (int ks = 0; ks < 4; ++ks) {
    bf16x8 vn[NDV];
#pragma unroll
    for (int d = 0; d < NDV; ++d) { vn[d] = vc[d];
      if (ks + 1 < 4) { const v4i16_t lo = vtr(va + (16 * (ks + 1)) * VSTR + d * 64), hi = vtr(va + (16 * (ks + 1) + 8) * VSTR + d * 64); vn[d] = __builtin_shufflevector(lo, hi, 0, 1, 2, 3, 4, 5, 6, 7); } }
#pragma unroll
    for (int d = 0; d < NDV; ++d) o[d] = mfma32(vc[d], pf[ks], o[d]);
    if (ks + 1 < 4) __builtin_amdgcn_sched_group_barrier(0x100, 2 * NDV, 0);
    __builtin_amdgcn_sched_group_barrier(0x008, NDV, 0);
    __builtin_amdgcn_sched_barrier(0);
#pragma unroll
    for (int d = 0; d < NDV; ++d) vc[d] = vn[d];
  }
  __builtin_amdgcn_s_setprio(0);
}

__device__ __forceinline__ void mla_phase(KP p, LAS unsigned char* lds, int wv0) {
  constexpr int KSTR = 400, VSTR = 320, KB = 64 * KSTR, VB = 64 * VSTR;
  const bf16_t* q = (const bf16_t*)(p->ws + O_Q); const bf16_t* kv = (const bf16_t*)(p->ws + O_KV);
  bf16_t* h = (bf16_t*)(p->ws + O_H);
  const int tid = otid(wv0), wid = __builtin_amdgcn_readfirstlane(tid >> 6), lane = tid & 63, c = lane & 31, hh = lane >> 5;
  const int G = ogrid(), bid = obid();
  for (int k = 0; k * G < 1024; ++k) {
    const int idx = (k & 1) ? (G - 1 - bid) : bid, rank = k * G + idx;
    if (rank >= 1024) continue;
    const int qb = 15 - rank / 64, bh = rank % 64, b = bh >> 4, hd = bh & 15;
    const int tok0 = b * SEQ, q0 = qb * 256 + 32 * wid;
    bf16x8 qf[12];
    { const bf16_t* qrow = q + (size_t)(tok0 + q0 + c) * NQ + hd * 192 + 8 * hh;
#pragma unroll
      for (int st = 0; st < 12; ++st) qf[st] = *(const bf16x8*)(qrow + 16 * st); }
    f32x16 o[4];
#pragma unroll
    for (int d = 0; d < 4; ++d)
#pragma unroll
      for (int r = 0; r < 16; ++r) o[d][r] = 0.f;
    float m = -1e30f, l = 0.f;
    const int ntiles = qb * 4 + 4;
    unsigned ksrc[3]; int kdst[3];
    const unsigned char* wsb = p->ws;
#pragma unroll
    for (int i = 0; i < 3; ++i) { const int cid = tid + 512 * i, key = cid / 24, ch = cid % 24;
      ksrc[i] = (ch < 16) ? (unsigned)(O_KV + ((size_t)(tok0 + key) * NKV + hd * 256 + ch * 8) * 2) : (unsigned)(O_H + ((size_t)(tok0 + key) * LDH + C_KR + (ch - 16) * 8) * 2);
      kdst[i] = key * KSTR + ch * 16; }
    const unsigned kinc0 = 64u * NKV * 2u, kinc1 = 64u * LDH * 2u;
    const bool k2rope = ((tid + 1024) % 24) >= 16, k1rope = ((tid + 512) % 24) >= 16, k0rope = (tid % 24) >= 16;
    unsigned vsrc[2]; int vdst[2];
#pragma unroll
    for (int i = 0; i < 2; ++i) { const int cid = tid + 512 * i, key = cid >> 4, ch = cid & 15;
      vsrc[i] = (unsigned)(O_KV + ((size_t)(tok0 + key) * NKV + hd * 256 + 128 + ch * 8) * 2); vdst[i] = key * VSTR + ch * 16; }
    u32x4 kr0 = *(const u32x4*)(wsb + ksrc[0]), kr1 = *(const u32x4*)(wsb + ksrc[1]), kr2 = *(const u32x4*)(wsb + ksrc[2]), vr0 = *(const u32x4*)(wsb + vsrc[0]), vr1 = *(const u32x4*)(wsb + vsrc[1]);
    for (int kt = 0; kt < ntiles; ++kt) {
      LAS unsigned char* Kb = lds + (kt & 1) * KB; LAS unsigned char* Vb = lds + 2 * KB + (kt & 1) * VB;
      *(LAS u32x4*)(Kb + kdst[0]) = kr0; *(LAS u32x4*)(Kb + kdst[1]) = kr1; *(LAS u32x4*)(Kb + kdst[2]) = kr2;
      *(LAS u32x4*)(Vb + vdst[0]) = vr0; *(LAS u32x4*)(Vb + vdst[1]) = vr1;
      __syncthreads();
      if (kt + 1 < ntiles) {
        ksrc[0] += k0rope ? kinc1 : kinc0; ksrc[1] += k1rope ? kinc1 : kinc0; ksrc[2] += k2rope ? kinc1 : kinc0; vsrc[0] += kinc0; vsrc[1] += kinc0;
        kr0 = *(const u32x4*)(wsb + ksrc[0]); kr1 = *(const u32x4*)(wsb + ksrc[1]); kr2 = *(const u32x4*)(wsb + ksrc[2]); vr0 = *(const u32x4*)(wsb + vsrc[0]); vr1 = *(const u32x4*)(wsb + vsrc[1]);
      }
      const int k0 = kt * 64;
      if (k0 <= q0 + 31) attn_tile<12, 4, KSTR, VSTR>(qf, o, m, l, Kb, Vb, lane, q0 + c, k0, 1 << 30, k0 + 63 > q0);
    }
    const float inv = frcp(l + __shfl_xor(l, 32));
    bf16_t* yrow = h + (size_t)(tok0 + q0 + c) * LDH + C_CQ + hd * 128 + 4 * hh;
#pragma unroll
    for (int d = 0; d < 4; ++d)
#pragma unroll
      for (int g = 0; g < 4; ++g) { u32x2 w; w.x = pk2(o[d][4 * g] * inv, o[d][4 * g + 1] * inv); w.y = pk2(o[d][4 * g + 2] * inv, o[d][4 * g + 3] * inv);
        *(u32x2*)(yrow + 32 * d + 8 * g) = w; }
    __syncthreads();
  }
}

__device__ __forceinline__ void swa_phase(KP p, int l, LAS unsigned char* lds, int wv0, int dummy = 0) {
  constexpr int STR = 144, VST = 192, TB = 64 * VST;
  bf16_t* h = (bf16_t*)(p->ws + O_H);
  const int tid = otid(wv0), wid = __builtin_amdgcn_readfirstlane(tid >> 6), lane = tid & 63, c = lane & 31, hh = lane >> 5;
  const int bid_ = obid(), grd_ = ogrid();
  for (int it = bid_; it < 512; it += grd_) {
    const int b = it >> 7, r = it & 127, kvh = r >> 6, qblk = r & 63, t0 = qblk * 64, hq = kvh * 8 + wid;
    const size_t tokb = (size_t)b * SEQ;
    bf16x8 qf[2][4];
    bf16_t* qrow0 = h + (tokb + t0 + c) * LDH + C_QA + hq * 64;
#pragma unroll
    for (int sub = 0; sub < 2; ++sub)
#pragma unroll
      for (int st = 0; st < 4; ++st) qf[sub][st] = *(const bf16x8*)(qrow0 + (size_t)sub * 32 * LDH + 16 * st + 8 * hh);
    { const int key = tid >> 3, ch = tid & 7;
#pragma unroll
      for (int j = 0; j < 3; ++j) { int kp = t0 - 128 + 64 * j + key; kp = kp < 0 ? 0 : kp;
        const bf16_t* src = h + (tokb + kp) * LDH + C_KA + kvh * 64 + ch * 8;
        *(LAS u32x4*)(lds + j * 2 * TB + key * STR + ch * 16) = *(const u32x4*)src;
        *(LAS u32x4*)(lds + j * 2 * TB + TB + key * VST + ch * 16) = *(const u32x4*)(src + (C_VA - C_KA)); } }
    __syncthreads();
    const float sink2 = p->sinks[l * 16 + hq] * LOG2E;
#pragma unroll
    for (int sub = 0; sub < 2; ++sub) {
      float m = sink2, ls = 0.f;
      f32x16 o[2];
#pragma unroll
      for (int d = 0; d < 2; ++d)
#pragma unroll
        for (int rr = 0; rr < 16; ++rr) o[d][rr] = 0.f;
      const int qpos = t0 + 32 * sub + c;
#pragma unroll
      for (int j = 0; j < 3; ++j) { const int k0 = t0 - 128 + 64 * j;
        if (k0 + 63 >= 0 && k0 + 63 >= t0 + 32 * sub - 127 && k0 <= t0 + 32 * sub + 31)
          attn_tile<4, 2, STR, VST>(qf[sub], o, m, ls, lds + j * 2 * TB, lds + j * 2 * TB + TB, lane, qpos, k0, 128, true); }
      const float inv = frcp(ls + __shfl_xor(ls, 32) + fexp2(sink2 - m));
      bf16_t* qrow = qrow0 + (size_t)sub * 32 * LDH;
#pragma unroll
      for (int d = 0; d < 2; ++d)
#pragma unroll
        for (int g = 0; g < 4; ++g) { u32x2 w; w.x = pk2(o[d][4 * g] * inv, o[d][4 * g + 1] * inv); w.y = pk2(o[d][4 * g + 2] * inv, o[d][4 * g + 3] * inv);
          bf16_t* dst_ = dummy ? (bf16_t*)(p->ws + O_Q) + (tokb + t0 + 32 * sub + c) * 1024 + hq * 64 : qrow; *(u32x2*)(dst_ + 32 * d + 8 * g + 4 * hh) = w; }
    }
    __syncthreads();
  }
}

__device__ __forceinline__ void sgu_phase(KP p, int l, LAS unsigned char* lds, int wv0, int dummy = 0) {
  constexpr int STR = 272;
  bf16_t* h = (bf16_t*)(p->ws + O_H); const f32x4* st = (const f32x4*)(p->ws + O_ST);
  LAS unsigned char* Wl = lds; LAS unsigned char* Vl = lds + 128 * STR;
  const int tid = otid(wv0), wid = __builtin_amdgcn_readfirstlane(tid >> 6), lane = tid & 63, c = lane & 31, hh = lane >> 5;
  const int bid_ = obid(), grd_ = ogrid();
  for (int it = bid_; it < 1024; it += grd_) {
    const int cidx = it >> 3, g = it & 7, tb0 = cidx * 128;
    const float* wg = p->sgu_w + ((size_t)l * 8 + g) * 128 * 128;
#pragma unroll
    for (int i = 0; i < 8; ++i) { const int idx = tid + 512 * i, t = idx >> 5, s4 = (idx & 31) * 4;
      const f32x4 v = *(const f32x4*)(wg + t * 128 + s4);
      u32x2 w; w.x = pk2(s4 <= t ? v[0] : 0.f, s4 + 1 <= t ? v[1] : 0.f); w.y = pk2(s4 + 2 <= t ? v[2] : 0.f, s4 + 3 <= t ? v[3] : 0.f);
      *(LAS u32x2*)(Wl + t * STR + s4 * 2) = w; }
#pragma unroll
    for (int i = 0; i < 4; ++i) { const int cid = tid + 512 * i, s = cid >> 4, ch = cid & 15;
      const u32x4 hv = *(const u32x4*)(h + (size_t)(tb0 + s) * LDH + C_HV + g * 128 + ch * 8);
      const f32x4 sv = st[tb0 + s]; const float mu = sv.z, rstd = sv.w;
      const float* lg = p->sgu_ln_g + l * 1024 + g * 128 + ch * 8; const float* lb = p->sgu_ln_b + l * 1024 + g * 128 + ch * 8;
      const f32x4 g0 = *(const f32x4*)lg, g1 = *(const f32x4*)(lg + 4), b0 = *(const f32x4*)lb, b1 = *(const f32x4*)(lb + 4);
      u32x4 w;
      w.x = pk2((bf_lo(hv.x) - mu) * rstd * g0[0] + b0[0], (bf_hi(hv.x) - mu) * rstd * g0[1] + b0[1]);
      w.y = pk2((bf_lo(hv.y) - mu) * rstd * g0[2] + b0[2], (bf_hi(hv.y) - mu) * rstd * g0[3] + b0[3]);
      w.z = pk2((bf_lo(hv.z) - mu) * rstd * g1[0] + b1[0], (bf_hi(hv.z) - mu) * rstd * g1[1] + b1[1]);
      w.w = pk2((bf_lo(hv.w) - mu) * rstd * g1[2] + b1[2], (bf_hi(hv.w) - mu) * rstd * g1[3] + b1[3]);
      *(LAS u32x4*)(Vl + s * STR + ch * 16) = w; }
    __syncthreads();
    const int tblk = wid >> 1, cb0 = (wid & 1) * 2;
    f32x16 acc[2];
#pragma unroll
    for (int d = 0; d < 2; ++d)
#pragma unroll
      for (int r = 0; r < 16; ++r) acc[d][r] = 0.f;
    const int i16 = lane & 15, g16 = (lane >> 4) & 1;
    const LAS unsigned char* wa = Wl + (32 * tblk + c) * STR + hh * 16;
    const LAS unsigned char* va = Vl + (8 * hh + (i16 >> 2)) * STR + (32 * cb0 + 16 * g16 + 4 * (i16 & 3)) * 2;
#pragma unroll
    for (int s = 0; s < 8; ++s) {
      const bf16x8 a = *(const LAS bf16x8*)(wa + s * 32);
#pragma unroll
      for (int d = 0; d < 2; ++d) {
        const v4i16_t lo = vtr(va + (16 * s) * STR + d * 64);
        const v4i16_t hi = vtr(va + (16 * s + 4) * STR + d * 64);
        const bf16x8 bfr = __builtin_shufflevector(lo, hi, 0, 1, 2, 3, 4, 5, 6, 7);
        acc[d] = mfma32(a, bfr, acc[d]);
      }
    }
    const float* sb = p->sgu_b + ((size_t)l * 8 + g) * 128;
    float uu[2][16], sbv[16];
#pragma unroll
    for (int r = 0; r < 16; ++r) { const int t = 32 * tblk + (r & 3) + 8 * (r >> 2) + 4 * hh; sbv[r] = sb[t];
#pragma unroll
      for (int d = 0; d < 2; ++d) uu[d][r] = bf1(h[(size_t)(tb0 + t) * LDH + C_HU + g * 128 + 32 * (cb0 + d) + c]); }
    asm volatile("" ::: "memory");
#pragma unroll
    for (int d = 0; d < 2; ++d)
#pragma unroll
      for (int r = 0; r < 16; ++r) { const int t = 32 * tblk + (r & 3) + 8 * (r >> 2) + 4 * hh, cc = 32 * (cb0 + d) + c;
        bf16_t* up = h + (size_t)(tb0 + t) * LDH + C_HU + g * 128 + cc;
        const float y = uu[d][r] * (acc[d][r] + sbv[r]);
        bf16_t* dst_ = dummy ? (bf16_t*)p->out + (size_t)(tb0 + t) * 1024 + g * 128 + cc : up; *dst_ = (bf16_t)(pk2(y, 0.f) & 0xffffu); }
    __syncthreads();
  }
}

__device__ __forceinline__ void fixup_phase(KP p, int l, int wv0) {
  const bf16_t* side = (const bf16_t*)(p->ws + O_SIDE); bf16_t* act = (bf16_t*)(p->ws + O_ACT);
  const float* cw = p->conv_w + (size_t)l * 3 * NUP; const float* cb = p->conv_b + (size_t)l * NUP;
  const int ntask = 704 * 128;
  const int id0_ = obid() * 512 + otid(wv0), idst_ = ogrid() * 512;
  for (int id = id0_; id < ntask; id += idst_) {
    const int cgp = id % 704, rk = id / 704, k = rk >> 1, rr = rk & 1, c0 = cgp * 8, t = (k * 256 + rr) & (SEQ - 1);
    const bf16_t* s0p = side + ((size_t)k * 4 + rr) * NUP;
    const bf16_t* s1p = rr ? side + ((size_t)k * 4) * NUP : side + ((size_t)(k > 0 ? k - 1 : 0) * 4 + 3) * NUP;
    const bf16_t* s2p = side + ((size_t)(k > 0 ? k - 1 : 0) * 4 + (rr ? 3 : 2)) * NUP;
    const float m1 = (t >= 1) ? 1.f : 0.f, m2 = (t >= 2) ? 1.f : 0.f;
    float y[8];
#pragma unroll
    for (int hf = 0; hf < 2; ++hf) {
      const int c = c0 + 4 * hf;
      const u32x2 a0 = *(const u32x2*)(s0p + c), a1 = *(const u32x2*)(s1p + c), a2 = *(const u32x2*)(s2p + c);
      const u32x2 d0 = *(const u32x2*)(s0p + DFF + c), d1 = *(const u32x2*)(s1p + DFF + c), d2 = *(const u32x2*)(s2p + DFF + c);
      const f32x4 wg0 = *(const f32x4*)(cw + c), wg1 = *(const f32x4*)(cw + NUP + c), wg2 = *(const f32x4*)(cw + 2 * NUP + c), bg = *(const f32x4*)(cb + c);
      const f32x4 wv0_ = *(const f32x4*)(cw + DFF + c), wv1 = *(const f32x4*)(cw + NUP + DFF + c), wv2 = *(const f32x4*)(cw + 2 * NUP + DFF + c), bv = *(const f32x4*)(cb + DFF + c);
      const float g0[4] = {bf_lo(a0.x), bf_hi(a0.x), bf_lo(a0.y), bf_hi(a0.y)}, g1[4] = {bf_lo(a1.x), bf_hi(a1.x), bf_lo(a1.y), bf_hi(a1.y)}, g2[4] = {bf_lo(a2.x), bf_hi(a2.x), bf_lo(a2.y), bf_hi(a2.y)};
      const float v0[4] = {bf_lo(d0.x), bf_hi(d0.x), bf_lo(d0.y), bf_hi(d0.y)}, v1[4] = {bf_lo(d1.x), bf_hi(d1.x), bf_lo(d1.y), bf_hi(d1.y)}, v2[4] = {bf_lo(d2.x), bf_hi(d2.x), bf_lo(d2.y), bf_hi(d2.y)};
#pragma unroll
      for (int e = 0; e < 4; ++e) {
        const float cgv = bg[e] + wg0[e] * (g2[e] * m2) + wg1[e] * (g1[e] * m1) + wg2[e] * g0[e];
        const float cvv = bv[e] + wv0_[e] * (v2[e] * m2) + wv1[e] * (v1[e] * m1) + wv2[e] * v0[e];
        y[4 * hf + e] = silu_mul(cgv, cvv);
      }
    }
    store8bf(act + (size_t)(k * 256 + rr) * DFF + c0, y);
  }
}

#define XB_TMO      128
#define XB_XCNT(j)  (256  + 64 * (j))
#define XB_XSUB(j)  (1280 + 64 * (j))
#define XB_XGEN(j)  (2304 + 64 * (j))
#define XB_TOP      3328
#define XB_TOPGEN   3392
#define XCD_BAR_WORDS 3456
#define XB_SPIN_CAP (1u << 20)
__device__ __forceinline__ unsigned xb_ld(unsigned* p)              { return __hip_atomic_load(p, __ATOMIC_RELAXED, __HIP_MEMORY_SCOPE_AGENT); }
__device__ __forceinline__ unsigned xb_add(unsigned* p, unsigned v) { return __hip_atomic_fetch_add(p, v, __ATOMIC_RELAXED, __HIP_MEMORY_SCOPE_AGENT); }
__device__ __forceinline__ unsigned xb_xcc_id() { return (unsigned)__builtin_amdgcn_s_getreg((3 << 11) | 20) & 0xFu; }
#define XB_SPIN(cond, bar) do { unsigned _sp = 0; while (cond) { __builtin_amdgcn_s_sleep(1); \
    if ((++_sp & 255u) == 0u) { if (xb_ld(&(bar)[XB_TMO])) break; if (_sp > XB_SPIN_CAP) { atomicAdd(&(bar)[XB_TMO], 1u); break; } } } } while (0)
__device__ __forceinline__ void xcd_barrier_complete(unsigned* bar, unsigned x, unsigned& nloc, unsigned& nx) {
    const unsigned G = gridDim.x * gridDim.y * gridDim.z;
    unsigned sum, cnt, mine, sp = 0u;
    for (;;) {
        sum = 0u; cnt = 0u; mine = 0u;
#pragma unroll
        for (unsigned j = 0; j < 16; ++j) { const unsigned c = xb_ld(&bar[XB_XCNT(j)]); sum += c; cnt += (c > 0u) ? 1u : 0u; mine = (j == x) ? c : mine; }
        if (sum == G) break;
        __builtin_amdgcn_s_sleep(1);
        if ((++sp & 255u) == 0u) { if (xb_ld(&bar[XB_TMO])) break; if (sp > XB_SPIN_CAP) { atomicAdd(&bar[XB_TMO], 1u); break; } }
    }
    nloc = mine > 0u ? mine : 1u; nx = cnt > 0u ? cnt : 1u;
}
__device__ __forceinline__ void xcd_barrier(unsigned* bar, volatile LAS unsigned* st, int wv0) {
    asm volatile("s_waitcnt vmcnt(0)" ::: "memory");
    __syncthreads();
    if (otid(wv0) == 0) {
        const unsigned x = xb_xcc_id();
        __builtin_amdgcn_s_waitcnt(0);
        unsigned nloc = st[0], nx = st[1];
        if (nloc == 0u) { xcd_barrier_complete(bar, x, nloc, nx); st[0] = nloc; st[1] = nx; }
        const unsigned old = xb_add(&bar[XB_XSUB(x)], 1u);
        const unsigned gen = old / nloc;
        if (old + 1u == (gen + 1u) * nloc) {
            __builtin_amdgcn_fence(__ATOMIC_RELEASE, "agent");
            asm volatile("s_waitcnt vmcnt(0)" ::: "memory");
            const unsigned og = xb_add(&bar[XB_TOP], 1u);
            const unsigned tg = og / nx;
            if (og + 1u == (tg + 1u) * nx) xb_add(&bar[XB_TOPGEN], 1u);
            else XB_SPIN(xb_ld(&bar[XB_TOPGEN]) == tg, bar);
            __builtin_amdgcn_fence(__ATOMIC_ACQUIRE, "agent");
            xb_add(&bar[XB_XGEN(x)], 1u);
            asm volatile("s_waitcnt vmcnt(0)" ::: "memory");
        } else {
            XB_SPIN(xb_ld(&bar[XB_XGEN(x)]) == gen, bar);
            __builtin_amdgcn_fence(__ATOMIC_ACQUIRE, "agent");
            asm volatile("s_waitcnt vmcnt(0)" ::: "memory");
        }
    }
    __syncthreads();
}
#define GSYNC() xcd_barrier((unsigned*)(p->ws + O_BAR), (volatile LAS unsigned*)((LAS unsigned char*)shm + 131072), wv0)

#ifndef PH_MASK
#define PH_MASK 0xFFFFF
#endif
#ifndef REP_MASK
#define REP_MASK 0
#endif
#define PH(b) for (int rep_ = 0, nrep_ = (int)(((PH_MASK >> (b)) & 1) + ((REP_MASK >> (b)) & 1)); rep_ < nrep_; ++rep_)
#define LAUNDER() do { asm volatile("" : "+s"(p), "+s"(l), "+s"(wv0) :: "memory"); ws = p->ws; xb = (bf16_t*)(ws + O_XB); xa = (float*)(ws + O_XA); hbuf = (bf16_t*)(ws + O_H); qbuf = (bf16_t*)(ws + O_Q); kvbuf = (bf16_t*)(ws + O_KV); gbuf = qbuf; mb = xb; cs = (const float*)(ws + O_CS); st = (const float*)(ws + O_ST); } while (0)
__global__ void __launch_bounds__(512, 2) mega(Params p_unused) {
  KP p = (KP)__builtin_amdgcn_kernarg_segment_ptr();
  int wv0 = __builtin_amdgcn_readfirstlane((int)threadIdx.x >> 6);
  extern __shared__ __attribute__((aligned(16))) unsigned char shm[];
  LAS unsigned char* lds = (LAS unsigned char*)shm;
  cg::grid_group grid = cg::this_grid();
  unsigned char* ws;
  bf16_t* xb; float* xa; bf16_t* hbuf; bf16_t* qbuf; bf16_t* kvbuf;
  bf16_t* gbuf;
  bf16_t* mb;
  const float* cs; const float* st; int l = 0;
  LAUNDER();

  if (otid(wv0) == 0) { volatile LAS unsigned* bst = (volatile LAS unsigned*)(lds + 131072); bst[0] = 0u; bst[1] = 0u; }
  { unsigned* bar0 = (unsigned*)(p->ws + O_BAR); for (int i = obid() * 512 + otid(wv0); i < XCD_BAR_WORDS; i += ogrid() * 512) bar0[i] = 0u; }
  PH(0) cvt_mixer_a(p, 0, lds, wv0);
  PH(1) prologue(p, wv0);
  grid.sync(); LAUNDER();
  if (otid(wv0) == 0) (void)xb_add((unsigned*)(ws + O_BAR) + XB_XCNT(xb_xcc_id()), 1u);
  for (l = 0; l < 2; ++l) {
    LAUNDER();
    PH(2) { EpiP e{}; e.out = hbuf; e.f0 = cs; run_gemm<E_MAIN>(lds, xb, DM, (const bf16_t*)(ws + O_WMAIN), NTOK, NHP, DM, e, wv0); }
    PH(18) { const int G_ = ogrid(), b_ = obid(), extra = ((NTOK / 256) * (NHP / 256)) % G_;
      cvt_mixer_b(p, l, lds, wv0, extra ? b_ - extra : b_, extra ? G_ - extra : G_); }
    GSYNC(); LAUNDER();
    PH(3) stats_phase(p, wv0);
    PH(4) swa_phase(p, l, lds, wv0, rep_ + 1 < nrep_);
    GSYNC(); LAUNDER();
    PH(5) { EpiP e{}; e.out = qbuf; e.f0 = st; e.facc = (float*)cs; run_gemm<E_UQ>(lds, hbuf + C_CQ, LDH, (const bf16_t*)(ws + O_WUQ), NTOK, NQ, 512, e, wv0); }
    PH(6) { EpiP e{}; e.out = kvbuf; e.f0 = st; run_gemm<E_UKV>(lds, hbuf + C_CKV, LDH, (const bf16_t*)(ws + O_WUKV), NTOK, NKV, 512, e, wv0); }
    PH(7) sgu_phase(p, l, lds, wv0, rep_ + 1 < nrep_);
    GSYNC(); LAUNDER();
    PH(8) mla_phase(p, lds, wv0);
    GSYNC(); LAUNDER();
    PH(9) { EpiP e{}; e.out = gbuf; e.f0 = p->b_gate + (size_t)l * NG; run_gemm<E_GATE>(lds, xb, DM, (const bf16_t*)(ws + O_WG), NTOK, NG, DM, e, wv0); }
    GSYNC(); LAUNDER();
    PH(10) { EpiP e{}; e.out = mb; e.b0 = gbuf; e.facc = p->out; e.aux = 0; run_gemm<E_PROJ>(lds, hbuf + C_QA, LDH, (const bf16_t*)(ws + O_PA), NTOK, DM, 1024, e, wv0); }
    PH(10) { EpiP e{}; e.out = mb; e.b0 = gbuf; e.facc = p->out; e.aux = 1; run_gemm<E_PROJ>(lds, hbuf + C_CQ, LDH, (const bf16_t*)(ws + O_PB), NTOK, DM, 2048, e, wv0); }
    PH(10) { EpiP e{}; e.out = mb; e.b0 = gbuf; e.facc = p->out; e.aux = 2; run_gemm<E_PROJ>(lds, hbuf + C_HU, LDH, (const bf16_t*)(ws + O_PC), NTOK, DM, 1024, e, wv0); }
    GSYNC(); LAUNDER();
    PH(11) { EpiP e{}; e.out = xa; e.f0 = (l == 0) ? p->x : xa; run_gemm<E_RES>(lds, mb, DM, (const bf16_t*)(ws + O_WO), NTOK, DM, DM, e, wv0); }
    GSYNC(); LAUNDER();
    PH(12) ln_phase(xa, xa, xb, p->ln1_g + l * DM, p->ln1_b + l * DM, wv0);
    PH(13) cvt_ffn(p, l, lds, wv0);
    GSYNC(); LAUNDER();
    PH(14) { EpiP e{}; e.out = ws + O_ACT; e.b0 = (const bf16_t*)(ws + O_SIDE); e.f0 = p->conv_w + (size_t)l * 3 * NUP; e.f1 = p->conv_b + (size_t)l * NUP; e.ex = lds + 131072 + 64;
      run_gemm<E_UPC>(lds, xb, DM, (const bf16_t*)(ws + O_WUP), NTOK, NUP, DM, e, wv0); }
    GSYNC(); LAUNDER();
    PH(15) fixup_phase(p, l, wv0);
    GSYNC(); LAUNDER();
    PH(16) { EpiP e{}; e.out = xa; e.f0 = xa; run_gemm<E_RES>(lds, (const bf16_t*)(ws + O_ACT), DFF, (const bf16_t*)(ws + O_WDN), NTOK, DM, DFF, e, wv0); }
    GSYNC(); LAUNDER();
    PH(17) ln_phase(xa, (l == 1) ? p->out : xa, (l == 1) ? nullptr : xb, p->ln2_g + l * DM, p->ln2_b + l * DM, wv0);
    if (l == 0) { PH(0) cvt_mixer_a(p, 1, lds, wv0); GSYNC(); }
  }
}

extern "C" void kernel_launch(void* const* d_in, const int* in_sizes, int n_in, void* d_out, int out_size, void* d_ws, size_t ws_size, hipStream_t stream) {
  constexpr size_t kDynLds = 131072 + 64 + 16384;
  static int grid_blocks = 0;
  if (!grid_blocks) {
    (void)hipFuncSetAttribute((const void*)mega, hipFuncAttributeMaxDynamicSharedMemorySize, (int)kDynLds);
    int dev = 0, cus = 0, per_cu = 0;
    (void)hipGetDevice(&dev);
    (void)hipDeviceGetAttribute(&cus, hipDeviceAttributeMultiprocessorCount, dev);
    (void)hipOccupancyMaxActiveBlocksPerMultiprocessor(&per_cu, mega, 512, kDynLds);
    if (per_cu > 1) per_cu = 1;
    if (per_cu < 1) per_cu = 1;
    grid_blocks = cus * per_cu;
  }
  if (ws_size < WS_NEED) { fprintf(stderr, "workspace too small: %zu < %zu\n", ws_size, (size_t)WS_NEED); return; }
  Params p{};
  p.x = (const float*)d_in[0]; p.pos = (const int*)d_in[1]; p.w_in = (const float*)d_in[2]; p.b_gate = (const float*)d_in[3]; p.sinks = (const float*)d_in[4];
  p.q_norm_g = (const float*)d_in[5]; p.kv_norm_g = (const float*)d_in[6]; p.w_uq = (const float*)d_in[7]; p.w_ukv = (const float*)d_in[8];
  p.sgu_ln_g = (const float*)d_in[9]; p.sgu_ln_b = (const float*)d_in[10]; p.sgu_w = (const float*)d_in[11]; p.sgu_b = (const float*)d_in[12];
  p.w_proj_a = (const float*)d_in[13]; p.w_proj_b = (const float*)d_in[14]; p.w_proj_c = (const float*)d_in[15]; p.w_o = (const float*)d_in[16];
  p.ln1_g = (const float*)d_in[17]; p.ln1_b = (const float*)d_in[18]; p.w_up = (const float*)d_in[19]; p.conv_w = (const float*)d_in[20]; p.conv_b = (const float*)d_in[21];
  p.w_down = (const float*)d_in[22]; p.ln2_g = (const float*)d_in[23]; p.ln2_b = (const float*)d_in[24];
  p.out = (float*)d_out; p.ws = (unsigned char*)d_ws;
  void* args[] = {&p};
  hipError_t e = hipLaunchCooperativeKernel((void*)mega, dim3(grid_blocks), dim3(512), args, kDynLds, stream);
  if (e != hipSuccess) fprintf(stderr, "cooperative launch failed: %s (grid %d)\n", hipGetErrorString(e), grid_blocks);
}
```

```cpp
#include <hip/hip_runtime.h>
#include <hip/hip_cooperative_groups.h>
#include <cstdio>
namespace cg = cooperative_groups;

#define LAS __attribute__((address_space(3)))
typedef unsigned short bf16_t;
typedef short bf16x8 __attribute__((ext_vector_type(8)));
typedef short v4i16_t __attribute__((ext_vector_type(4)));
typedef float f32x4 __attribute__((ext_vector_type(4)));
typedef float f32x2 __attribute__((ext_vector_type(2)));
typedef float f32x16 __attribute__((ext_vector_type(16)));
typedef unsigned u32x4 __attribute__((ext_vector_type(4)));
typedef unsigned u32x2 __attribute__((ext_vector_type(2)));

constexpr int NTOK = 16384, SEQ = 4096, DM = 2048;
constexpr int LDH = 4416, NHP = 4608;
constexpr int C_QA = 0, C_KA = 1024, C_VA = 1152, C_KR = 1280, C_HU = 1344, C_CQ = 2368, C_CKV = 2880, C_HV = 3392;
constexpr int NG = 6144, NQ = 3072, NKV = 4096, NUP = 11264, DFF = 5632, NIN = 10560;
constexpr float LOG2E = 1.4426950408889634f;
constexpr float ALPHA = 1.4142135623730951f;
constexpr float EPS = 1e-5f;
constexpr float SWA_QSCALE = 0.125f * LOG2E;
constexpr float MLA_QSCALE = 0.07216878364870322f * LOG2E;

__device__ const float INV_FREQ[32] = {1.000000000e+00f, 7.498942018e-01f, 5.623413324e-01f, 4.216965139e-01f, 3.162277639e-01f, 2.371373773e-01f, 1.778279394e-01f, 1.333521456e-01f, 1.000000015e-01f, 7.498942316e-02f, 5.623413250e-02f, 4.216964915e-02f, 3.162277490e-02f, 2.371373773e-02f, 1.778279431e-02f, 1.333521400e-02f, 9.999999776e-03f, 7.498942316e-03f, 5.623413250e-03f, 4.216964822e-03f, 3.162277630e-03f, 2.371373819e-03f, 1.778279431e-03f, 1.333521446e-03f, 1.000000047e-03f, 7.498941850e-04f, 5.623413017e-04f, 4.216965172e-04f, 3.162277571e-04f, 2.371373703e-04f, 1.778279402e-04f, 1.333521504e-04f};

constexpr size_t SZ_W = 76546048;
constexpr size_t O_WMAIN = 0, O_WG = 18874368, O_WUQ = O_WG + 25165824, O_WUKV = O_WUQ + 3145728, O_PA = O_WUKV + 4194304, O_PB = O_PA + 4194304, O_PC = O_PB + 8388608, O_WO = O_PC + 4194304;
constexpr size_t O_WUP = 0, O_WDN = 46137344;
constexpr size_t O_XB = SZ_W;
constexpr size_t O_XA = O_XB + 67108864;
constexpr size_t O_BIG = O_XA + 134217728;
constexpr size_t O_H = O_BIG, O_Q = O_H + 144703488, O_KV = O_Q + 100663296;
constexpr size_t O_ACT = O_BIG, O_SIDE = O_BIG + 184549376;
constexpr size_t O_CS = O_BIG + 379584512;
constexpr size_t O_ST = O_CS + 4194304;
constexpr size_t O_BAR = O_ST + 262144;
constexpr size_t WS_NEED = O_BAR + 16384;

struct Params {
  const float* x; const int* pos; const float* w_in; const float* b_gate; const float* sinks; const float* q_norm_g; const float* kv_norm_g;
  const float* w_uq; const float* w_ukv; const float* sgu_ln_g; const float* sgu_ln_b; const float* sgu_w; const float* sgu_b;
  const float* w_proj_a; const float* w_proj_b; const float* w_proj_c; const float* w_o; const float* ln1_g; const float* ln1_b;
  const float* w_up; const float* conv_w; const float* conv_b; const float* w_down; const float* ln2_g; const float* ln2_b;
  float* out; unsigned char* ws;
};

typedef const Params __attribute__((address_space(4)))* KP;
__device__ __forceinline__ int olane() { unsigned m = ~0u; asm volatile("" : "+s"(m)); return (int)__builtin_amdgcn_mbcnt_hi(m, __builtin_amdgcn_mbcnt_lo(m, 0u)); }
__device__ __forceinline__ int otid(int wv0) { int t = (wv0 << 6) | olane(); asm volatile("" : "+v"(t)); return t; }
__device__ __forceinline__ int obid() { int b = blockIdx.x; asm volatile("" : "+s"(b)); return b; }
__device__ __forceinline__ int ogrid() { int g = gridDim.x; asm volatile("" : "+s"(g)); return g; }
__device__ __forceinline__ unsigned pk2(float lo, float hi) {
  typedef __bf16 b2 __attribute__((ext_vector_type(2)));
  b2 r = __builtin_convertvector((f32x2){lo, hi}, b2);
  return __builtin_bit_cast(unsigned, r);
}
__device__ __forceinline__ float bf_lo(unsigned u) { return __uint_as_float(u << 16); }
__device__ __forceinline__ float bf_hi(unsigned u) { return __uint_as_float(u & 0xffff0000u); }
__device__ __forceinline__ float bf1(bf16_t u) { return __uint_as_float(((unsigned)u) << 16); }
__device__ __forceinline__ float fexp2(float x) { return __builtin_amdgcn_exp2f(x); }
__device__ __forceinline__ float frcp(float x) { return __builtin_amdgcn_rcpf(x); }
__device__ __forceinline__ float wave_sum(float v) {
#pragma unroll
  for (int o = 32; o > 0; o >>= 1) v += __shfl_xor(v, o);
  return v;
}
__device__ __forceinline__ float gelu1(float v) {
  const float av = __builtin_fabsf(v), d = av * 0.2316418882f + 1.0f;
  const float t = frcp(d);
  float q = t * 0.5307027145f + (-0.7265760135f); q = q * t + 0.7107068705f; q = q * t + (-0.142248368f); q = q * t + 0.127414796f; q = q * t;
  const float s = (v * v) * (-0.72134752044f);
  const float e = fexp2(s);
  const float m = v * (q * e), r = v - m;
  return v < 0.f ? m : r;
}
__device__ __forceinline__ f32x16 mfma32(bf16x8 a, bf16x8 b, f32x16 c) { return __builtin_amdgcn_mfma_f32_32x32x16_bf16(a, b, c, 0, 0, 0); }
__device__ __forceinline__ v4i16_t vtr(const LAS unsigned char* p) { return __builtin_amdgcn_ds_read_tr16_b64_v4i16((LAS v4i16_t*)p); }

namespace pg8 {
constexpr int BM = 256, BK = 64, HALF = 128, HTB = HALF * BK * 2, STAGE_BYTES = 8 * HTB, NXCD = 8, WGM = 8;
__device__ __forceinline__ int lds_byte(int r, int c) { const int st = (r >> 4) * 2 + (c >> 5), rr = r & 15, cc = c & 31, ob = rr * 64 + cc * 2; return st * 1024 + (ob ^ (((ob >> 9) & 1) << 5)); }
__device__ __forceinline__ void stage_rc(int b, int& R, int& C) { const int st = b / 1024, sb = b % 1024, swz = sb ^ (((sb >> 9) & 1) << 5); R = (st >> 1) * 16 + swz / 64; C = (st & 1) * 32 + (swz % 64) / 2; }
__device__ __forceinline__ int perm32(int rho) { const int n = rho >> 4, i = rho & 15; return 8 * (i >> 2) + 4 * n + (i & 3); }
struct Unit { int pm, pn; };
struct Gemm { const bf16_t* A; const bf16_t* Bt; int M, N, K, lda; };
struct StaticOrder {
  int nM, nN, nwg, G, c;
  __device__ void init(int M, int N, int G_, int c_) { nM = M / BM; nN = N / BM; nwg = nM * nN; G = G_; c = c_; }
  __device__ bool next(int i, Unit& u) const {
    const long L = (long)i * G + c; if (L >= nwg) return false;
    int wgid = (int)L; { const int q = nwg / NXCD, r = nwg % NXCD, xcd = wgid % NXCD, off = wgid / NXCD; wgid = (xcd < r ? xcd * (q + 1) : r * (q + 1) + (xcd - r) * q) + off; }
    const int nig = WGM * nN, gid = wgid / nig, fm = gid * WGM, gsz = (nM - fm) < WGM ? (nM - fm) : WGM;
    u.pm = fm + ((wgid % nig) % gsz); u.pn = (wgid % nig) / gsz; return true;
  }
};

template <class Epi>
__device__ __forceinline__ void gemm_phase(LAS unsigned char* lds, const Gemm g, const StaticOrder& S, const Epi& E, int wv0) {
  const int tid = otid(wv0), wid = __builtin_amdgcn_readfirstlane(tid >> 6), lane = tid & 63, wr = wid >> 2, wc = wid & 3, fr = lane & 15, fq = lane >> 4;
  const int K = g.K, nt = K / BK, lda = g.lda;
  unsigned voffA[2], voffB[2];
#pragma unroll
  for (int i = 0; i < 2; ++i) { int R, C; stage_rc(tid * 16 + i * 8192, R, C); const int Rb = (R & ~31) + perm32(R & 31);
    voffA[i] = (unsigned)(R * lda + C) * 2u; voffB[i] = (unsigned)(Rb * K + C) * 2u; }
  const size_t kstep = (size_t)(BK * 2);
  const size_t hstepA = (size_t)HALF * lda * 2, hstepB = (size_t)HALF * K * 2;
  const size_t tstepA = 2 * hstepA, tstepB = 2 * hstepB;
  const unsigned ldsw = (unsigned)wid * 1024u;
  const int aoff = lds_byte(wr * 64 + fr, fq * 8), boff = lds_byte(wc * 32 + fr, fq * 8);
#define PG8_SA(b, h) (((b) * 2 + (h)) * HTB)
#define PG8_SB(b, h) ((4 + (b) * 2 + (h)) * HTB)
#define PG8_STAGE(bufoff, gbase, voff) do { _Pragma("unroll") for (int _i = 0; _i < 2; ++_i) \
    __builtin_amdgcn_global_load_lds((const unsigned*)((const char*)(gbase) + (voff)[_i]), (LAS unsigned*)(lds + (bufoff) + ldsw + _i * 8192), 16, 0, 0); } while (0)
#define PG8_LDA(dst, b, h) do { _Pragma("unroll") for (int m = 0; m < 4; ++m) _Pragma("unroll") for (int k = 0; k < 2; ++k) dst[m][k] = *(const LAS bf16x8*)(lds + PG8_SA(b, h) + aoff + m * 2048 + k * 1024); } while (0)
#define PG8_LDB(dst, b, h) do { _Pragma("unroll") for (int n = 0; n < 2; ++n) _Pragma("unroll") for (int k = 0; k < 2; ++k) dst[n][k] = *(const LAS bf16x8*)(lds + PG8_SB(b, h) + boff + n * 2048 + k * 1024); } while (0)
#define PG8_MMA(ai, bj, At, Bt) do { __builtin_amdgcn_s_setprio(1); _Pragma("unroll") for (int m = 0; m < 4; ++m) _Pragma("unroll") for (int n = 0; n < 2; ++n) _Pragma("unroll") for (int k = 0; k < 2; ++k) \
    acc[ai][bj][m][n] = __builtin_amdgcn_mfma_f32_16x16x32_bf16(Bt[n][k], At[m][k], acc[ai][bj][m][n], 0, 0, 0); __builtin_amdgcn_s_setprio(0); } while (0)
#define PG8_WAIT_V(n) asm volatile("s_waitcnt vmcnt(" #n ")" ::: "memory")
#define PG8_WAIT_L(n) asm volatile("s_waitcnt lgkmcnt(" #n ")" ::: "memory")
#define PG8_BAR __builtin_amdgcn_s_barrier()
#define PG8_SCHED __builtin_amdgcn_sched_barrier(0)
  Unit cur, nxt; int ui = 0;
  if (!S.next(0, cur)) return;
  f32x4 acc[2][2][4][2];
#pragma unroll
  for (int a = 0; a < 2; ++a)
#pragma unroll
    for (int b = 0; b < 2; ++b)
#pragma unroll
      for (int m = 0; m < 4; ++m)
#pragma unroll
        for (int n = 0; n < 2; ++n) acc[a][b][m][n] = (f32x4){0.f, 0.f, 0.f, 0.f};
  bf16x8 At[4][2], B0[2][2], B1[2][2];
  const char* cA = (const char*)g.A + (size_t)cur.pm * tstepA; const char* cB = (const char*)g.Bt + (size_t)cur.pn * tstepB;
  PG8_STAGE(PG8_SB(0, 0), cB, voffB); PG8_STAGE(PG8_SA(0, 0), cA, voffA); PG8_STAGE(PG8_SB(0, 1), cB + hstepB, voffB); PG8_STAGE(PG8_SA(0, 1), cA + hstepA, voffA);
  if (wr == 1) PG8_BAR;
  PG8_WAIT_V(4); PG8_BAR;
  PG8_STAGE(PG8_SB(1, 0), cB + kstep, voffB); PG8_STAGE(PG8_SA(1, 0), cA + kstep, voffA); PG8_STAGE(PG8_SB(1, 1), cB + hstepB + kstep, voffB);
  PG8_WAIT_V(6); PG8_BAR;
  for (;;) {
    const bool has_next = S.next(ui + 1, nxt);
    const char* nA = has_next ? (const char*)g.A + (size_t)nxt.pm * tstepA : cA; const char* nB = has_next ? (const char*)g.Bt + (size_t)nxt.pn * tstepB : cB;
    for (int t = 0; t < nt; t += 2) {
      const bool last = (t == nt - 2);
      const char* a1 = cA + (size_t)(t + 1) * kstep;
      const char* a2 = last ? nA : cA + (size_t)(t + 2) * kstep; const char* b2 = last ? nB : cB + (size_t)(t + 2) * kstep;
      const char* a3 = a2 + kstep; const char* b3 = b2 + kstep;
      PG8_LDB(B0, 0, 0); PG8_SCHED; PG8_LDA(At, 0, 0); PG8_STAGE(PG8_SA(1, 1), a1 + hstepA, voffA);
      PG8_WAIT_L(8); PG8_BAR; PG8_WAIT_L(0); PG8_MMA(0, 0, At, B0); PG8_BAR; PG8_SCHED;
      PG8_LDB(B1, 0, 1); PG8_STAGE(PG8_SB(0, 0), b2, voffB);
      PG8_BAR; PG8_WAIT_L(0); PG8_MMA(0, 1, At, B1); PG8_BAR;
      PG8_LDA(At, 0, 1); PG8_STAGE(PG8_SA(0, 0), a2, voffA);
      PG8_BAR; PG8_WAIT_L(0); PG8_MMA(1, 0, At, B0); PG8_BAR; PG8_SCHED;
      PG8_STAGE(PG8_SB(0, 1), b2 + hstepB, voffB);
      PG8_WAIT_V(6); PG8_BAR; PG8_MMA(1, 1, At, B1); PG8_BAR;
      PG8_LDB(B0, 1, 0); PG8_SCHED; PG8_LDA(At, 1, 0); PG8_STAGE(PG8_SA(0, 1), a2 + hstepA, voffA);
      PG8_WAIT_L(8); PG8_BAR; PG8_WAIT_L(0); PG8_MMA(0, 0, At, B0); PG8_BAR; PG8_SCHED;
      PG8_LDB(B1, 1, 1); PG8_STAGE(PG8_SB(1, 0), b3, voffB);
      PG8_BAR; PG8_WAIT_L(0); PG8_MMA(0, 1, At, B1); PG8_BAR;
      PG8_LDA(At, 1, 1); PG8_STAGE(PG8_SA(1, 0), a3, voffA);
      PG8_BAR; PG8_WAIT_L(0); PG8_MMA(1, 0, At, B0); PG8_BAR; PG8_SCHED;
      PG8_STAGE(PG8_SB(1, 1), b3 + hstepB, voffB);
      PG8_WAIT_V(6); PG8_BAR; PG8_MMA(1, 1, At, B1); PG8_BAR;
    }
    E(acc, cur, wr, wc, fr, fq);
    if (!has_next) break;
#pragma unroll
    for (int a = 0; a < 2; ++a)
#pragma unroll
      for (int b = 0; b < 2; ++b)
#pragma unroll
        for (int m = 0; m < 4; ++m)
#pragma unroll
          for (int n = 0; n < 2; ++n) acc[a][b][m][n] = (f32x4){0.f, 0.f, 0.f, 0.f};
    cur = nxt; cA = nA; cB = nB; ++ui;
  }
  PG8_WAIT_V(0);
  if (wr == 0) PG8_BAR;
  PG8_BAR;
#undef PG8_SA
#undef PG8_SB
#undef PG8_STAGE
#undef PG8_LDA
#undef PG8_LDB
#undef PG8_MMA
#undef PG8_WAIT_V
#undef PG8_WAIT_L
#undef PG8_BAR
#undef PG8_SCHED
}
}

struct EpiP { void* out; int ldo; const float* f0; const bf16_t* b0; float* facc; int aux; const float* f1; LAS unsigned char* ex; };
enum { E_MAIN = 0, E_GATE = 1, E_UQ = 2, E_UKV = 3, E_PROJ = 4, E_RES = 5, E_UP = 6, E_UPC = 7 };

__device__ __forceinline__ void rope8(float (&v)[8], const f32x2* cs) {
#pragma unroll
  for (int i = 0; i < 4; ++i) { const f32x2 c = cs[i]; const float x1 = v[2 * i], x2 = v[2 * i + 1]; v[2 * i] = x1 * c.x - x2 * c.y; v[2 * i + 1] = x2 * c.x + x1 * c.y; }
}
__device__ __forceinline__ void store8bf(bf16_t* dst, const float (&v)[8]) {
  u32x4 w; w.x = pk2(v[0], v[1]); w.y = pk2(v[2], v[3]); w.z = pk2(v[4], v[5]); w.w = pk2(v[6], v[7]);
  *(u32x4*)dst = w;
}


__device__ __forceinline__ float dpp_shr1(float x) { return __int_as_float(__builtin_amdgcn_update_dpp(0, __float_as_int(x), 0x111, 0xF, 0xF, true)); }
__device__ __forceinline__ float dpp_shr2(float x) { return __int_as_float(__builtin_amdgcn_update_dpp(0, __float_as_int(x), 0x112, 0xF, 0xF, true)); }
__device__ __forceinline__ float dpp_prev1(float prev, float cur) {
  const int t = __builtin_amdgcn_update_dpp(0, __float_as_int(prev), 0x121, 0xF, 0xF, false);
  return __int_as_float(__builtin_amdgcn_update_dpp(t, __float_as_int(cur), 0x111, 0xF, 0xF, false)); }
__device__ __forceinline__ float dpp_prev2(float prev, float cur) {
  const int t = __builtin_amdgcn_update_dpp(0, __float_as_int(prev), 0x122, 0xF, 0xF, false);
  return __int_as_float(__builtin_amdgcn_update_dpp(t, __float_as_int(cur), 0x112, 0xF, 0xF, false)); }
__device__ __forceinline__ float silu_mul(float g, float v) { return g * frcp(1.0f + fexp2(-g * LOG2E)) * v; }
__device__ __forceinline__ void epi_upc(const EpiP& e, const f32x4 (&acc)[2][2][4][2], const pg8::Unit& u, int wr, int wc, int fr, int fq) {
  LAS unsigned char* ex = e.ex;
  bf16_t* side = (bf16_t*)e.b0;
  const int lc0 = 32 * wc + 8 * fq;
#pragma unroll
  for (int ai = 0; ai < 2; ++ai)
#pragma unroll
    for (int m = 0; m < 4; ++m) {
      const int g = ai * 8 + wr * 4 + m;
#pragma unroll
      for (int bj = 0; bj < 2; ++bj) {
        u32x4 w; w.x = pk2(acc[ai][bj][m][0][0], acc[ai][bj][m][0][1]); w.y = pk2(acc[ai][bj][m][0][2], acc[ai][bj][m][0][3]);
        w.z = pk2(acc[ai][bj][m][1][0], acc[ai][bj][m][1][1]); w.w = pk2(acc[ai][bj][m][1][2], acc[ai][bj][m][1][3]);
        if (m == 3 && fr >= 14) *(LAS u32x4*)(ex + ((g * 2 + (fr - 14)) * 256 + bj * 128 + lc0) * 2) = w;
        const int ucol = bj * DFF + 128 * u.pn + lc0;
        if (g == 15 && fr >= 14) *(u32x4*)(side + ((size_t)u.pm * 4 + 2 + (fr - 14)) * NUP + ucol) = w;
        if (g == 0 && fr < 2) *(u32x4*)(side + ((size_t)u.pm * 4 + fr) * NUP + ucol) = w;
      }
    }
  asm volatile("s_waitcnt lgkmcnt(0)" ::: "memory");
  __builtin_amdgcn_s_barrier();
  __builtin_amdgcn_s_barrier();
  asm volatile("" ::: "memory");
  const float* cw = e.f0; const float* cb = e.f1;
  bf16_t* act = (bf16_t*)e.out;
#pragma unroll
  for (int n = 0; n < 2; ++n) {
    const int ch = 128 * u.pn + lc0 + 4 * n;
    const f32x4 wg0 = *(const f32x4*)(cw + ch), wg1 = *(const f32x4*)(cw + NUP + ch), wg2 = *(const f32x4*)(cw + 2 * NUP + ch), bg = *(const f32x4*)(cb + ch);
    const f32x4 wv0 = *(const f32x4*)(cw + DFF + ch), wv1 = *(const f32x4*)(cw + NUP + DFF + ch), wv2 = *(const f32x4*)(cw + 2 * NUP + DFF + ch), bv = *(const f32x4*)(cb + DFF + ch);
#pragma unroll
    for (int ai = 0; ai < 2; ++ai)
#pragma unroll
      for (int m = 0; m < 4; ++m) {
        const int g = ai * 8 + wr * 4 + m, gp = g > 0 ? g - 1 : 0;
        const f32x4 xg = acc[ai][0][m][n], xv = acc[ai][1][m][n];
        float y[4];
        if (m > 0) {
          const f32x4 pg = acc[ai][0][m - 1][n], pv = acc[ai][1][m - 1][n];
#pragma unroll
          for (int k = 0; k < 4; ++k) {
            const float g1 = dpp_prev1(pg[k], xg[k]), g2 = dpp_prev2(pg[k], xg[k]), v1 = dpp_prev1(pv[k], xv[k]), v2 = dpp_prev2(pv[k], xv[k]);
            const float cg = bg[k] + wg0[k] * g2 + wg1[k] * g1 + wg2[k] * xg[k];
            const float cv = bv[k] + wv0[k] * v2 + wv1[k] * v1 + wv2[k] * xv[k];
            y[k] = silu_mul(cg, cv);
          }
        } else {
          const LAS unsigned char* hp = ex + (gp * 2 * 256 + lc0 + 4 * n) * 2;
          const u32x2 hg14 = *(const LAS u32x2*)hp, hg15 = *(const LAS u32x2*)(hp + 512), hv14 = *(const LAS u32x2*)(hp + 256), hv15 = *(const LAS u32x2*)(hp + 512 + 256);
          const float h14g[4] = {bf_lo(hg14.x), bf_hi(hg14.x), bf_lo(hg14.y), bf_hi(hg14.y)}, h15g[4] = {bf_lo(hg15.x), bf_hi(hg15.x), bf_lo(hg15.y), bf_hi(hg15.y)};
          const float h14v[4] = {bf_lo(hv14.x), bf_hi(hv14.x), bf_lo(hv14.y), bf_hi(hv14.y)}, h15v[4] = {bf_lo(hv15.x), bf_hi(hv15.x), bf_lo(hv15.y), bf_hi(hv15.y)};
#pragma unroll
          for (int k = 0; k < 4; ++k) {
            float g1 = dpp_shr1(xg[k]), g2 = dpp_shr2(xg[k]), v1 = dpp_shr1(xv[k]), v2 = dpp_shr2(xv[k]);
            if (fr == 0) { g1 = h15g[k]; g2 = h14g[k]; v1 = h15v[k]; v2 = h14v[k]; }
            if (fr == 1) { g2 = h15g[k]; v2 = h15v[k]; }
            const float cg = bg[k] + wg0[k] * g2 + wg1[k] * g1 + wg2[k] * xg[k];
            const float cv = bv[k] + wv0[k] * v2 + wv1[k] * v1 + wv2[k] * xv[k];
            y[k] = silu_mul(cg, cv);
          }
        }
        const int row = u.pm * 256 + ai * 128 + wr * 64 + m * 16 + fr;
        if (!(g == 0 && fr < 2)) { u32x2 w; w.x = pk2(y[0], y[1]); w.y = pk2(y[2], y[3]); *(u32x2*)(act + (size_t)row * DFF + ch) = w; }
      }
    asm volatile("" ::: "memory");
  }
}
struct EpiPre { f32x4 a0, a1; u32x4 u0, u1; float s; };
__device__ __forceinline__ void rope8v(float (&v)[8], f32x4 c0, f32x4 c1) {
  const float cs[8] = {c0[0], c0[1], c0[2], c0[3], c1[0], c1[1], c1[2], c1[3]};
#pragma unroll
  for (int i = 0; i < 4; ++i) { const float x1 = v[2 * i], x2 = v[2 * i + 1]; v[2 * i] = x1 * cs[2 * i] - x2 * cs[2 * i + 1]; v[2 * i + 1] = x2 * cs[2 * i] + x1 * cs[2 * i + 1]; }
}
template <int MODE> struct Epi {
  EpiP e;
  __device__ __forceinline__ void preload(EpiPre& q, int row, int col) const {
    if (MODE == E_GATE || MODE == E_UKV) return;
    if (MODE == E_MAIN) {
      if (col >= C_KR && col < C_HU) { const float* cs = e.f0 + ((size_t)row * 32 + ((col - C_KR) >> 1)) * 2; q.a0 = *(const f32x4*)cs; q.a1 = *(const f32x4*)(cs + 4); }
    } else if (MODE == E_GATE) {
      q.a0 = *(const f32x4*)(e.f0 + col); q.a1 = *(const f32x4*)(e.f0 + col + 4);
    } else if (MODE == E_UQ) {
      const int c192 = col % 192;
      if (c192 >= 128) { const float* cs = e.facc + ((size_t)row * 32 + ((c192 - 128) >> 1)) * 2; q.a0 = *(const f32x4*)cs; q.a1 = *(const f32x4*)(cs + 4); }
    } else if (MODE == E_UKV) {
      q.s = ((const f32x4*)e.f0)[row].y;
    } else if (MODE == E_PROJ) {
      q.u0 = *(const u32x4*)(e.b0 + (size_t)row * NG + e.aux * DM + col);
      if (e.aux > 0) q.u1 = *(const u32x4*)((const bf16_t*)e.facc + (size_t)row * DM + col);
    } else if (MODE == E_RES) {
      const float* rs = e.f0 + (size_t)row * DM + col; q.a0 = *(const f32x4*)rs; q.a1 = *(const f32x4*)(rs + 4);
    }
  }
  __device__ __forceinline__ void emit(const EpiPre& q0, int row, int col, f32x4 a, f32x4 b, const f32x4 (&hb)[2][2], const float (&hs)[2][4], int ai_, int m_, int bj_) const {
    EpiPre q = q0;
    if (MODE == E_GATE) { q.a0 = hb[bj_][0]; q.a1 = hb[bj_][1]; }
    if (MODE == E_UQ || MODE == E_UKV) q.s = hs[ai_][m_];
    float v[8] = {a[0], a[1], a[2], a[3], b[0], b[1], b[2], b[3]};
    if (MODE == E_MAIN) {
      if (col >= LDH) return;
      if (col < C_KA) {
#pragma unroll
        for (int j = 0; j < 8; ++j) v[j] *= SWA_QSCALE;
      } else if (col >= C_KR && col < C_HU) {
        rope8v(v, q.a0, q.a1);
      } else if ((col >= C_HU && col < C_CQ) || col >= C_HV) {
#pragma unroll
        for (int j = 0; j < 8; ++j) v[j] = gelu1(v[j]);
      }
      store8bf((bf16_t*)e.out + (size_t)row * LDH + col, v);
    } else if (MODE == E_GATE) {
      const float bb[8] = {q.a0[0], q.a0[1], q.a0[2], q.a0[3], q.a1[0], q.a1[1], q.a1[2], q.a1[3]};
#pragma unroll
      for (int j = 0; j < 8; ++j) v[j] = frcp(1.0f + fexp2(-(v[j] + bb[j]) * LOG2E));
      store8bf((bf16_t*)e.out + (size_t)row * NG + col, v);
    } else if (MODE == E_UQ) {
#pragma unroll
      for (int j = 0; j < 8; ++j) v[j] *= q.s;
      if (col % 192 >= 128) rope8v(v, q.a0, q.a1);
      store8bf((bf16_t*)e.out + (size_t)row * NQ + col, v);
    } else if (MODE == E_UKV) {
#pragma unroll
      for (int j = 0; j < 8; ++j) v[j] *= q.s;
      store8bf((bf16_t*)e.out + (size_t)row * NKV + col, v);
    } else if (MODE == E_PROJ) {
      const int br = e.aux; const u32x4 gw = q.u0;
      v[0] *= bf_lo(gw.x); v[1] *= bf_hi(gw.x); v[2] *= bf_lo(gw.y); v[3] *= bf_hi(gw.y);
      v[4] *= bf_lo(gw.z); v[5] *= bf_hi(gw.z); v[6] *= bf_lo(gw.w); v[7] *= bf_hi(gw.w);
      bf16_t* fa = (bf16_t*)e.facc + (size_t)row * DM + col;
      if (br > 0) { const u32x4 pw = q.u1;
        v[0] += bf_lo(pw.x); v[1] += bf_hi(pw.x); v[2] += bf_lo(pw.y); v[3] += bf_hi(pw.y); v[4] += bf_lo(pw.z); v[5] += bf_hi(pw.z); v[6] += bf_lo(pw.w); v[7] += bf_hi(pw.w); }
      if (br == 2) store8bf((bf16_t*)e.out + (size_t)row * DM + col, v);
      else store8bf(fa, v);
    } else if (MODE == E_RES) {
      const f32x4 r0 = q.a0, r1 = q.a1;
      float* o = (float*)e.out + (size_t)row * DM + col;
      *(f32x4*)o = (f32x4){ALPHA * r0[0] + v[0], ALPHA * r0[1] + v[1], ALPHA * r0[2] + v[2], ALPHA * r0[3] + v[3]};
      *(f32x4*)(o + 4) = (f32x4){ALPHA * r1[0] + v[4], ALPHA * r1[1] + v[5], ALPHA * r1[2] + v[6], ALPHA * r1[3] + v[7]};
    } else {
      store8bf((bf16_t*)e.out + (size_t)row * e.ldo + col, v);
    }
  }
  __device__ __forceinline__ void operator()(const f32x4 (&acc)[2][2][4][2], const pg8::Unit& u, int wr, int wc, int fr, int fq) const {
    if (MODE == E_UPC) { epi_upc(e, acc, u, wr, wc, fr, fq); return; }
    const int row0 = u.pm * 256 + wr * 64 + fr, col0 = u.pn * 256 + wc * 32 + 8 * fq;
    f32x4 hb[2][2]; float hs[2][4];
#pragma unroll
    for (int bj = 0; bj < 2; ++bj) { hb[bj][0] = (f32x4){0.f, 0.f, 0.f, 0.f}; hb[bj][1] = hb[bj][0];
      if (MODE == E_GATE) { hb[bj][0] = *(const f32x4*)(e.f0 + col0 + bj * 128); hb[bj][1] = *(const f32x4*)(e.f0 + col0 + bj * 128 + 4); } }
#pragma unroll
    for (int ai = 0; ai < 2; ++ai)
#pragma unroll
      for (int m = 0; m < 4; ++m) { hs[ai][m] = 0.f;
        if (MODE == E_UQ) hs[ai][m] = ((const f32x4*)e.f0)[row0 + ai * 128 + m * 16].x * MLA_QSCALE;
        if (MODE == E_UKV) hs[ai][m] = ((const f32x4*)e.f0)[row0 + ai * 128 + m * 16].y; }
    EpiPre q[2][4];
#pragma unroll
    for (int i = 0; i < 4; ++i) preload(q[0][i], row0 + (i >> 1) * 16, col0 + (i & 1) * 128);
#pragma unroll
    for (int gi = 0; gi < 4; ++gi) {
      const int ai = gi >> 1, mp = gi & 1;
      if (gi + 1 < 4) { const int ai2 = (gi + 1) >> 1, mp2 = (gi + 1) & 1;
#pragma unroll
        for (int i = 0; i < 4; ++i) preload(q[(gi + 1) & 1][i], row0 + ai2 * 128 + (2 * mp2 + (i >> 1)) * 16, col0 + (i & 1) * 128); }
      asm volatile("" ::: "memory");
#pragma unroll
      for (int i = 0; i < 4; ++i) { const int m = 2 * mp + (i >> 1), bj = i & 1; emit(q[gi & 1][i], row0 + ai * 128 + m * 16, col0 + bj * 128, acc[ai][bj][m][0], acc[ai][bj][m][1], hb, hs, ai, m, bj); }
      asm volatile("" ::: "memory");
    }
  }
};

template <int MODE>
__device__ __forceinline__ void run_gemm(LAS unsigned char* lds, const bf16_t* A, int lda, const bf16_t* Bt, int M, int N, int K, const EpiP& ep, int wv0) {
  pg8::Gemm g; g.A = A; g.Bt = Bt; g.M = M; g.N = N; g.K = K; g.lda = lda;
  pg8::StaticOrder S; S.init(M, N, ogrid(), obid());
  Epi<MODE> E; E.e = ep;
  pg8::gemm_phase(lds, g, S, E, wv0);
}

__device__ __forceinline__ int rope_src(int j) { return (j & 1) ? 32 + (j >> 1) : (j >> 1); }
__device__ __forceinline__ int srcmap(int kind, int n) {
  if (kind == 0) return n;
  if (kind == 1) {
    if (n < C_KR) return n;
    if (n < C_HU) return 2304 + rope_src(n - C_KR);
    if (n < C_CQ) return n - C_HU + 2368;
    if (n < C_CKV) return n - C_CQ + 1280;
    if (n < C_HV) return n - C_CKV + 1792;
    if (n < LDH) return n;
    return -1;
  }
  if (kind == 2) return 4416 + n;
  if (kind == 4) { const int pn = n >> 8, lc = n & 255; return lc < 128 ? 128 * pn + lc : DFF + 128 * pn + (lc - 128); }
  { const int hd = n / 192, c = n % 192; if (c < 128) return n; return hd * 192 + 128 + rope_src(c - 128); }
}
__device__ __forceinline__ void cvt_job(LAS unsigned char* lds, const float* src, bf16_t* dst, const float* kscale, int K, int Nsrc, int Ndst, int kind, int wv0, int bid_, int grd_) {
  LAS float* tile = (LAS float*)lds;
  const int tid = otid(wv0), nkt = K / 64, ntile = (Ndst / 64) * nkt;
  if (bid_ < 0) return;
  const int nl = tid & 63, kb = tid >> 6;
  float v[8];
#define CVT_LOAD(t_) do { const int k0_ = ((t_) % nkt) * 64, n0_ = ((t_) / nkt) * 64; const int sn = srcmap(kind, n0_ + nl); \
    _Pragma("unroll") for (int i = 0; i < 8; ++i) { const int kl = kb + 8 * i; v[i] = 0.f; \
      if (sn >= 0) { v[i] = src[(size_t)(k0_ + kl) * Nsrc + sn]; if (kscale) v[i] *= kscale[k0_ + kl]; } } } while (0)
  if (bid_ < ntile) CVT_LOAD(bid_);
  for (int t = bid_; t < ntile; t += grd_) {
    const int k0 = (t % nkt) * 64, n0 = (t / nkt) * 64;
#pragma unroll
    for (int i = 0; i < 8; ++i) tile[(kb + 8 * i) * 65 + nl] = v[i];
    __syncthreads();
    if (t + grd_ < ntile) CVT_LOAD(t + grd_);
    { const int nl2 = tid >> 3, kc = (tid & 7) * 8; float w[8];
#pragma unroll
      for (int j = 0; j < 8; ++j) w[j] = tile[(kc + j) * 65 + nl2];
      store8bf(dst + (size_t)(n0 + nl2) * K + k0 + kc, w); }
    __syncthreads();
  }
#undef CVT_LOAD
}
__device__ __forceinline__ void cvt_mixer_a(KP p, int l, LAS unsigned char* lds, int wv0) {
  unsigned char* W = p->ws; const int f = obid(), st = ogrid();
  cvt_job(lds, p->w_in + (size_t)l * DM * NIN, (bf16_t*)(W + O_WMAIN), nullptr, DM, NIN, NHP, 1, wv0, f, st);
  cvt_job(lds, p->w_in + (size_t)l * DM * NIN, (bf16_t*)(W + O_WG), nullptr, DM, NIN, NG, 2, wv0, f, st);
}
__device__ __forceinline__ void cvt_mixer_b(KP p, int l, LAS unsigned char* lds, int wv0, int f, int st) {
  unsigned char* W = p->ws;
  cvt_job(lds, p->w_uq + (size_t)l * 512 * NQ, (bf16_t*)(W + O_WUQ), p->q_norm_g + l * 512, 512, NQ, NQ, 3, wv0, f, st);
  cvt_job(lds, p->w_ukv + (size_t)l * 512 * NKV, (bf16_t*)(W + O_WUKV), p->kv_norm_g + l * 512, 512, NKV, NKV, 0, wv0, f, st);
  cvt_job(lds, p->w_proj_a + (size_t)l * 1024 * DM, (bf16_t*)(W + O_PA), nullptr, 1024, DM, DM, 0, wv0, f, st);
  cvt_job(lds, p->w_proj_b + (size_t)l * 2048 * DM, (bf16_t*)(W + O_PB), nullptr, 2048, DM, DM, 0, wv0, f, st);
  cvt_job(lds, p->w_proj_c + (size_t)l * 1024 * DM, (bf16_t*)(W + O_PC), nullptr, 1024, DM, DM, 0, wv0, f, st);
  cvt_job(lds, p->w_o + (size_t)l * DM * DM, (bf16_t*)(W + O_WO), nullptr, DM, DM, DM, 0, wv0, f, st);
}
__device__ __forceinline__ void cvt_ffn(KP p, int l, LAS unsigned char* lds, int wv0) {
  unsigned char* W = p->ws; const int f = obid(), st = ogrid();
  cvt_job(lds, p->w_up + (size_t)l * DM * NUP, (bf16_t*)(W + O_WUP), nullptr, DM, NUP, NUP, 4, wv0, f, st);
  cvt_job(lds, p->w_down + (size_t)l * DFF * DM, (bf16_t*)(W + O_WDN), nullptr, DFF, DM, DM, 0, wv0, f, st);
}

__device__ __forceinline__ void prologue(KP p, int wv0) {
  const size_t tid = (size_t)obid() * 512 + otid(wv0), nth = (size_t)ogrid() * 512;
  bf16_t* xb = (bf16_t*)(p->ws + O_XB);
  for (size_t i = tid; i < (size_t)NTOK * DM / 4; i += 4 * nth) {
    f32x4 v[4];
#pragma unroll
    for (int j = 0; j < 4; ++j) if (i + j * nth < (size_t)NTOK * DM / 4) v[j] = ((const f32x4*)p->x)[i + j * nth];
#pragma unroll
    for (int j = 0; j < 4; ++j) if (i + j * nth < (size_t)NTOK * DM / 4) { u32x2 w; w.x = pk2(v[j][0], v[j][1]); w.y = pk2(v[j][2], v[j][3]); ((u32x2*)xb)[i + j * nth] = w; } }
  f32x2* cs = (f32x2*)(p->ws + O_CS);
  for (size_t i = tid; i < (size_t)NTOK * 32; i += nth) {
    const int tok = (int)(i >> 5), f = (int)(i & 31);
    const float ang = (float)p->pos[tok] * INV_FREQ[f];
    double t = (double)ang * 0.15915494309189535; t -= __builtin_rint(t);
    const float tf = (float)t;
    cs[i] = (f32x2){__builtin_amdgcn_cosf(tf), __builtin_amdgcn_sinf(tf)};
  }
}

__device__ __forceinline__ void stats_phase(KP p, int wv0) {
  const bf16_t* h = (const bf16_t*)(p->ws + O_H); f32x4* st = (f32x4*)(p->ws + O_ST);
  const int tid_ = otid(wv0); const int lane = tid_ & 63, wv = obid() * 8 + (tid_ >> 6), nwv = ogrid() * 8;
  for (int row0 = wv; row0 < NTOK; row0 += 4 * nwv) {
    u32x4 a[4], b[4], v0[4], v1[4];
#pragma unroll
    for (int k = 0; k < 4; ++k) { const int row = row0 + k * nwv < NTOK ? row0 + k * nwv : row0; const bf16_t* hr = h + (size_t)row * LDH;
      a[k] = *(const u32x4*)(hr + C_CQ + lane * 8); b[k] = *(const u32x4*)(hr + C_CKV + lane * 8);
      v0[k] = *(const u32x4*)(hr + C_HV + lane * 16); v1[k] = *(const u32x4*)(hr + C_HV + lane * 16 + 8); }
    float sa[4], sb[4], sv[4], sq[4], mu[4];
#pragma unroll
    for (int k = 0; k < 4; ++k) { sa[k] = 0.f; sb[k] = 0.f; sv[k] = 0.f;
#pragma unroll
      for (int j = 0; j < 4; ++j) { float x0 = bf_lo(a[k][j]), x1 = bf_hi(a[k][j]); sa[k] += x0 * x0 + x1 * x1; x0 = bf_lo(b[k][j]); x1 = bf_hi(b[k][j]); sb[k] += x0 * x0 + x1 * x1;
        sv[k] += bf_lo(v0[k][j]) + bf_hi(v0[k][j]) + bf_lo(v1[k][j]) + bf_hi(v1[k][j]); } }
#pragma unroll
    for (int o = 32; o > 0; o >>= 1)
#pragma unroll
      for (int k = 0; k < 4; ++k) { sa[k] += __shfl_xor(sa[k], o); sb[k] += __shfl_xor(sb[k], o); sv[k] += __shfl_xor(sv[k], o); }
#pragma unroll
    for (int k = 0; k < 4; ++k) { mu[k] = sv[k] * (1.0f / 1024.0f); sq[k] = 0.f;
#pragma unroll
      for (int j = 0; j < 4; ++j) { float d;
        d = bf_lo(v0[k][j]) - mu[k]; sq[k] += d * d; d = bf_hi(v0[k][j]) - mu[k]; sq[k] += d * d; d = bf_lo(v1[k][j]) - mu[k]; sq[k] += d * d; d = bf_hi(v1[k][j]) - mu[k]; sq[k] += d * d; } }
#pragma unroll
    for (int o = 32; o > 0; o >>= 1)
#pragma unroll
      for (int k = 0; k < 4; ++k) sq[k] += __shfl_xor(sq[k], o);
#pragma unroll
    for (int k = 0; k < 4; ++k) if (lane == 0 && row0 + k * nwv < NTOK)
      st[row0 + k * nwv] = (f32x4){__builtin_amdgcn_rsqf(sa[k] * (1.0f / 512.0f) + EPS), __builtin_amdgcn_rsqf(sb[k] * (1.0f / 512.0f) + EPS), mu[k], __builtin_amdgcn_rsqf(sq[k] * (1.0f / 1024.0f) + EPS)};
  }
}

__device__ __forceinline__ void ln_phase(const float* in, float* outf, bf16_t* outb, const float* g, const float* b, int wv0) {
  const int tid_ = otid(wv0); const int lane = tid_ & 63, wv = obid() * 8 + (tid_ >> 6), nwv = ogrid() * 8;
  f32x4 gg[8], bb[8];
#pragma unroll
  for (int i = 0; i < 8; ++i) { gg[i] = ((const f32x4*)g)[i * 64 + lane]; bb[i] = ((const f32x4*)b)[i * 64 + lane]; }
  f32x4 vn[8];
  if (wv < NTOK) { const f32x4* ir = (const f32x4*)(in + (size_t)wv * DM);
#pragma unroll
    for (int i = 0; i < 8; ++i) vn[i] = ir[i * 64 + lane]; }
  for (int row = wv; row < NTOK; row += nwv) {
    f32x4 v[8]; float s = 0.f;
#pragma unroll
    for (int i = 0; i < 8; ++i) v[i] = vn[i];
    if (row + nwv < NTOK) { const f32x4* ir = (const f32x4*)(in + (size_t)(row + nwv) * DM);
#pragma unroll
      for (int i = 0; i < 8; ++i) vn[i] = ir[i * 64 + lane]; }
#pragma unroll
    for (int i = 0; i < 8; ++i) s += v[i][0] + v[i][1] + v[i][2] + v[i][3];
    s = wave_sum(s); const float mu = s * (1.0f / 2048.0f);
    float sq = 0.f;
#pragma unroll
    for (int i = 0; i < 8; ++i) { v[i] -= mu; sq += v[i][0] * v[i][0] + v[i][1] * v[i][1] + v[i][2] * v[i][2] + v[i][3] * v[i][3]; }
    sq = wave_sum(sq); const float rstd = __builtin_amdgcn_rsqf(sq * (1.0f / 2048.0f) + EPS);
#pragma unroll
    for (int i = 0; i < 8; ++i) {
      const f32x4 y = v[i] * rstd * gg[i] + bb[i];
      ((f32x4*)(outf + (size_t)row * DM))[i * 64 + lane] = y;
      if (outb) { u32x2 w; w.x = pk2(y[0], y[1]); w.y = pk2(y[2], y[3]); ((u32x2*)(outb + (size_t)row * DM))[i * 64 + lane] = w; } }
  }
}

template <int NQK, int NDV, int KSTR, int VSTR>
__device__ __forceinline__ void attn_tile(const bf16x8 (&qf)[NQK], f32x16 (&o)[NDV], float& m, float& l, const LAS unsigned char* Kt, const LAS unsigned char* Vt,
                                          int lane, int qpos, int kpos0, int window, bool domask) {
  const int c = lane & 31, h = lane >> 5;
  f32x16 s0, s1;
#pragma unroll
  for (int r = 0; r < 16; ++r) { s0[r] = 0.f; s1[r] = 0.f; }
  const LAS unsigned char* ka = Kt + c * KSTR + h * 16;
  bf16x8 kc0 = *(const LAS bf16x8*)(ka), kc1 = *(const LAS bf16x8*)(ka + 32 * KSTR);
  __builtin_amdgcn_s_setprio(1);
#pragma unroll
  for (int st = 0; st < NQK; ++st) {
    bf16x8 kn0 = kc0, kn1 = kc1;
    if (st + 1 < NQK) { kn0 = *(const LAS bf16x8*)(ka + (st + 1) * 32); kn1 = *(const LAS bf16x8*)(ka + 32 * KSTR + (st + 1) * 32); }
    s0 = mfma32(kc0, qf[st], s0);
    s1 = mfma32(kc1, qf[st], s1);
    if (st + 1 < NQK) __builtin_amdgcn_sched_group_barrier(0x100, 2, 0);
    __builtin_amdgcn_sched_group_barrier(0x008, 2, 0);
    __builtin_amdgcn_sched_barrier(0);
    kc0 = kn0; kc1 = kn1;
  }
  __builtin_amdgcn_s_setprio(0);
  __builtin_amdgcn_sched_barrier(0);
  if (domask) {
#pragma unroll
    for (int r = 0; r < 16; ++r) { const int kp = kpos0 + (r & 3) + 8 * (r >> 2) + 4 * h;
      const bool v0 = (kp <= qpos) && (kp > qpos - window) && (kp >= 0);
      const bool v1 = (kp + 32 <= qpos) && (kp + 32 > qpos - window) && (kp + 32 >= 0);
      s0[r] = v0 ? s0[r] : -1e30f; s1[r] = v1 ? s1[r] : -1e30f; }
  }
  float mx = fmaxf(s0[0], s1[0]);
#pragma unroll
  for (int r = 1; r < 16; ++r) mx = fmaxf(mx, fmaxf(s0[r], s1[r]));
  mx = fmaxf(mx, __shfl_xor(mx, 32));
  if (__builtin_amdgcn_ballot_w64(mx > m + 8.0f) != 0ull) {
    const float mn = fmaxf(m, mx), alpha = fexp2(m - mn);
    m = mn; l *= alpha;
#pragma unroll
    for (int d = 0; d < NDV; ++d) o[d] *= alpha;
  }
  float ps = 0.f;
#pragma unroll
  for (int r = 0; r < 16; ++r) { s0[r] = fexp2(s0[r] - m); s1[r] = fexp2(s1[r] - m); ps += s0[r] + s1[r]; }
  l += ps;
  bf16x8 pf[4];
#pragma unroll
  for (int s = 0; s < 2; ++s) {
    u32x4 w0, w1;
    w0.x = pk2(s0[8 * s + 0], s0[8 * s + 1]); w0.y = pk2(s0[8 * s + 2], s0[8 * s + 3]); w0.z = pk2(s0[8 * s + 4], s0[8 * s + 5]); w0.w = pk2(s0[8 * s + 6], s0[8 * s + 7]);
    w1.x = pk2(s1[8 * s + 0], s1[8 * s + 1]); w1.y = pk2(s1[8 * s + 2], s1[8 * s + 3]); w1.z = pk2(s1[8 * s + 4], s1[8 * s + 5]); w1.w = pk2(s1[8 * s + 6], s1[8 * s + 7]);
    pf[s] = __builtin_bit_cast(bf16x8, w0); pf[2 + s] = __builtin_bit_cast(bf16x8, w1);
  }
  __builtin_amdgcn_sched_barrier(0);
  const int i16 = lane & 15, g16 = (lane >> 4) & 1;
  const LAS unsigned char* va = Vt + (4 * h + (i16 >> 2)) * VSTR + (16 * g16 + 4 * (i16 & 3)) * 2;
  bf16x8 vc[NDV];
#pragma unroll
  for (int d = 0; d < NDV; ++d) { const v4i16_t lo = vtr(va + d * 64), hi = vtr(va + 8 * VSTR + d * 64); vc[d] = __builtin_shufflevector(lo, hi, 0, 1, 2, 3, 4, 5, 6, 7); }
  __builtin_amdgcn_s_setprio(1);
#pragma unroll
  for (int ks = 0; ks < 4; ++ks) {
    bf16x8 vn[NDV];
#pragma unroll
    for (int d = 0; d < NDV; ++d) { vn[d] = vc[d];
      if (ks + 1 < 4) { const v4i16_t lo = vtr(va + (16 * (ks + 1)) * VSTR + d * 64), hi = vtr(va + (16 * (ks + 1) + 8) * VSTR + d * 64); vn[d] = __builtin_shufflevector(lo, hi, 0, 1, 2, 3, 4, 5, 6, 7); } }
#pragma unroll
    for (int d = 0; d < NDV; ++d) o[d] = mfma32(vc[d], pf[ks], o[d]);
    if (ks + 1 < 4) __builtin_amdgcn_sched_group_barrier(0x100, 2 * NDV, 0);
    __builtin_amdgcn_sched_group_barrier(0x008, NDV, 0);
    __builtin_amdgcn_sched_barrier(0);
#pragma unroll
    for (int d = 0; d < NDV; ++d) vc[d] = vn[d];
  }
  __builtin_amdgcn_s_setprio(0);
}

__device__ __forceinline__ void mla_phase(KP p, LAS unsigned char* lds, int wv0) {
  constexpr int KSTR = 400, VSTR = 320, KB = 64 * KSTR, VB = 64 * VSTR;
  const bf16_t* q = (const bf16_t*)(p->ws + O_Q); const bf16_t* kv = (const bf16_t*)(p->ws + O_KV);
  bf16_t* h = (bf16_t*)(p->ws + O_H);
  const int tid = otid(wv0), wid = __builtin_amdgcn_readfirstlane(tid >> 6), lane = tid & 63, c = lane & 31, hh = lane >> 5;
  const int G = ogrid(), bid = obid();
  for (int k = 0; k * G < 1024; ++k) {
    const int idx = (k & 1) ? (G - 1 - bid) : bid, rank = k * G + idx;
    if (rank >= 1024) continue;
    const int qb = 15 - rank / 64, bh = rank % 64, b = bh >> 4, hd = bh & 15;
    const int tok0 = b * SEQ, q0 = qb * 256 + 32 * wid;
    bf16x8 qf[12];
    { const bf16_t* qrow = q + (size_t)(tok0 + q0 + c) * NQ + hd * 192 + 8 * hh;
#pragma unroll
      for (int st = 0; st < 12; ++st) qf[st] = *(const bf16x8*)(qrow + 16 * st); }
    f32x16 o[4];
#pragma unroll
    for (int d = 0; d < 4; ++d)
#pragma unroll
      for (int r = 0; r < 16; ++r) o[d][r] = 0.f;
    float m = -1e30f, l = 0.f;
    const int ntiles = qb * 4 + 4;
    unsigned ksrc[3]; int kdst[3];
    const unsigned char* wsb = p->ws;
#pragma unroll
    for (int i = 0; i < 3; ++i) { const int cid = tid + 512 * i, key = cid / 24, ch = cid % 24;
      ksrc[i] = (ch < 16) ? (unsigned)(O_KV + ((size_t)(tok0 + key) * NKV + hd * 256 + ch * 8) * 2) : (unsigned)(O_H + ((size_t)(tok0 + key) * LDH + C_KR + (ch - 16) * 8) * 2);
      kdst[i] = key * KSTR + ch * 16; }
    const unsigned kinc0 = 64u * NKV * 2u, kinc1 = 64u * LDH * 2u;
    const bool k2rope = ((tid + 1024) % 24) >= 16, k1rope = ((tid + 512) % 24) >= 16, k0rope = (tid % 24) >= 16;
    unsigned vsrc[2]; int vdst[2];
#pragma unroll
    for (int i = 0; i < 2; ++i) { const int cid = tid + 512 * i, key = cid >> 4, ch = cid & 15;
      vsrc[i] = (unsigned)(O_KV + ((size_t)(tok0 + key) * NKV + hd * 256 + 128 + ch * 8) * 2); vdst[i] = key * VSTR + ch * 16; }
    u32x4 kr0 = *(const u32x4*)(wsb + ksrc[0]), kr1 = *(const u32x4*)(wsb + ksrc[1]), kr2 = *(const u32x4*)(wsb + ksrc[2]), vr0 = *(const u32x4*)(wsb + vsrc[0]), vr1 = *(const u32x4*)(wsb + vsrc[1]);
    for (int kt = 0; kt < ntiles; ++kt) {
      LAS unsigned char* Kb = lds + (kt & 1) * KB; LAS unsigned char* Vb = lds + 2 * KB + (kt & 1) * VB;
      *(LAS u32x4*)(Kb + kdst[0]) = kr0; *(LAS u32x4*)(Kb + kdst[1]) = kr1; *(LAS u32x4*)(Kb + kdst[2]) = kr2;
      *(LAS u32x4*)(Vb + vdst[0]) = vr0; *(LAS u32x4*)(Vb + vdst[1]) = vr1;
      __syncthreads();
      if (kt + 1 < ntiles) {
        ksrc[0] += k0rope ? kinc1 : kinc0; ksrc[1] += k1rope ? kinc1 : kinc0; ksrc[2] += k2rope ? kinc1 : kinc0; vsrc[0] += kinc0; vsrc[1] += kinc0;
        kr0 = *(const u32x4*)(wsb + ksrc[0]); kr1 = *(const u32x4*)(wsb + ksrc[1]); kr2 = *(const u32x4*)(wsb + ksrc[2]); vr0 = *(const u32x4*)(wsb + vsrc[0]); vr1 = *(const u32x4*)(wsb + vsrc[1]);
      }
      const int k0 = kt * 64;
      if (k0 <= q0 + 31) attn_tile<12, 4, KSTR, VSTR>(qf, o, m, l, Kb, Vb, lane, q0 + c, k0, 1 << 30, k0 + 63 > q0);
    }
    const float inv = frcp(l + __shfl_xor(l, 32));
    bf16_t* yrow = h + (size_t)(tok0 + q0 + c) * LDH + C_CQ + hd * 128 + 4 * hh;
#pragma unroll
    for (int d = 0; d < 4; ++d)
#pragma unroll
      for (int g = 0; g < 4; ++g) { u32x2 w; w.x = pk2(o[d][4 * g] * inv, o[d][4 * g + 1] * inv); w.y = pk2(o[d][4 * g + 2] * inv, o[d][4 * g + 3] * inv);
        *(u32x2*)(yrow + 32 * d + 8 * g) = w; }
    __syncthreads();
  }
}

__device__ __forceinline__ void swa_phase(KP p, int l, LAS unsigned char* lds, int wv0, int dummy = 0) {
  constexpr int STR = 144, VST = 192, TB = 64 * VST;
  bf16_t* h = (bf16_t*)(p->ws + O_H);
  const int tid = otid(wv0), wid = __builtin_amdgcn_readfirstlane(tid >> 6), lane = tid & 63, c = lane & 31, hh = lane >> 5;
  const int bid_ = obid(), grd_ = ogrid();
  for (int it = bid_; it < 512; it += grd_) {
    const int b = it >> 7, r = it & 127, kvh = r >> 6, qblk = r & 63, t0 = qblk * 64, hq = kvh * 8 + wid;
    const size_t tokb = (size_t)b * SEQ;
    bf16x8 qf[2][4];
    bf16_t* qrow0 = h + (tokb + t0 + c) * LDH + C_QA + hq * 64;
#pragma unroll
    for (int sub = 0; sub < 2; ++sub)
#pragma unroll
      for (int st = 0; st < 4; ++st) qf[sub][st] = *(const bf16x8*)(qrow0 + (size_t)sub * 32 * LDH + 16 * st + 8 * hh);
    { const int key = tid >> 3, ch = tid & 7;
#pragma unroll
      for (int j = 0; j < 3; ++j) { int kp = t0 - 128 + 64 * j + key; kp = kp < 0 ? 0 : kp;
        const bf16_t* src = h + (tokb + kp) * LDH + C_KA + kvh * 64 + ch * 8;
        *(LAS u32x4*)(lds + j * 2 * TB + key * STR + ch * 16) = *(const u32x4*)src;
        *(LAS u32x4*)(lds + j * 2 * TB + TB + key * VST + ch * 16) = *(const u32x4*)(src + (C_VA - C_KA)); } }
    __syncthreads();
    const float sink2 = p->sinks[l * 16 + hq] * LOG2E;
#pragma unroll
    for (int sub = 0; sub < 2; ++sub) {
      float m = sink2, ls = 0.f;
      f32x16 o[2];
#pragma unroll
      for (int d = 0; d < 2; ++d)
#pragma unroll
        for (int rr = 0; rr < 16; ++rr) o[d][rr] = 0.f;
      const int qpos = t0 + 32 * sub + c;
#pragma unroll
      for (int j = 0; j < 3; ++j) { const int k0 = t0 - 128 + 64 * j;
        if (k0 + 63 >= 0 && k0 + 63 >= t0 + 32 * sub - 127 && k0 <= t0 + 32 * sub + 31)
          attn_tile<4, 2, STR, VST>(qf[sub], o, m, ls, lds + j * 2 * TB, lds + j * 2 * TB + TB, lane, qpos, k0, 128, true); }
      const float inv = frcp(ls + __shfl_xor(ls, 32) + fexp2(sink2 - m));
      bf16_t* qrow = qrow0 + (size_t)sub * 32 * LDH;
#pragma unroll
      for (int d = 0; d < 2; ++d)
#pragma unroll
        for (int g = 0; g < 4; ++g) { u32x2 w; w.x = pk2(o[d][4 * g] * inv, o[d][4 * g + 1] * inv); w.y = pk2(o[d][4 * g + 2] * inv, o[d][4 * g + 3] * inv);
          bf16_t* dst_ = dummy ? (bf16_t*)(p->ws + O_Q) + (tokb + t0 + 32 * sub + c) * 1024 + hq * 64 : qrow; *(u32x2*)(dst_ + 32 * d + 8 * g + 4 * hh) = w; }
    }
    __syncthreads();
  }
}

__device__ __forceinline__ void sgu_phase(KP p, int l, LAS unsigned char* lds, int wv0, int dummy = 0) {
  constexpr int STR = 272;
  bf16_t* h = (bf16_t*)(p->ws + O_H); const f32x4* st = (const f32x4*)(p->ws + O_ST);
  LAS unsigned char* Wl = lds; LAS unsigned char* Vl = lds + 128 * STR;
  const int tid = otid(wv0), wid = __builtin_amdgcn_readfirstlane(tid >> 6), lane = tid & 63, c = lane & 31, hh = lane >> 5;
  const int bid_ = obid(), grd_ = ogrid();
  int gprev = -1;
  for (int it = bid_; it < 1024; it += grd_) {
    const int cidx = it >> 3, g = it & 7, tb0 = cidx * 128;
    if (g != gprev) {
      gprev = g;
      const float* wg = p->sgu_w + ((size_t)l * 8 + g) * 128 * 128;
#pragma unroll
      for (int i = 0; i < 8; ++i) { const int idx = tid + 512 * i, t = idx >> 5, s4 = (idx & 31) * 4;
        const f32x4 v = *(const f32x4*)(wg + t * 128 + s4);
        u32x2 w; w.x = pk2(s4 <= t ? v[0] : 0.f, s4 + 1 <= t ? v[1] : 0.f); w.y = pk2(s4 + 2 <= t ? v[2] : 0.f, s4 + 3 <= t ? v[3] : 0.f);
        *(LAS u32x2*)(Wl + t * STR + s4 * 2) = w; }
    }
#pragma unroll
    for (int i = 0; i < 4; ++i) { const int cid = tid + 512 * i, s = cid >> 4, ch = cid & 15;
      const u32x4 hv = *(const u32x4*)(h + (size_t)(tb0 + s) * LDH + C_HV + g * 128 + ch * 8);
      const f32x4 sv = st[tb0 + s]; const float mu = sv.z, rstd = sv.w;
      const float* lg = p->sgu_ln_g + l * 1024 + g * 128 + ch * 8; const float* lb = p->sgu_ln_b + l * 1024 + g * 128 + ch * 8;
      const f32x4 g0 = *(const f32x4*)lg, g1 = *(const f32x4*)(lg + 4), b0 = *(const f32x4*)lb, b1 = *(const f32x4*)(lb + 4);
      u32x4 w;
      w.x = pk2((bf_lo(hv.x) - mu) * rstd * g0[0] + b0[0], (bf_hi(hv.x) - mu) * rstd * g0[1] + b0[1]);
      w.y = pk2((bf_lo(hv.y) - mu) * rstd * g0[2] + b0[2], (bf_hi(hv.y) - mu) * rstd * g0[3] + b0[3]);
      w.z = pk2((bf_lo(hv.z) - mu) * rstd * g1[0] + b1[0], (bf_hi(hv.z) - mu) * rstd * g1[1] + b1[1]);
      w.w = pk2((bf_lo(hv.w) - mu) * rstd * g1[2] + b1[2], (bf_hi(hv.w) - mu) * rstd * g1[3] + b1[3]);
      *(LAS u32x4*)(Vl + s * STR + ch * 16) = w; }
    __syncthreads();
    const int tblk = wid >> 1, cb0 = (wid & 1) * 2;
    f32x16 acc[2];
#pragma unroll
    for (int d = 0; d < 2; ++d)
#pragma unroll
      for (int r = 0; r < 16; ++r) acc[d][r] = 0.f;
    const int i16 = lane & 15, g16 = (lane >> 4) & 1;
    const LAS unsigned char* wa = Wl + (32 * tblk + c) * STR + hh * 16;
    const LAS unsigned char* va = Vl + (8 * hh + (i16 >> 2)) * STR + (32 * cb0 + 16 * g16 + 4 * (i16 & 3)) * 2;
#pragma unroll
    for (int s = 0; s < 8; ++s) {
      const bf16x8 a = *(const LAS bf16x8*)(wa + s * 32);
#pragma unroll
      for (int d = 0; d < 2; ++d) {
        const v4i16_t lo = vtr(va + (16 * s) * STR + d * 64);
        const v4i16_t hi = vtr(va + (16 * s + 4) * STR + d * 64);
        const bf16x8 bfr = __builtin_shufflevector(lo, hi, 0, 1, 2, 3, 4, 5, 6, 7);
        acc[d] = mfma32(a, bfr, acc[d]);
      }
    }
    const float* sb = p->sgu_b + ((size_t)l * 8 + g) * 128;
    float uu[2][16], sbv[16];
#pragma unroll
    for (int r = 0; r < 16; ++r) { const int t = 32 * tblk + (r & 3) + 8 * (r >> 2) + 4 * hh; sbv[r] = sb[t];
#pragma unroll
      for (int d = 0; d < 2; ++d) uu[d][r] = bf1(h[(size_t)(tb0 + t) * LDH + C_HU + g * 128 + 32 * (cb0 + d) + c]); }
    asm volatile("" ::: "memory");
#pragma unroll
    for (int d = 0; d < 2; ++d)
#pragma unroll
      for (int r = 0; r < 16; ++r) { const int t = 32 * tblk + (r & 3) + 8 * (r >> 2) + 4 * hh, cc = 32 * (cb0 + d) + c;
        bf16_t* up = h + (size_t)(tb0 + t) * LDH + C_HU + g * 128 + cc;
        const float y = uu[d][r] * (acc[d][r] + sbv[r]);
        bf16_t* dst_ = dummy ? (bf16_t*)p->out + (size_t)(tb0 + t) * 1024 + g * 128 + cc : up; *dst_ = (bf16_t)(pk2(y, 0.f) & 0xffffu); }
    __syncthreads();
  }
}

__device__ __forceinline__ void fixup_phase(KP p, int l, int wv0) {
  const bf16_t* side = (const bf16_t*)(p->ws + O_SIDE); bf16_t* act = (bf16_t*)(p->ws + O_ACT);
  const float* cw = p->conv_w + (size_t)l * 3 * NUP; const float* cb = p->conv_b + (size_t)l * NUP;
  const int ntask = 704 * 128;
  const int id0_ = obid() * 512 + otid(wv0), idst_ = ogrid() * 512;
  for (int id = id0_; id < ntask; id += idst_) {
    const int cgp = id % 704, rk = id / 704, k = rk >> 1, rr = rk & 1, c0 = cgp * 8, t = (k * 256 + rr) & (SEQ - 1);
    const bf16_t* s0p = side + ((size_t)k * 4 + rr) * NUP;
    const bf16_t* s1p = rr ? side + ((size_t)k * 4) * NUP : side + ((size_t)(k > 0 ? k - 1 : 0) * 4 + 3) * NUP;
    const bf16_t* s2p = side + ((size_t)(k > 0 ? k - 1 : 0) * 4 + (rr ? 3 : 2)) * NUP;
    const float m1 = (t >= 1) ? 1.f : 0.f, m2 = (t >= 2) ? 1.f : 0.f;
    float y[8];
#pragma unroll
    for (int hf = 0; hf < 2; ++hf) {
      const int c = c0 + 4 * hf;
      const u32x2 a0 = *(const u32x2*)(s0p + c), a1 = *(const u32x2*)(s1p + c), a2 = *(const u32x2*)(s2p + c);
      const u32x2 d0 = *(const u32x2*)(s0p + DFF + c), d1 = *(const u32x2*)(s1p + DFF + c), d2 = *(const u32x2*)(s2p + DFF + c);
      const f32x4 wg0 = *(const f32x4*)(cw + c), wg1 = *(const f32x4*)(cw + NUP + c), wg2 = *(const f32x4*)(cw + 2 * NUP + c), bg = *(const f32x4*)(cb + c);
      const f32x4 wv0_ = *(const f32x4*)(cw + DFF + c), wv1 = *(const f32x4*)(cw + NUP + DFF + c), wv2 = *(const f32x4*)(cw + 2 * NUP + DFF + c), bv = *(const f32x4*)(cb + DFF + c);
      const float g0[4] = {bf_lo(a0.x), bf_hi(a0.x), bf_lo(a0.y), bf_hi(a0.y)}, g1[4] = {bf_lo(a1.x), bf_hi(a1.x), bf_lo(a1.y), bf_hi(a1.y)}, g2[4] = {bf_lo(a2.x), bf_hi(a2.x), bf_lo(a2.y), bf_hi(a2.y)};
      const float v0[4] = {bf_lo(d0.x), bf_hi(d0.x), bf_lo(d0.y), bf_hi(d0.y)}, v1[4] = {bf_lo(d1.x), bf_hi(d1.x), bf_lo(d1.y), bf_hi(d1.y)}, v2[4] = {bf_lo(d2.x), bf_hi(d2.x), bf_lo(d2.y), bf_hi(d2.y)};
#pragma unroll
      for (int e = 0; e < 4; ++e) {
        const float cgv = bg[e] + wg0[e] * (g2[e] * m2) + wg1[e] * (g1[e] * m1) + wg2[e] * g0[e];
        const float cvv = bv[e] + wv0_[e] * (v2[e] * m2) + wv1[e] * (v1[e] * m1) + wv2[e] * v0[e];
        y[4 * hf + e] = silu_mul(cgv, cvv);
      }
    }
    store8bf(act + (size_t)(k * 256 + rr) * DFF + c0, y);
  }
}

#define XB_TMO      128
#define XB_XCNT(j)  (256  + 64 * (j))
#define XB_XSUB(j)  (1280 + 64 * (j))
#define XB_XGEN(j)  (2304 + 64 * (j))
#define XB_TOP      3328
#define XB_TOPGEN   3392
#define XCD_BAR_WORDS 3456
#define XB_SPIN_CAP (1u << 20)
__device__ __forceinline__ unsigned xb_ld(unsigned* p)              { return __hip_atomic_load(p, __ATOMIC_RELAXED, __HIP_MEMORY_SCOPE_AGENT); }
__device__ __forceinline__ unsigned xb_add(unsigned* p, unsigned v) { return __hip_atomic_fetch_add(p, v, __ATOMIC_RELAXED, __HIP_MEMORY_SCOPE_AGENT); }
__device__ __forceinline__ unsigned xb_xcc_id() { return (unsigned)__builtin_amdgcn_s_getreg((3 << 11) | 20) & 0xFu; }
#define XB_SPIN(cond, bar) do { unsigned _sp = 0; while (cond) { __builtin_amdgcn_s_sleep(1); \
    if ((++_sp & 255u) == 0u) { if (xb_ld(&(bar)[XB_TMO])) break; if (_sp > XB_SPIN_CAP) { atomicAdd(&(bar)[XB_TMO], 1u); break; } } } } while (0)
__device__ __forceinline__ void xcd_barrier_complete(unsigned* bar, unsigned x, unsigned& nloc, unsigned& nx) {
    const unsigned G = gridDim.x * gridDim.y * gridDim.z;
    unsigned sum, cnt, mine, sp = 0u;
    for (;;) {
        sum = 0u; cnt = 0u; mine = 0u;
#pragma unroll
        for (unsigned j = 0; j < 16; ++j) { const unsigned c = xb_ld(&bar[XB_XCNT(j)]); sum += c; cnt += (c > 0u) ? 1u : 0u; mine = (j == x) ? c : mine; }
        if (sum == G) break;
        __builtin_amdgcn_s_sleep(1);
        if ((++sp & 255u) == 0u) { if (xb_ld(&bar[XB_TMO])) break; if (sp > XB_SPIN_CAP) { atomicAdd(&bar[XB_TMO], 1u); break; } }
    }
    nloc = mine > 0u ? mine : 1u; nx = cnt > 0u ? cnt : 1u;
}
__device__ __forceinline__ void xcd_barrier(unsigned* bar, volatile LAS unsigned* st, int wv0) {
    asm volatile("s_waitcnt vmcnt(0)" ::: "memory");
    __syncthreads();
    if (otid(wv0) == 0) {
        const unsigned x = xb_xcc_id();
        __builtin_amdgcn_s_waitcnt(0);
        unsigned nloc = st[0], nx = st[1];
        if (nloc == 0u) { xcd_barrier_complete(bar, x, nloc, nx); st[0] = nloc; st[1] = nx; }
        const unsigned old = xb_add(&bar[XB_XSUB(x)], 1u);
        const unsigned gen = old / nloc;
        if (old + 1u == (gen + 1u) * nloc) {
            __builtin_amdgcn_fence(__ATOMIC_RELEASE, "agent");
            asm volatile("s_waitcnt vmcnt(0)" ::: "memory");
            const unsigned og = xb_add(&bar[XB_TOP], 1u);
            const unsigned tg = og / nx;
            if (og + 1u == (tg + 1u) * nx) xb_add(&bar[XB_TOPGEN], 1u);
            else XB_SPIN(xb_ld(&bar[XB_TOPGEN]) == tg, bar);
            __builtin_amdgcn_fence(__ATOMIC_ACQUIRE, "agent");
            xb_add(&bar[XB_XGEN(x)], 1u);
            asm volatile("s_waitcnt vmcnt(0)" ::: "memory");
        } else {
            XB_SPIN(xb_ld(&bar[XB_XGEN(x)]) == gen, bar);
            __builtin_amdgcn_fence(__ATOMIC_ACQUIRE, "agent");
            asm volatile("s_waitcnt vmcnt(0)" ::: "memory");
        }
    }
    __syncthreads();
}
#define GSYNC() xcd_barrier((unsigned*)(p->ws + O_BAR), (volatile LAS unsigned*)((LAS unsigned char*)shm + 131072), wv0)

#ifndef PH_MASK
#define PH_MASK 0xFFFFF
#endif
#ifndef REP_MASK
#define REP_MASK 0
#endif
#define PH(b) for (int rep_ = 0, nrep_ = (int)(((PH_MASK >> (b)) & 1) + ((REP_MASK >> (b)) & 1)); rep_ < nrep_; ++rep_)
#define LAUNDER() do { asm volatile("" : "+s"(p), "+s"(l), "+s"(wv0) :: "memory"); ws = p->ws; xb = (bf16_t*)(ws + O_XB); xa = (float*)(ws + O_XA); hbuf = (bf16_t*)(ws + O_H); qbuf = (bf16_t*)(ws + O_Q); kvbuf = (bf16_t*)(ws + O_KV); gbuf = qbuf; mb = xb; cs = (const float*)(ws + O_CS); st = (const float*)(ws + O_ST); } while (0)
__global__ void __launch_bounds__(512, 2) mega(Params p_unused) {
  KP p = (KP)__builtin_amdgcn_kernarg_segment_ptr();
  int wv0 = __builtin_amdgcn_readfirstlane((int)threadIdx.x >> 6);
  extern __shared__ __attribute__((aligned(16))) unsigned char shm[];
  LAS unsigned char* lds = (LAS unsigned char*)shm;
  cg::grid_group grid = cg::this_grid();
  unsigned char* ws;
  bf16_t* xb; float* xa; bf16_t* hbuf; bf16_t* qbuf; bf16_t* kvbuf;
  bf16_t* gbuf;
  bf16_t* mb;
  const float* cs; const float* st; int l = 0;
  LAUNDER();

  if (otid(wv0) == 0) { volatile LAS unsigned* bst = (volatile LAS unsigned*)(lds + 131072); bst[0] = 0u; bst[1] = 0u; }
  { unsigned* bar0 = (unsigned*)(p->ws + O_BAR); for (int i = obid() * 512 + otid(wv0); i < XCD_BAR_WORDS; i += ogrid() * 512) bar0[i] = 0u; }
  PH(0) cvt_mixer_a(p, 0, lds, wv0);
  PH(1) prologue(p, wv0);
  grid.sync(); LAUNDER();
  if (otid(wv0) == 0) (void)xb_add((unsigned*)(ws + O_BAR) + XB_XCNT(xb_xcc_id()), 1u);
  for (l = 0; l < 2; ++l) {
    LAUNDER();
    PH(2) { EpiP e{}; e.out = hbuf; e.f0 = cs; run_gemm<E_MAIN>(lds, xb, DM, (const bf16_t*)(ws + O_WMAIN), NTOK, NHP, DM, e, wv0); }
    PH(18) { const int G_ = ogrid(), b_ = obid(), extra = ((NTOK / 256) * (NHP / 256)) % G_;
      cvt_mixer_b(p, l, lds, wv0, extra ? b_ - extra : b_, extra ? G_ - extra : G_); }
    GSYNC(); LAUNDER();
    PH(3) stats_phase(p, wv0);
    PH(4) swa_phase(p, l, lds, wv0, rep_ + 1 < nrep_);
    GSYNC(); LAUNDER();
    PH(5) { EpiP e{}; e.out = qbuf; e.f0 = st; e.facc = (float*)cs; run_gemm<E_UQ>(lds, hbuf + C_CQ, LDH, (const bf16_t*)(ws + O_WUQ), NTOK, NQ, 512, e, wv0); }
    PH(6) { EpiP e{}; e.out = kvbuf; e.f0 = st; run_gemm<E_UKV>(lds, hbuf + C_CKV, LDH, (const bf16_t*)(ws + O_WUKV), NTOK, NKV, 512, e, wv0); }
    PH(7) sgu_phase(p, l, lds, wv0, rep_ + 1 < nrep_);
    GSYNC(); LAUNDER();
    PH(8) mla_phase(p, lds, wv0);
    GSYNC(); LAUNDER();
    PH(9) { EpiP e{}; e.out = gbuf; e.f0 = p->b_gate + (size_t)l * NG; run_gemm<E_GATE>(lds, xb, DM, (const bf16_t*)(ws + O_WG), NTOK, NG, DM, e, wv0); }
    GSYNC(); LAUNDER();
    PH(10) { EpiP e{}; e.out = mb; e.b0 = gbuf; e.facc = p->out; e.aux = 0; run_gemm<E_PROJ>(lds, hbuf + C_QA, LDH, (const bf16_t*)(ws + O_PA), NTOK, DM, 1024, e, wv0); }
    PH(10) { EpiP e{}; e.out = mb; e.b0 = gbuf; e.facc = p->out; e.aux = 1; run_gemm<E_PROJ>(lds, hbuf + C_CQ, LDH, (const bf16_t*)(ws + O_PB), NTOK, DM, 2048, e, wv0); }
    PH(10) { EpiP e{}; e.out = mb; e.b0 = gbuf; e.facc = p->out; e.aux = 2; run_gemm<E_PROJ>(lds, hbuf + C_HU, LDH, (const bf16_t*)(ws + O_PC), NTOK, DM, 1024, e, wv0); }
    GSYNC(); LAUNDER();
    PH(11) { EpiP e{}; e.out = xa; e.f0 = (l == 0) ? p->x : xa; run_gemm<E_RES>(lds, mb, DM, (const bf16_t*)(ws + O_WO), NTOK, DM, DM, e, wv0); }
    GSYNC(); LAUNDER();
    PH(12) ln_phase(xa, xa, xb, p->ln1_g + l * DM, p->ln1_b + l * DM, wv0);
    PH(13) cvt_ffn(p, l, lds, wv0);
    GSYNC(); LAUNDER();
    PH(14) { EpiP e{}; e.out = ws + O_ACT; e.b0 = (const bf16_t*)(ws + O_SIDE); e.f0 = p->conv_w + (size_t)l * 3 * NUP; e.f1 = p->conv_b + (size_t)l * NUP; e.ex = lds + 131072 + 64;
      run_gemm<E_UPC>(lds, xb, DM, (const bf16_t*)(ws + O_WUP), NTOK, NUP, DM, e, wv0); }
    GSYNC(); LAUNDER();
    PH(15) fixup_phase(p, l, wv0);
    GSYNC(); LAUNDER();
    PH(16) { EpiP e{}; e.out = xa; e.f0 = xa; run_gemm<E_RES>(lds, (const bf16_t*)(ws + O_ACT), DFF, (const bf16_t*)(ws + O_WDN), NTOK, DM, DFF, e, wv0); }
    GSYNC(); LAUNDER();
    PH(17) ln_phase(xa, (l == 1) ? p->out : xa, (l == 1) ? nullptr : xb, p->ln2_g + l * DM, p->ln2_b + l * DM, wv0);
    if (l == 0) { PH(0) cvt_mixer_a(p, 1, lds, wv0); GSYNC(); }
  }
}

extern "C" void kernel_launch(void* const* d_in, const int* in_sizes, int n_in, void* d_out, int out_size, void* d_ws, size_t ws_size, hipStream_t stream) {
  constexpr size_t kDynLds = 131072 + 64 + 16384;
  static int grid_blocks = 0;
  if (!grid_blocks) {
    (void)hipFuncSetAttribute((const void*)mega, hipFuncAttributeMaxDynamicSharedMemorySize, (int)kDynLds);
    int dev = 0, cus = 0, per_cu = 0;
    (void)hipGetDevice(&dev);
    (void)hipDeviceGetAttribute(&cus, hipDeviceAttributeMultiprocessorCount, dev);
    (void)hipOccupancyMaxActiveBlocksPerMultiprocessor(&per_cu, mega, 512, kDynLds);
    if (per_cu > 1) per_cu = 1;
    if (per_cu < 1) per_cu = 1;
    grid_blocks = cus * per_cu;
  }
  if (ws_size < WS_NEED) { fprintf(stderr, "workspace too small: %zu < %zu\n", ws_size, (size_t)WS_NEED); return; }
  Params p{};
  p.x = (const float*)d_in[0]; p.pos = (const int*)d_in[1]; p.w_in = (const float*)d_in[2]; p.b_gate = (const float*)d_in[3]; p.sinks = (const float*)d_in[4];
  p.q_norm_g = (const float*)d_in[5]; p.kv_norm_g = (const float*)d_in[6]; p.w_uq = (const float*)d_in[7]; p.w_ukv = (const float*)d_in[8];
  p.sgu_ln_g = (const float*)d_in[9]; p.sgu_ln_b = (const float*)d_in[10]; p.sgu_w = (const float*)d_in[11]; p.sgu_b = (const float*)d_in[12];
  p.w_proj_a = (const float*)d_in[13]; p.w_proj_b = (const float*)d_in[14]; p.w_proj_c = (const float*)d_in[15]; p.w_o = (const float*)d_in[16];
  p.ln1_g = (const float*)d_in[17]; p.ln1_b = (const float*)d_in[18]; p.w_up = (const float*)d_in[19]; p.conv_w = (const float*)d_in[20]; p.conv_b = (const float*)d_in[21];
  p.w_down = (const float*)d_in[22]; p.ln2_g = (const float*)d_in[23]; p.ln2_b = (const float*)d_in[24];
  p.out = (float*)d_out; p.ws = (unsigned char*)d_ws;
  void* args[] = {&p};
  hipError_t e = hipLaunchCooperativeKernel((void*)mega, dim3(grid_blocks), dim3(512), args, kDynLds, stream);
  if (e != hipSuccess) fprintf(stderr, "cooperative launch failed: %s (grid %d)\n", hipGetErrorString(e), grid_blocks);
}
```

```cpp
#include <hip/hip_runtime.h>
#include <hip/hip_cooperative_groups.h>
#include <cstdio>
namespace cg = cooperative_groups;

#define LAS __attribute__((address_space(3)))
typedef unsigned short bf16_t;
typedef short bf16x8 __attribute__((ext_vector_type(8)));
typedef short v4i16_t __attribute__((ext_vector_type(4)));
typedef float f32x4 __attribute__((ext_vector_type(4)));
typedef float f32x2 __attribute__((ext_vector_type(2)));
typedef float f32x16 __attribute__((ext_vector_type(16)));
typedef unsigned u32x4 __attribute__((ext_vector_type(4)));
typedef unsigned u32x2 __attribute__((ext_vector_type(2)));

constexpr int NTOK = 16384, SEQ = 4096, DM = 2048;
constexpr int LDH = 4416, NHP = 4608;
constexpr int C_QA = 0, C_KA = 1024, C_VA = 1152, C_KR = 1280, C_HU = 1344, C_CQ = 2368, C_CKV = 2880, C_HV = 3392;
constexpr int NG = 6144, NQ = 3072, NKV = 4096, NUP = 11264, DFF = 5632, NIN = 10560;
constexpr float LOG2E = 1.4426950408889634f;
constexpr float ALPHA = 1.4142135623730951f;
constexpr float EPS = 1e-5f;
constexpr float SWA_QSCALE = 0.125f * LOG2E;
constexpr float MLA_QSCALE = 0.07216878364870322f * LOG2E;

__device__ const float INV_FREQ[32] = {1.000000000e+00f, 7.498942018e-01f, 5.623413324e-01f, 4.216965139e-01f, 3.162277639e-01f, 2.371373773e-01f, 1.778279394e-01f, 1.333521456e-01f, 1.000000015e-01f, 7.498942316e-02f, 5.623413250e-02f, 4.216964915e-02f, 3.162277490e-02f, 2.371373773e-02f, 1.778279431e-02f, 1.333521400e-02f, 9.999999776e-03f, 7.498942316e-03f, 5.623413250e-03f, 4.216964822e-03f, 3.162277630e-03f, 2.371373819e-03f, 1.778279431e-03f, 1.333521446e-03f, 1.000000047e-03f, 7.498941850e-04f, 5.623413017e-04f, 4.216965172e-04f, 3.162277571e-04f, 2.371373703e-04f, 1.778279402e-04f, 1.333521504e-04f};

constexpr size_t SZ_W = 76546048;
constexpr size_t O_WMAIN = 0, O_WG = 18874368, O_WUQ = O_WG + 25165824, O_WUKV = O_WUQ + 3145728, O_PA = O_WUKV + 4194304, O_PB = O_PA + 4194304, O_PC = O_PB + 8388608, O_WO = O_PC + 4194304;
constexpr size_t O_WUP = 0, O_WDN = 46137344;
constexpr size_t O_XB = SZ_W;
constexpr size_t O_XA = O_XB + 67108864;
constexpr size_t O_BIG = O_XA + 134217728;
constexpr size_t O_H = O_BIG, O_Q = O_H + 144703488, O_KV = O_Q + 100663296;
constexpr size_t O_ACT = O_BIG, O_SIDE = O_BIG + 184549376;
constexpr size_t O_CS = O_BIG + 379584512;
constexpr size_t O_ST = O_CS + 4194304;
constexpr size_t O_BAR = O_ST + 262144;
constexpr size_t WS_NEED = O_BAR + 16384;

struct Params {
  const float* x; const int* pos; const float* w_in; const float* b_gate; const float* sinks; const float* q_norm_g; const float* kv_norm_g;
  const float* w_uq; const float* w_ukv; const float* sgu_ln_g; const float* sgu_ln_b; const float* sgu_w; const float* sgu_b;
  const float* w_proj_a; const float* w_proj_b; const float* w_proj_c; const float* w_o; const float* ln1_g; const float* ln1_b;
  const float* w_up; const float* conv_w; const float* conv_b; const float* w_down; const float* ln2_g; const float* ln2_b;
  float* out; unsigned char* ws;
};

typedef const Params __attribute__((address_space(4)))* KP;
__device__ __forceinline__ int olane() { unsigned m = ~0u; asm volatile("" : "+s"(m)); return (int)__builtin_amdgcn_mbcnt_hi(m, __builtin_amdgcn_mbcnt_lo(m, 0u)); }
__device__ __forceinline__ int otid(int wv0) { int t = (wv0 << 6) | olane(); asm volatile("" : "+v"(t)); return t; }
__device__ __forceinline__ int obid() { int b = blockIdx.x; asm volatile("" : "+s"(b)); return b; }
__device__ __forceinline__ int ogrid() { int g = gridDim.x; asm volatile("" : "+s"(g)); return g; }
__device__ __forceinline__ unsigned pk2(float lo, float hi) {
  typedef __bf16 b2 __attribute__((ext_vector_type(2)));
  b2 r = __builtin_convertvector((f32x2){lo, hi}, b2);
  return __builtin_bit_cast(unsigned, r);
}
__device__ __forceinline__ float bf_lo(unsigned u) { return __uint_as_float(u << 16); }
__device__ __forceinline__ float bf_hi(unsigned u) { return __uint_as_float(u & 0xffff0000u); }
__device__ __forceinline__ float bf1(bf16_t u) { return __uint_as_float(((unsigned)u) << 16); }
__device__ __forceinline__ float fexp2(float x) { return __builtin_amdgcn_exp2f(x); }
__device__ __forceinline__ float frcp(float x) { return __builtin_amdgcn_rcpf(x); }
__device__ __forceinline__ float wave_sum(float v) {
#pragma unroll
  for (int o = 32; o > 0; o >>= 1) v += __shfl_xor(v, o);
  return v;
}
__device__ __forceinline__ float gelu1(float v) {
  const float av = __builtin_fabsf(v), d = av * 0.2316418882f + 1.0f;
  const float t = frcp(d);
  float q = t * 0.5307027145f + (-0.7265760135f); q = q * t + 0.7107068705f; q = q * t + (-0.142248368f); q = q * t + 0.127414796f; q = q * t;
  const float s = (v * v) * (-0.72134752044f);
  const float e = fexp2(s);
  const float m = v * (q * e), r = v - m;
  return v < 0.f ? m : r;
}
__device__ __forceinline__ f32x16 mfma32(bf16x8 a, bf16x8 b, f32x16 c) { return __builtin_amdgcn_mfma_f32_32x32x16_bf16(a, b, c, 0, 0, 0); }
__device__ __forceinline__ v4i16_t vtr(const LAS unsigned char* p) { return __builtin_amdgcn_ds_read_tr16_b64_v4i16((LAS v4i16_t*)p); }

namespace pg8 {
constexpr int BM = 256, BK = 64, HALF = 128, HTB = HALF * BK * 2, STAGE_BYTES = 8 * HTB, NXCD = 8, WGM = 8;
__device__ __forceinline__ int lds_byte(int r, int c) { const int st = (r >> 4) * 2 + (c >> 5), rr = r & 15, cc = c & 31, ob = rr * 64 + cc * 2; return st * 1024 + (ob ^ (((ob >> 9) & 1) << 5)); }
__device__ __forceinline__ void stage_rc(int b, int& R, int& C) { const int st = b / 1024, sb = b % 1024, swz = sb ^ (((sb >> 9) & 1) << 5); R = (st >> 1) * 16 + swz / 64; C = (st & 1) * 32 + (swz % 64) / 2; }
__device__ __forceinline__ int perm32(int rho) { const int n = rho >> 4, i = rho & 15; return 8 * (i >> 2) + 4 * n + (i & 3); }
struct Unit { int pm, pn; };
struct Gemm { const bf16_t* A; const bf16_t* Bt; int M, N, K, lda; };
struct StaticOrder {
  int nM, nN, nwg, G, c;
  __device__ void init(int M, int N, int G_, int c_) { nM = M / BM; nN = N / BM; nwg = nM * nN; G = G_; c = c_; }
  __device__ bool next(int i, Unit& u) const {
    const long L = (long)i * G + c; if (L >= nwg) return false;
    int wgid = (int)L; { const int q = nwg / NXCD, r = nwg % NXCD, xcd = wgid % NXCD, off = wgid / NXCD; wgid = (xcd < r ? xcd * (q + 1) : r * (q + 1) + (xcd - r) * q) + off; }
    const int nig = WGM * nN, gid = wgid / nig, fm = gid * WGM, gsz = (nM - fm) < WGM ? (nM - fm) : WGM;
    u.pm = fm + ((wgid % nig) % gsz); u.pn = (wgid % nig) / gsz; return true;
  }
};

template <class Epi>
__device__ __forceinline__ void gemm_phase(LAS unsigned char* lds, const Gemm g, const StaticOrder& S, const Epi& E, int wv0) {
  const int tid = otid(wv0), wid = __builtin_amdgcn_readfirstlane(tid >> 6), lane = tid & 63, wr = wid >> 2, wc = wid & 3, fr = lane & 15, fq = lane >> 4;
  const int K = g.K, nt = K / BK, lda = g.lda;
  unsigned voffA[2], voffB[2];
#pragma unroll
  for (int i = 0; i < 2; ++i) { int R, C; stage_rc(tid * 16 + i * 8192, R, C); const int Rb = (R & ~31) + perm32(R & 31);
    voffA[i] = (unsigned)(R * lda + C) * 2u; voffB[i] = (unsigned)(Rb * K + C) * 2u; }
  const size_t kstep = (size_t)(BK * 2);
  const size_t hstepA = (size_t)HALF * lda * 2, hstepB = (size_t)HALF * K * 2;
  const size_t tstepA = 2 * hstepA, tstepB = 2 * hstepB;
  const unsigned ldsw = (unsigned)wid * 1024u;
  const int aoff = lds_byte(wr * 64 + fr, fq * 8), boff = lds_byte(wc * 32 + fr, fq * 8);
#define PG8_SA(b, h) (((b) * 2 + (h)) * HTB)
#define PG8_SB(b, h) ((4 + (b) * 2 + (h)) * HTB)
#define PG8_STAGE(bufoff, gbase, voff) do { _Pragma("unroll") for (int _i = 0; _i < 2; ++_i) \
    __builtin_amdgcn_global_load_lds((const unsigned*)((const char*)(gbase) + (voff)[_i]), (LAS unsigned*)(lds + (bufoff) + ldsw + _i * 8192), 16, 0, 0); } while (0)
#define PG8_LDA(dst, b, h) do { _Pragma("unroll") for (int m = 0; m < 4; ++m) _Pragma("unroll") for (int k = 0; k < 2; ++k) dst[m][k] = *(const LAS bf16x8*)(lds + PG8_SA(b, h) + aoff + m * 2048 + k * 1024); } while (0)
#define PG8_LDB(dst, b, h) do { _Pragma("unroll") for (int n = 0; n < 2; ++n) _Pragma("unroll") for (int k = 0; k < 2; ++k) dst[n][k] = *(const LAS bf16x8*)(lds + PG8_SB(b, h) + boff + n * 2048 + k * 1024); } while (0)
#define PG8_MMA(ai, bj, At, Bt) do { __builtin_amdgcn_s_setprio(1); _Pragma("unroll") for (int m = 0; m < 4; ++m) _Pragma("unroll") for (int n = 0; n < 2; ++n) _Pragma("unroll") for (int k = 0; k < 2; ++k) \
    acc[ai][bj][m][n] = __builtin_amdgcn_mfma_f32_16x16x32_bf16(Bt[n][k], At[m][k], acc[ai][bj][m][n], 0, 0, 0); __builtin_amdgcn_s_setprio(0); } while (0)
#define PG8_WAIT_V(n) asm volatile("s_waitcnt vmcnt(" #n ")" ::: "memory")
#define PG8_WAIT_L(n) asm volatile("s_waitcnt lgkmcnt(" #n ")" ::: "memory")
#define PG8_BAR __builtin_amdgcn_s_barrier()
#define PG8_SCHED __builtin_amdgcn_sched_barrier(0)
  Unit cur, nxt; int ui = 0;
  if (!S.next(0, cur)) return;
  f32x4 acc[2][2][4][2];
#pragma unroll
  for (int a = 0; a < 2; ++a)
#pragma unroll
    for (int b = 0; b < 2; ++b)
#pragma unroll
      for (int m = 0; m < 4; ++m)
#pragma unroll
        for (int n = 0; n < 2; ++n) acc[a][b][m][n] = (f32x4){0.f, 0.f, 0.f, 0.f};
  bf16x8 At[4][2], B0[2][2], B1[2][2];
  const char* cA = (const char*)g.A + (size_t)cur.pm * tstepA; const char* cB = (const char*)g.Bt + (size_t)cur.pn * tstepB;
  PG8_STAGE(PG8_SB(0, 0), cB, voffB); PG8_STAGE(PG8_SA(0, 0), cA, voffA); PG8_STAGE(PG8_SB(0, 1), cB + hstepB, voffB); PG8_STAGE(PG8_SA(0, 1), cA + hstepA, voffA);
  if (wr == 1) PG8_BAR;
  PG8_WAIT_V(4); PG8_BAR;
  PG8_STAGE(PG8_SB(1, 0), cB + kstep, voffB); PG8_STAGE(PG8_SA(1, 0), cA + kstep, voffA); PG8_STAGE(PG8_SB(1, 1), cB + hstepB + kstep, voffB);
  PG8_WAIT_V(6); PG8_BAR;
  for (;;) {
    const bool has_next = S.next(ui + 1, nxt);
    const char* nA = has_next ? (const char*)g.A + (size_t)nxt.pm * tstepA : cA; const char* nB = has_next ? (const char*)g.Bt + (size_t)nxt.pn * tstepB : cB;
    for (int t = 0; t < nt; t += 2) {
      const bool last = (t == nt - 2);
      const char* a1 = cA + (size_t)(t + 1) * kstep;
      const char* a2 = last ? nA : cA + (size_t)(t + 2) * kstep; const char* b2 = last ? nB : cB + (size_t)(t + 2) * kstep;
      const char* a3 = a2 + kstep; const char* b3 = b2 + kstep;
      PG8_LDB(B0, 0, 0); PG8_SCHED; PG8_LDA(At, 0, 0); PG8_STAGE(PG8_SA(1, 1), a1 + hstepA, voffA);
      PG8_WAIT_L(8); PG8_BAR; PG8_WAIT_L(0); PG8_MMA(0, 0, At, B0); PG8_BAR; PG8_SCHED;
      PG8_LDB(B1, 0, 1); PG8_STAGE(PG8_SB(0, 0), b2, voffB);
      PG8_BAR; PG8_WAIT_L(0); PG8_MMA(0, 1, At, B1); PG8_BAR;
      PG8_LDA(At, 0, 1); PG8_STAGE(PG8_SA(0, 0), a2, voffA);
      PG8_BAR; PG8_WAIT_L(0); PG8_MMA(1, 0, At, B0); PG8_BAR; PG8_SCHED;
      PG8_STAGE(PG8_SB(0, 1), b2 + hstepB, voffB);
      PG8_WAIT_V(6); PG8_BAR; PG8_MMA(1, 1, At, B1); PG8_BAR;
      PG8_LDB(B0, 1, 0); PG8_SCHED; PG8_LDA(At, 1, 0); PG8_STAGE(PG8_SA(0, 1), a2 + hstepA, voffA);
      PG8_WAIT_L(8); PG8_BAR; PG8_WAIT_L(0); PG8_MMA(0, 0, At, B0); PG8_BAR; PG8_SCHED;
      PG8_LDB(B1, 1, 1); PG8_STAGE(PG8_SB(1, 0), b3, voffB);
      PG8_BAR; PG8_WAIT_L(0); PG8_MMA(0, 1, At, B1); PG8_BAR;
      PG8_LDA(At, 1, 1); PG8_STAGE(PG8_SA(1, 0), a3, voffA);
      PG8_BAR; PG8_WAIT_L(0); PG8_MMA(1, 0, At, B0); PG8_BAR; PG8_SCHED;
      PG8_STAGE(PG8_SB(1, 1), b3 + hstepB, voffB);
      PG8_WAIT_V(6); PG8_BAR; PG8_MMA(1, 1, At, B1); PG8_BAR;
    }
    E(acc, cur, wr, wc, fr, fq);
    if (!has_next) break;
#pragma unroll
    for (int a = 0; a < 2; ++a)
#pragma unroll
      for (int b = 0; b < 2; ++b)
#pragma unroll
        for (int m = 0; m < 4; ++m)
#pragma unroll
          for (int n = 0; n < 2; ++n) acc[a][b][m][n] = (f32x4){0.f, 0.f, 0.f, 0.f};
    cur = nxt; cA = nA; cB = nB; ++ui;
  }
  PG8_WAIT_V(0);
  if (wr == 0) PG8_BAR;
  PG8_BAR;
#undef PG8_SA
#undef PG8_SB
#undef PG8_STAGE
#undef PG8_LDA
#undef PG8_LDB
#undef PG8_MMA
#undef PG8_WAIT_V
#undef PG8_WAIT_L
#undef PG8_BAR
#undef PG8_SCHED
}
}

struct EpiP { void* out; int ldo; const float* f0; const bf16_t* b0; float* facc; int aux; const float* f1; LAS unsigned char* ex; };
enum { E_MAIN = 0, E_GATE = 1, E_UQ = 2, E_UKV = 3, E_PROJ = 4, E_RES = 5, E_UP = 6, E_UPC = 7 };

__device__ __forceinline__ void rope8(float (&v)[8], const f32x2* cs) {
#pragma unroll
  for (int i = 0; i < 4; ++i) { const f32x2 c = cs[i]; const float x1 = v[2 * i], x2 = v[2 * i + 1]; v[2 * i] = x1 * c.x - x2 * c.y; v[2 * i + 1] = x2 * c.x + x1 * c.y; }
}
__device__ __forceinline__ void store8bf(bf16_t* dst, const float (&v)[8]) {
  u32x4 w; w.x = pk2(v[0], v[1]); w.y = pk2(v[2], v[3]); w.z = pk2(v[4], v[5]); w.w = pk2(v[6], v[7]);
  *(u32x4*)dst = w;
}


__device__ __forceinline__ float dpp_shr1(float x) { return __int_as_float(__builtin_amdgcn_update_dpp(0, __float_as_int(x), 0x111, 0xF, 0xF, true)); }
__device__ __forceinline__ float dpp_shr2(float x) { return __int_as_float(__builtin_amdgcn_update_dpp(0, __float_as_int(x), 0x112, 0xF, 0xF, true)); }
__device__ __forceinline__ float dpp_prev1(float prev, float cur) {
  const int t = __builtin_amdgcn_update_dpp(0, __float_as_int(prev), 0x121, 0xF, 0xF, false);
  return __int_as_float(__builtin_amdgcn_update_dpp(t, __float_as_int(cur), 0x111, 0xF, 0xF, false)); }
__device__ __forceinline__ float dpp_prev2(float prev, float cur) {
  const int t = __builtin_amdgcn_update_dpp(0, __float_as_int(prev), 0x122, 0xF, 0xF, false);
  return __int_as_float(__builtin_amdgcn_update_dpp(t, __float_as_int(cur), 0x112, 0xF, 0xF, false)); }
__device__ __forceinline__ float silu_mul(float g, float v) { return g * frcp(1.0f + fexp2(-g * LOG2E)) * v; }
__device__ __forceinline__ void epi_upc(const EpiP& e, const f32x4 (&acc)[2][2][4][2], const pg8::Unit& u, int wr, int wc, int fr, int fq) {
  LAS unsigned char* ex = e.ex;
  bf16_t* side = (bf16_t*)e.b0;
  const int lc0 = 32 * wc + 8 * fq;
#pragma unroll
  for (int ai = 0; ai < 2; ++ai)
#pragma unroll
    for (int m = 0; m < 4; ++m) {
      const int g = ai * 8 + wr * 4 + m;
#pragma unroll
      for (int bj = 0; bj < 2; ++bj) {
        u32x4 w; w.x = pk2(acc[ai][bj][m][0][0], acc[ai][bj][m][0][1]); w.y = pk2(acc[ai][bj][m][0][2], acc[ai][bj][m][0][3]);
        w.z = pk2(acc[ai][bj][m][1][0], acc[ai][bj][m][1][1]); w.w = pk2(acc[ai][bj][m][1][2], acc[ai][bj][m][1][3]);
        if (m == 3 && fr >= 14) *(LAS u32x4*)(ex + ((g * 2 + (fr - 14)) * 256 + bj * 128 + lc0) * 2) = w;
        const int ucol = bj * DFF + 128 * u.pn + lc0;
        if (g == 15 && fr >= 14) *(u32x4*)(side + ((size_t)u.pm * 4 + 2 + (fr - 14)) * NUP + ucol) = w;
        if (g == 0 && fr < 2) *(u32x4*)(side + ((size_t)u.pm * 4 + fr) * NUP + ucol) = w;
      }
    }
  asm volatile("s_waitcnt lgkmcnt(0)" ::: "memory");
  __builtin_amdgcn_s_barrier();
  __builtin_amdgcn_s_barrier();
  asm volatile("" ::: "memory");
  const float* cw = e.f0; const float* cb = e.f1;
  bf16_t* act = (bf16_t*)e.out;
#pragma unroll
  for (int n = 0; n < 2; ++n) {
    const int ch = 128 * u.pn + lc0 + 4 * n;
    const f32x4 wg0 = *(const f32x4*)(cw + ch), wg1 = *(const f32x4*)(cw + NUP + ch), wg2 = *(const f32x4*)(cw + 2 * NUP + ch), bg = *(const f32x4*)(cb + ch);
    const f32x4 wv0 = *(const f32x4*)(cw + DFF + ch), wv1 = *(const f32x4*)(cw + NUP + DFF + ch), wv2 = *(const f32x4*)(cw + 2 * NUP + DFF + ch), bv = *(const f32x4*)(cb + DFF + ch);
#pragma unroll
    for (int ai = 0; ai < 2; ++ai)
#pragma unroll
      for (int m = 0; m < 4; ++m) {
        const int g = ai * 8 + wr * 4 + m, gp = g > 0 ? g - 1 : 0;
        const f32x4 xg = acc[ai][0][m][n], xv = acc[ai][1][m][n];
        float y[4];
        if (m > 0) {
          const f32x4 pg = acc[ai][0][m - 1][n], pv = acc[ai][1][m - 1][n];
#pragma unroll
          for (int k = 0; k < 4; ++k) {
            const float g1 = dpp_prev1(pg[k], xg[k]), g2 = dpp_prev2(pg[k], xg[k]), v1 = dpp_prev1(pv[k], xv[k]), v2 = dpp_prev2(pv[k], xv[k]);
            const float cg = bg[k] + wg0[k] * g2 + wg1[k] * g1 + wg2[k] * xg[k];
            const float cv = bv[k] + wv0[k] * v2 + wv1[k] * v1 + wv2[k] * xv[k];
            y[k] = silu_mul(cg, cv);
          }
        } else {
          const LAS unsigned char* hp = ex + (gp * 2 * 256 + lc0 + 4 * n) * 2;
          const u32x2 hg14 = *(const LAS u32x2*)hp, hg15 = *(const LAS u32x2*)(hp + 512), hv14 = *(const LAS u32x2*)(hp + 256), hv15 = *(const LAS u32x2*)(hp + 512 + 256);
          const float h14g[4] = {bf_lo(hg14.x), bf_hi(hg14.x), bf_lo(hg14.y), bf_hi(hg14.y)}, h15g[4] = {bf_lo(hg15.x), bf_hi(hg15.x), bf_lo(hg15.y), bf_hi(hg15.y)};
          const float h14v[4] = {bf_lo(hv14.x), bf_hi(hv14.x), bf_lo(hv14.y), bf_hi(hv14.y)}, h15v[4] = {bf_lo(hv15.x), bf_hi(hv15.x), bf_lo(hv15.y), bf_hi(hv15.y)};
#pragma unroll
          for (int k = 0; k < 4; ++k) {
            float g1 = dpp_shr1(xg[k]), g2 = dpp_shr2(xg[k]), v1 = dpp_shr1(xv[k]), v2 = dpp_shr2(xv[k]);
            if (fr == 0) { g1 = h15g[k]; g2 = h14g[k]; v1 = h15v[k]; v2 = h14v[k]; }
            if (fr == 1) { g2 = h15g[k]; v2 = h15v[k]; }
            const float cg = bg[k] + wg0[k] * g2 + wg1[k] * g1 + wg2[k] * xg[k];
            const float cv = bv[k] + wv0[k] * v2 + wv1[k] * v1 + wv2[k] * xv[k];
            y[k] = silu_mul(cg, cv);
          }
        }
        const int row = u.pm * 256 + ai * 128 + wr * 64 + m * 16 + fr;
        if (!(g == 0 && fr < 2)) { u32x2 w; w.x = pk2(y[0], y[1]); w.y = pk2(y[2], y[3]); *(u32x2*)(act + (size_t)row * DFF + ch) = w; }
      }
    asm volatile("" ::: "memory");
  }
}
struct EpiPre { f32x4 a0, a1; u32x4 u0, u1; float s; };
__device__ __forceinline__ void rope8v(float (&v)[8], f32x4 c0, f32x4 c1) {
  const float cs[8] = {c0[0], c0[1], c0[2], c0[3], c1[0], c1[1], c1[2], c1[3]};
#pragma unroll
  for (int i = 0; i < 4; ++i) { const float x1 = v[2 * i], x2 = v[2 * i + 1]; v[2 * i] = x1 * cs[2 * i] - x2 * cs[2 * i + 1]; v[2 * i + 1] = x2 * cs[2 * i] + x1 * cs[2 * i + 1]; }
}
template <int MODE> struct Epi {
  EpiP e;
  __device__ __forceinline__ void preload(EpiPre& q, int row, int col) const {
    if (MODE == E_GATE || MODE == E_UKV) return;
    if (MODE == E_MAIN) {
      if (col >= C_KR && col < C_HU) { const float* cs = e.f0 + ((size_t)row * 32 + ((col - C_KR) >> 1)) * 2; q.a0 = *(const f32x4*)cs; q.a1 = *(const f32x4*)(cs + 4); }
    } else if (MODE == E_GATE) {
      q.a0 = *(const f32x4*)(e.f0 + col); q.a1 = *(const f32x4*)(e.f0 + col + 4);
    } else if (MODE == E_UQ) {
      const int c192 = col % 192;
      if (c192 >= 128) { const float* cs = e.facc + ((size_t)row * 32 + ((c192 - 128) >> 1)) * 2; q.a0 = *(const f32x4*)cs; q.a1 = *(const f32x4*)(cs + 4); }
    } else if (MODE == E_UKV) {
      q.s = ((const f32x4*)e.f0)[row].y;
    } else if (MODE == E_PROJ) {
      q.u0 = *(const u32x4*)(e.b0 + (size_t)row * NG + e.aux * DM + col);
      if (e.aux > 0) q.u1 = *(const u32x4*)((const bf16_t*)e.facc + (size_t)row * DM + col);
    } else if (MODE == E_RES) {
      const float* rs = e.f0 + (size_t)row * DM + col; q.a0 = *(const f32x4*)rs; q.a1 = *(const f32x4*)(rs + 4);
    }
  }
  __device__ __forceinline__ void emit(const EpiPre& q0, int row, int col, f32x4 a, f32x4 b, const f32x4 (&hb)[2][2], const float (&hs)[2][4], int ai_, int m_, int bj_) const {
    EpiPre q = q0;
    if (MODE == E_GATE) { q.a0 = hb[bj_][0]; q.a1 = hb[bj_][1]; }
    if (MODE == E_UQ || MODE == E_UKV) q.s = hs[ai_][m_];
    float v[8] = {a[0], a[1], a[2], a[3], b[0], b[1], b[2], b[3]};
    if (MODE == E_MAIN) {
      if (col >= LDH) return;
      if (col < C_KA) {
#pragma unroll
        for (int j = 0; j < 8; ++j) v[j] *= SWA_QSCALE;
      } else if (col >= C_KR && col < C_HU) {
        rope8v(v, q.a0, q.a1);
      } else if ((col >= C_HU && col < C_CQ) || col >= C_HV) {
#pragma unroll
        for (int j = 0; j < 8; ++j) v[j] = gelu1(v[j]);
      }
      store8bf((bf16_t*)e.out + (size_t)row * LDH + col, v);
    } else if (MODE == E_GATE) {
      const float bb[8] = {q.a0[0], q.a0[1], q.a0[2], q.a0[3], q.a1[0], q.a1[1], q.a1[2], q.a1[3]};
#pragma unroll
      for (int j = 0; j < 8; ++j) v[j] = frcp(1.0f + fexp2(__builtin_fmaf(v[j], -LOG2E, bb[j])));
      store8bf((bf16_t*)e.out + (size_t)row * NG + col, v);
    } else if (MODE == E_UQ) {
#pragma unroll
      for (int j = 0; j < 8; ++j) v[j] *= q.s;
      if (col % 192 >= 128) rope8v(v, q.a0, q.a1);
      store8bf((bf16_t*)e.out + (size_t)row * NQ + col, v);
    } else if (MODE == E_UKV) {
#pragma unroll
      for (int j = 0; j < 8; ++j) v[j] *= q.s;
      store8bf((bf16_t*)e.out + (size_t)row * NKV + col, v);
    } else if (MODE == E_PROJ) {
      const int br = e.aux; const u32x4 gw = q.u0;
      v[0] *= bf_lo(gw.x); v[1] *= bf_hi(gw.x); v[2] *= bf_lo(gw.y); v[3] *= bf_hi(gw.y);
      v[4] *= bf_lo(gw.z); v[5] *= bf_hi(gw.z); v[6] *= bf_lo(gw.w); v[7] *= bf_hi(gw.w);
      bf16_t* fa = (bf16_t*)e.facc + (size_t)row * DM + col;
      if (br > 0) { const u32x4 pw = q.u1;
        v[0] += bf_lo(pw.x); v[1] += bf_hi(pw.x); v[2] += bf_lo(pw.y); v[3] += bf_hi(pw.y); v[4] += bf_lo(pw.z); v[5] += bf_hi(pw.z); v[6] += bf_lo(pw.w); v[7] += bf_hi(pw.w); }
      if (br == 2) store8bf((bf16_t*)e.out + (size_t)row * DM + col, v);
      else store8bf(fa, v);
    } else if (MODE == E_RES) {
      const f32x4 r0 = q.a0, r1 = q.a1;
      float* o = (float*)e.out + (size_t)row * DM + col;
      *(f32x4*)o = (f32x4){ALPHA * r0[0] + v[0], ALPHA * r0[1] + v[1], ALPHA * r0[2] + v[2], ALPHA * r0[3] + v[3]};
      *(f32x4*)(o + 4) = (f32x4){ALPHA * r1[0] + v[4], ALPHA * r1[1] + v[5], ALPHA * r1[2] + v[6], ALPHA * r1[3] + v[7]};
    } else {
      store8bf((bf16_t*)e.out + (size_t)row * e.ldo + col, v);
    }
  }
  __device__ __forceinline__ void operator()(const f32x4 (&acc)[2][2][4][2], const pg8::Unit& u, int wr, int wc, int fr, int fq) const {
    if (MODE == E_UPC) { epi_upc(e, acc, u, wr, wc, fr, fq); return; }
    const int row0 = u.pm * 256 + wr * 64 + fr, col0 = u.pn * 256 + wc * 32 + 8 * fq;
    f32x4 hb[2][2]; float hs[2][4];
#pragma unroll
    for (int bj = 0; bj < 2; ++bj) { hb[bj][0] = (f32x4){0.f, 0.f, 0.f, 0.f}; hb[bj][1] = hb[bj][0];
      if (MODE == E_GATE) { hb[bj][0] = *(const f32x4*)(e.f0 + col0 + bj * 128) * (-LOG2E); hb[bj][1] = *(const f32x4*)(e.f0 + col0 + bj * 128 + 4) * (-LOG2E); } }
#pragma unroll
    for (int ai = 0; ai < 2; ++ai)
#pragma unroll
      for (int m = 0; m < 4; ++m) { hs[ai][m] = 0.f;
        if (MODE == E_UQ) hs[ai][m] = ((const f32x4*)e.f0)[row0 + ai * 128 + m * 16].x * MLA_QSCALE;
        if (MODE == E_UKV) hs[ai][m] = ((const f32x4*)e.f0)[row0 + ai * 128 + m * 16].y; }
    EpiPre q[2][4];
#pragma unroll
    for (int i = 0; i < 4; ++i) preload(q[0][i], row0 + (i >> 1) * 16, col0 + (i & 1) * 128);
#pragma unroll
    for (int gi = 0; gi < 4; ++gi) {
      const int ai = gi >> 1, mp = gi & 1;
      if (gi + 1 < 4) { const int ai2 = (gi + 1) >> 1, mp2 = (gi + 1) & 1;
#pragma unroll
        for (int i = 0; i < 4; ++i) preload(q[(gi + 1) & 1][i], row0 + ai2 * 128 + (2 * mp2 + (i >> 1)) * 16, col0 + (i & 1) * 128); }
      asm volatile("" ::: "memory");
#pragma unroll
      for (int i = 0; i < 4; ++i) { const int m = 2 * mp + (i >> 1), bj = i & 1; emit(q[gi & 1][i], row0 + ai * 128 + m * 16, col0 + bj * 128, acc[ai][bj][m][0], acc[ai][bj][m][1], hb, hs, ai, m, bj); }
      asm volatile("" ::: "memory");
    }
  }
};

template <int MODE>
__device__ __forceinline__ void run_gemm(LAS unsigned char* lds, const bf16_t* A, int lda, const bf16_t* Bt, int M, int N, int K, const EpiP& ep, int wv0) {
  pg8::Gemm g; g.A = A; g.Bt = Bt; g.M = M; g.N = N; g.K = K; g.lda = lda;
  pg8::StaticOrder S; S.init(M, N, ogrid(), obid());
  Epi<MODE> E; E.e = ep;
  pg8::gemm_phase(lds, g, S, E, wv0);
}

__device__ __forceinline__ int rope_src(int j) { return (j & 1) ? 32 + (j >> 1) : (j >> 1); }
__device__ __forceinline__ int srcmap(int kind, int n) {
  if (kind == 0) return n;
  if (kind == 1) {
    if (n < C_KR) return n;
    if (n < C_HU) return 2304 + rope_src(n - C_KR);
    if (n < C_CQ) return n - C_HU + 2368;
    if (n < C_CKV) return n - C_CQ + 1280;
    if (n < C_HV) return n - C_CKV + 1792;
    if (n < LDH) return n;
    return -1;
  }
  if (kind == 2) return 4416 + n;
  if (kind == 4) { const int pn = n >> 8, lc = n & 255; return lc < 128 ? 128 * pn + lc : DFF + 128 * pn + (lc - 128); }
  { const int hd = n / 192, c = n % 192; if (c < 128) return n; return hd * 192 + 128 + rope_src(c - 128); }
}
__device__ __forceinline__ void cvt_job(LAS unsigned char* lds, const float* src, bf16_t* dst, const float* kscale, int K, int Nsrc, int Ndst, int kind, int wv0, int bid_, int grd_) {
  LAS float* tile = (LAS float*)lds;
  const int tid = otid(wv0), nkt = K / 64, ntile = (Ndst / 64) * nkt;
  if (bid_ < 0) return;
  const int nl = tid & 63, kb = tid >> 6;
  float v[8];
#define CVT_LOAD(t_) do { const int k0_ = ((t_) % nkt) * 64, n0_ = ((t_) / nkt) * 64; const int sn = srcmap(kind, n0_ + nl); \
    _Pragma("unroll") for (int i = 0; i < 8; ++i) { const int kl = kb + 8 * i; v[i] = 0.f; \
      if (sn >= 0) { v[i] = src[(size_t)(k0_ + kl) * Nsrc + sn]; if (kscale) v[i] *= kscale[k0_ + kl]; } } } while (0)
  if (bid_ < ntile) CVT_LOAD(bid_);
  for (int t = bid_; t < ntile; t += grd_) {
    const int k0 = (t % nkt) * 64, n0 = (t / nkt) * 64;
#pragma unroll
    for (int i = 0; i < 8; ++i) tile[(kb + 8 * i) * 65 + nl] = v[i];
    __syncthreads();
    if (t + grd_ < ntile) CVT_LOAD(t + grd_);
    { const int nl2 = tid >> 3, kc = (tid & 7) * 8; float w[8];
#pragma unroll
      for (int j = 0; j < 8; ++j) w[j] = tile[(kc + j) * 65 + nl2];
      store8bf(dst + (size_t)(n0 + nl2) * K + k0 + kc, w); }
    __syncthreads();
  }
#undef CVT_LOAD
}
__device__ __forceinline__ void cvt_mixer_a(KP p, int l, LAS unsigned char* lds, int wv0) {
  unsigned char* W = p->ws; const int f = obid(), st = ogrid();
  cvt_job(lds, p->w_in + (size_t)l * DM * NIN, (bf16_t*)(W + O_WMAIN), nullptr, DM, NIN, NHP, 1, wv0, f, st);
  cvt_job(lds, p->w_in + (size_t)l * DM * NIN, (bf16_t*)(W + O_WG), nullptr, DM, NIN, NG, 2, wv0, f, st);
}
__device__ __forceinline__ void cvt_mixer_b(KP p, int l, LAS unsigned char* lds, int wv0, int f, int st) {
  unsigned char* W = p->ws;
  cvt_job(lds, p->w_uq + (size_t)l * 512 * NQ, (bf16_t*)(W + O_WUQ), p->q_norm_g + l * 512, 512, NQ, NQ, 3, wv0, f, st);
  cvt_job(lds, p->w_ukv + (size_t)l * 512 * NKV, (bf16_t*)(W + O_WUKV), p->kv_norm_g + l * 512, 512, NKV, NKV, 0, wv0, f, st);
  cvt_job(lds, p->w_proj_a + (size_t)l * 1024 * DM, (bf16_t*)(W + O_PA), nullptr, 1024, DM, DM, 0, wv0, f, st);
  cvt_job(lds, p->w_proj_b + (size_t)l * 2048 * DM, (bf16_t*)(W + O_PB), nullptr, 2048, DM, DM, 0, wv0, f, st);
  cvt_job(lds, p->w_proj_c + (size_t)l * 1024 * DM, (bf16_t*)(W + O_PC), nullptr, 1024, DM, DM, 0, wv0, f, st);
  cvt_job(lds, p->w_o + (size_t)l * DM * DM, (bf16_t*)(W + O_WO), nullptr, DM, DM, DM, 0, wv0, f, st);
}
__device__ __forceinline__ void cvt_ffn(KP p, int l, LAS unsigned char* lds, int wv0) {
  unsigned char* W = p->ws; const int f = obid(), st = ogrid();
  cvt_job(lds, p->w_up + (size_t)l * DM * NUP, (bf16_t*)(W + O_WUP), nullptr, DM, NUP, NUP, 4, wv0, f, st);
  cvt_job(lds, p->w_down + (size_t)l * DFF * DM, (bf16_t*)(W + O_WDN), nullptr, DFF, DM, DM, 0, wv0, f, st);
}

__device__ __forceinline__ void prologue(KP p, int wv0) {
  const size_t tid = (size_t)obid() * 512 + otid(wv0), nth = (size_t)ogrid() * 512;
  bf16_t* xb = (bf16_t*)(p->ws + O_XB);
  for (size_t i = tid; i < (size_t)NTOK * DM / 4; i += 4 * nth) {
    f32x4 v[4];
#pragma unroll
    for (int j = 0; j < 4; ++j) if (i + j * nth < (size_t)NTOK * DM / 4) v[j] = ((const f32x4*)p->x)[i + j * nth];
#pragma unroll
    for (int j = 0; j < 4; ++j) if (i + j * nth < (size_t)NTOK * DM / 4) { u32x2 w; w.x = pk2(v[j][0], v[j][1]); w.y = pk2(v[j][2], v[j][3]); ((u32x2*)xb)[i + j * nth] = w; } }
  f32x2* cs = (f32x2*)(p->ws + O_CS);
  for (size_t i = tid; i < (size_t)NTOK * 32; i += nth) {
    const int tok = (int)(i >> 5), f = (int)(i & 31);
    const float ang = (float)p->pos[tok] * INV_FREQ[f];
    double t = (double)ang * 0.15915494309189535; t -= __builtin_rint(t);
    const float tf = (float)t;
    cs[i] = (f32x2){__builtin_amdgcn_cosf(tf), __builtin_amdgcn_sinf(tf)};
  }
}

__device__ __forceinline__ void stats_phase(KP p, int wv0) {
  const bf16_t* h = (const bf16_t*)(p->ws + O_H); f32x4* st = (f32x4*)(p->ws + O_ST);
  const int tid_ = otid(wv0); const int lane = tid_ & 63, wv = obid() * 8 + (tid_ >> 6), nwv = ogrid() * 8;
  for (int row0 = wv; row0 < NTOK; row0 += 4 * nwv) {
    u32x4 a[4], b[4], v0[4], v1[4];
#pragma unroll
    for (int k = 0; k < 4; ++k) { const int row = row0 + k * nwv < NTOK ? row0 + k * nwv : row0; const bf16_t* hr = h + (size_t)row * LDH;
      a[k] = *(const u32x4*)(hr + C_CQ + lane * 8); b[k] = *(const u32x4*)(hr + C_CKV + lane * 8);
      v0[k] = *(const u32x4*)(hr + C_HV + lane * 16); v1[k] = *(const u32x4*)(hr + C_HV + lane * 16 + 8); }
    float sa[4], sb[4], sv[4], sq[4], mu[4];
#pragma unroll
    for (int k = 0; k < 4; ++k) { sa[k] = 0.f; sb[k] = 0.f; sv[k] = 0.f;
#pragma unroll
      for (int j = 0; j < 4; ++j) { float x0 = bf_lo(a[k][j]), x1 = bf_hi(a[k][j]); sa[k] += x0 * x0 + x1 * x1; x0 = bf_lo(b[k][j]); x1 = bf_hi(b[k][j]); sb[k] += x0 * x0 + x1 * x1;
        sv[k] += bf_lo(v0[k][j]) + bf_hi(v0[k][j]) + bf_lo(v1[k][j]) + bf_hi(v1[k][j]); } }
#pragma unroll
    for (int o = 32; o > 0; o >>= 1)
#pragma unroll
      for (int k = 0; k < 4; ++k) { sa[k] += __shfl_xor(sa[k], o); sb[k] += __shfl_xor(sb[k], o); sv[k] += __shfl_xor(sv[k], o); }
#pragma unroll
    for (int k = 0; k < 4; ++k) { mu[k] = sv[k] * (1.0f / 1024.0f); sq[k] = 0.f;
#pragma unroll
      for (int j = 0; j < 4; ++j) { float d;
        d = bf_lo(v0[k][j]) - mu[k]; sq[k] += d * d; d = bf_hi(v0[k][j]) - mu[k]; sq[k] += d * d; d = bf_lo(v1[k][j]) - mu[k]; sq[k] += d * d; d = bf_hi(v1[k][j]) - mu[k]; sq[k] += d * d; } }
#pragma unroll
    for (int o = 32; o > 0; o >>= 1)
#pragma unroll
      for (int k = 0; k < 4; ++k) sq[k] += __shfl_xor(sq[k], o);
#pragma unroll
    for (int k = 0; k < 4; ++k) if (lane == 0 && row0 + k * nwv < NTOK)
      st[row0 + k * nwv] = (f32x4){__builtin_amdgcn_rsqf(sa[k] * (1.0f / 512.0f) + EPS), __builtin_amdgcn_rsqf(sb[k] * (1.0f / 512.0f) + EPS), mu[k], __builtin_amdgcn_rsqf(sq[k] * (1.0f / 1024.0f) + EPS)};
  }
}

__device__ __forceinline__ void ln_phase(const float* in, float* outf, bf16_t* outb, const float* g, const float* b, int wv0) {
  const int tid_ = otid(wv0); const int lane = tid_ & 63, wv = obid() * 8 + (tid_ >> 6), nwv = ogrid() * 8;
  f32x4 gg[8], bb[8];
#pragma unroll
  for (int i = 0; i < 8; ++i) { gg[i] = ((const f32x4*)g)[i * 64 + lane]; bb[i] = ((const f32x4*)b)[i * 64 + lane]; }
  f32x4 vn[8];
  if (wv < NTOK) { const f32x4* ir = (const f32x4*)(in + (size_t)wv * DM);
#pragma unroll
    for (int i = 0; i < 8; ++i) vn[i] = ir[i * 64 + lane]; }
  for (int row = wv; row < NTOK; row += nwv) {
    f32x4 v[8]; float s = 0.f;
#pragma unroll
    for (int i = 0; i < 8; ++i) v[i] = vn[i];
    if (row + nwv < NTOK) { const f32x4* ir = (const f32x4*)(in + (size_t)(row + nwv) * DM);
#pragma unroll
      for (int i = 0; i < 8; ++i) vn[i] = ir[i * 64 + lane]; }
#pragma unroll
    for (int i = 0; i < 8; ++i) s += v[i][0] + v[i][1] + v[i][2] + v[i][3];
    s = wave_sum(s); const float mu = s * (1.0f / 2048.0f);
    float sq = 0.f;
#pragma unroll
    for (int i = 0; i < 8; ++i) { v[i] -= mu; sq += v[i][0] * v[i][0] + v[i][1] * v[i][1] + v[i][2] * v[i][2] + v[i][3] * v[i][3]; }
    sq = wave_sum(sq); const float rstd = __builtin_amdgcn_rsqf(sq * (1.0f / 2048.0f) + EPS);
#pragma unroll
    for (int i = 0; i < 8; ++i) {
      const f32x4 y = v[i] * rstd * gg[i] + bb[i];
      ((f32x4*)(outf + (size_t)row * DM))[i * 64 + lane] = y;
      if (outb) { u32x2 w; w.x = pk2(y[0], y[1]); w.y = pk2(y[2], y[3]); ((u32x2*)(outb + (size_t)row * DM))[i * 64 + lane] = w; } }
  }
}

template <int NQK, int NDV, int KSTR, int VSTR>
__device__ __forceinline__ void attn_tile(const bf16x8 (&qf)[NQK], f32x16 (&o)[NDV], float& m, float& l, const LAS unsigned char* Kt, const LAS unsigned char* Vt,
                                          int lane, int qpos, int kpos0, int window, bool domask) {
  const int c = lane & 31, h = lane >> 5;
  f32x16 s0, s1;
#pragma unroll
  for (int r = 0; r < 16; ++r) { s0[r] = 0.f; s1[r] = 0.f; }
  const LAS unsigned char* ka = Kt + c * KSTR + h * 16;
  bf16x8 kc0 = *(const LAS bf16x8*)(ka), kc1 = *(const LAS bf16x8*)(ka + 32 * KSTR);
  __builtin_amdgcn_s_setprio(1);
#pragma unroll
  for (int st = 0; st < NQK; ++st) {
    bf16x8 kn0 = kc0, kn1 = kc1;
    if (st + 1 < NQK) { kn0 = *(const LAS bf16x8*)(ka + (st + 1) * 32); kn1 = *(const LAS bf16x8*)(ka + 32 * KSTR + (st + 1) * 32); }
    s0 = mfma32(kc0, qf[st], s0);
    s1 = mfma32(kc1, qf[st], s1);
    if (st + 1 < NQK) __builtin_amdgcn_sched_group_barrier(0x100, 2, 0);
    __builtin_amdgcn_sched_group_barrier(0x008, 2, 0);
    __builtin_amdgcn_sched_barrier(0);
    kc0 = kn0; kc1 = kn1;
  }
  __builtin_amdgcn_s_setprio(0);
  __builtin_amdgcn_sched_barrier(0);
  if (domask) {
#pragma unroll
    for (int r = 0; r < 16; ++r) { const int kp = kpos0 + (r & 3) + 8 * (r >> 2) + 4 * h;
      const bool v0 = (kp <= qpos) && (kp > qpos - window) && (kp >= 0);
      const bool v1 = (kp + 32 <= qpos) && (kp + 32 > qpos - window) && (kp + 32 >= 0);
      s0[r] = v0 ? s0[r] : -1e30f; s1[r] = v1 ? s1[r] : -1e30f; }
  }
  float mx = fmaxf(s0[0], s1[0]);
#pragma unroll
  for (int r = 1; r < 16; ++r) mx = fmaxf(mx, fmaxf(s0[r], s1[r]));
  mx = fmaxf(mx, __shfl_xor(mx, 32));
  if (__builtin_amdgcn_ballot_w64(mx > m + 8.0f) != 0ull) {
    const float mn = fmaxf(m, mx), alpha = fexp2(m - mn);
    m = mn; l *= alpha;
#pragma unroll
    for (int d = 0; d < NDV; ++d) o[d] *= alpha;
  }
  float ps = 0.f;
#pragma unroll
  for (int r = 0; r < 16; ++r) { s0[r] = fexp2(s0[r] - m); s1[r] = fexp2(s1[r] - m); ps += s0[r] + s1[r]; }
  l += ps;
  bf16x8 pf[4];
#pragma unroll
  for (int s = 0; s < 2; ++s) {
    u32x4 w0, w1;
    w0.x = pk2(s0[8 * s + 0], s0[8 * s + 1]); w0.y = pk2(s0[8 * s + 2], s0[8 * s + 3]); w0.z = pk2(s0[8 * s + 4], s0[8 * s + 5]); w0.w = pk2(s0[8 * s + 6], s0[8 * s + 7]);
    w1.x = pk2(s1[8 * s + 0], s1[8 * s + 1]); w1.y = pk2(s1[8 * s + 2], s1[8 * s + 3]); w1.z = pk2(s1[8 * s + 4], s1[8 * s + 5]); w1.w = pk2(s1[8 * s + 6], s1[8 * s + 7]);
    pf[s] = __builtin_bit_cast(bf16x8, w0); pf[2 + s] = __builtin_bit_cast(bf16x8, w1);
  }
  __builtin_amdgcn_sched_barrier(0);
  const int i16 = lane & 15, g16 = (lane >> 4) & 1;
  const LAS unsigned char* va = Vt + (4 * h + (i16 >> 2)) * VSTR + (16 * g16 + 4 * (i16 & 3)) * 2;
  bf16x8 vc[NDV];
#pragma unroll
  for (int d = 0; d < NDV; ++d) { const v4i16_t lo = vtr(va + d * 64), hi = vtr(va + 8 * VSTR + d * 64); vc[d] = __builtin_shufflevector(lo, hi, 0, 1, 2, 3, 4, 5, 6, 7); }
  __builtin_amdgcn_s_setprio(1);
#pragma unroll
  for (int ks = 0; ks < 4; ++ks) {
    bf16x8 vn[NDV];
#pragma unroll
    for (int d = 0; d < NDV; ++d) { vn[d] = vc[d];
      if (ks + 1 < 4) { const v4i16_t lo = vtr(va + (16 * (ks + 1)) * VSTR + d * 64), hi = vtr(va + (16 * (ks + 1) + 8) * VSTR + d * 64); vn[d] = __builtin_shufflevector(lo, hi, 0, 1, 2, 3, 4, 5, 6, 7); } }
#pragma unroll
    for (int d = 0; d < NDV; ++d) o[d] = mfma32(vc[d], pf[ks], o[d]);
    if (ks + 1 < 4) __builtin_amdgcn_sched_group_barrier(0x100, 2 * NDV, 0);
    __builtin_amdgcn_sched_group_barrier(0x008, NDV, 0);
    __builtin_amdgcn_sched_barrier(0);
#pragma unroll
    for (int d = 0; d < NDV; ++d) vc[d] = vn[d];
  }
  __builtin_amdgcn_s_setprio(0);
}

__device__ __forceinline__ void mla_phase(KP p, LAS unsigned char* lds, int wv0) {
  constexpr int KSTR = 400, VSTR = 320, KB = 64 * KSTR, VB = 64 * VSTR;
  const bf16_t* q = (const bf16_t*)(p->ws + O_Q); const bf16_t* kv = (const bf16_t*)(p->ws + O_KV);
  bf16_t* h = (bf16_t*)(p->ws + O_H);
  const int tid = otid(wv0), wid = __builtin_amdgcn_readfirstlane(tid >> 6), lane = tid & 63, c = lane & 31, hh = lane >> 5;
  const int G = ogrid(), bid = obid();
  for (int k = 0; k * G < 1024; ++k) {
    const int idx = (k & 1) ? (G - 1 - bid) : bid, rank = k * G + idx;
    if (rank >= 1024) continue;
    const int qb = 15 - rank / 64, bh = rank % 64, b = bh >> 4, hd = bh & 15;
    const int tok0 = b * SEQ, q0 = qb * 256 + 32 * wid;
    bf16x8 qf[12];
    { const bf16_t* qrow = q + (size_t)(tok0 + q0 + c) * NQ + hd * 192 + 8 * hh;
#pragma unroll
      for (int st = 0; st < 12; ++st) qf[st] = *(const bf16x8*)(qrow + 16 * st); }
    f32x16 o[4];
#pragma unroll
    for (int d = 0; d < 4; ++d)
#pragma unroll
      for (int r = 0; r < 16; ++r) o[d][r] = 0.f;
    float m = -1e30f, l = 0.f;
    const int ntiles = qb * 4 + 4;
    unsigned ksrc[3]; int kdst[3];
    const unsigned char* wsb = p->ws;
#pragma unroll
    for (int i = 0; i < 3; ++i) { const int cid = tid + 512 * i, key = cid / 24, ch = cid % 24;
      ksrc[i] = (ch < 16) ? (unsigned)(O_KV + ((size_t)(tok0 + key) * NKV + hd * 256 + ch * 8) * 2) : (unsigned)(O_H + ((size_t)(tok0 + key) * LDH + C_KR + (ch - 16) * 8) * 2);
      kdst[i] = key * KSTR + ch * 16; }
    const unsigned kinc0 = 64u * NKV * 2u, kinc1 = 64u * LDH * 2u;
    const bool k2rope = ((tid + 1024) % 24) >= 16, k1rope = ((tid + 512) % 24) >= 16, k0rope = (tid % 24) >= 16;
    unsigned vsrc[2]; int vdst[2];
#pragma unroll
    for (int i = 0; i < 2; ++i) { const int cid = tid + 512 * i, key = cid >> 4, ch = cid & 15;
      vsrc[i] = (unsigned)(O_KV + ((size_t)(tok0 + key) * NKV + hd * 256 + 128 + ch * 8) * 2); vdst[i] = key * VSTR + ch * 16; }
    u32x4 kr0 = *(const u32x4*)(wsb + ksrc[0]), kr1 = *(const u32x4*)(wsb + ksrc[1]), kr2 = *(const u32x4*)(wsb + ksrc[2]), vr0 = *(const u32x4*)(wsb + vsrc[0]), vr1 = *(const u32x4*)(wsb + vsrc[1]);
    for (int kt = 0; kt < ntiles; ++kt) {
      LAS unsigned char* Kb = lds + (kt & 1) * KB; LAS unsigned char* Vb = lds + 2 * KB + (kt & 1) * VB;
      *(LAS u32x4*)(Kb + kdst[0]) = kr0; *(LAS u32x4*)(Kb + kdst[1]) = kr1; *(LAS u32x4*)(Kb + kdst[2]) = kr2;
      *(LAS u32x4*)(Vb + vdst[0]) = vr0; *(LAS u32x4*)(Vb + vdst[1]) = vr1;
      __syncthreads();
      if (kt + 1 < ntiles) {
        ksrc[0] += k0rope ? kinc1 : kinc0; ksrc[1] += k1rope ? kinc1 : kinc0; ksrc[2] += k2rope ? kinc1 : kinc0; vsrc[0] += kinc0; vsrc[1] += kinc0;
        kr0 = *(const u32x4*)(wsb + ksrc[0]); kr1 = *(const u32x4*)(wsb + ksrc[1]); kr2 = *(const u32x4*)(wsb + ksrc[2]); vr0 = *(const u32x4*)(wsb + vsrc[0]); vr1 = *(const u32x4*)(wsb + vsrc[1]);
      }
      const int k0 = kt * 64;
      if (k0 <= q0 + 31) attn_tile<12, 4, KSTR, VSTR>(qf, o, m, l, Kb, Vb, lane, q0 + c, k0, 1 << 30, k0 + 63 > q0);
    }
    const float inv = frcp(l + __shfl_xor(l, 32));
    bf16_t* yrow = h + (size_t)(tok0 + q0 + c) * LDH + C_CQ + hd * 128 + 4 * hh;
#pragma unroll
    for (int d = 0; d < 4; ++d)
#pragma unroll
      for (int g = 0; g < 4; ++g) { u32x2 w; w.x = pk2(o[d][4 * g] * inv, o[d][4 * g + 1] * inv); w.y = pk2(o[d][4 * g + 2] * inv, o[d][4 * g + 3] * inv);
        *(u32x2*)(yrow + 32 * d + 8 * g) = w; }
    __syncthreads();
  }
}

__device__ __forceinline__ void swa_phase(KP p, int l, LAS unsigned char* lds, int wv0, int dummy = 0) {
  constexpr int STR = 144, VST = 192, TB = 64 * VST;
  bf16_t* h = (bf16_t*)(p->ws + O_H);
  const int tid = otid(wv0), wid = __builtin_amdgcn_readfirstlane(tid >> 6), lane = tid & 63, c = lane & 31, hh = lane >> 5;
  const int bid_ = obid(), grd_ = ogrid();
  for (int it = bid_; it < 512; it += grd_) {
    const int b = it >> 7, r = it & 127, kvh = r >> 6, qblk = r & 63, t0 = qblk * 64, hq = kvh * 8 + wid;
    const size_t tokb = (size_t)b * SEQ;
    bf16x8 qf[2][4];
    bf16_t* qrow0 = h + (tokb + t0 + c) * LDH + C_QA + hq * 64;
#pragma unroll
    for (int sub = 0; sub < 2; ++sub)
#pragma unroll
      for (int st = 0; st < 4; ++st) qf[sub][st] = *(const bf16x8*)(qrow0 + (size_t)sub * 32 * LDH + 16 * st + 8 * hh);
    { const int key = tid >> 3, ch = tid & 7;
#pragma unroll
      for (int j = 0; j < 3; ++j) { int kp = t0 - 128 + 64 * j + key; kp = kp < 0 ? 0 : kp;
        const bf16_t* src = h + (tokb + kp) * LDH + C_KA + kvh * 64 + ch * 8;
        *(LAS u32x4*)(lds + j * 2 * TB + key * STR + ch * 16) = *(const u32x4*)src;
        *(LAS u32x4*)(lds + j * 2 * TB + TB + key * VST + ch * 16) = *(const u32x4*)(src + (C_VA - C_KA)); } }
    __syncthreads();
    const float sink2 = p->sinks[l * 16 + hq] * LOG2E;
#pragma unroll
    for (int sub = 0; sub < 2; ++sub) {
      float m = sink2, ls = 0.f;
      f32x16 o[2];
#pragma unroll
      for (int d = 0; d < 2; ++d)
#pragma unroll
        for (int rr = 0; rr < 16; ++rr) o[d][rr] = 0.f;
      const int qpos = t0 + 32 * sub + c;
#pragma unroll
      for (int j = 0; j < 3; ++j) { const int k0 = t0 - 128 + 64 * j;
        if (k0 + 63 >= 0 && k0 + 63 >= t0 + 32 * sub - 127 && k0 <= t0 + 32 * sub + 31)
          attn_tile<4, 2, STR, VST>(qf[sub], o, m, ls, lds + j * 2 * TB, lds + j * 2 * TB + TB, lane, qpos, k0, 128, true); }
      const float inv = frcp(ls + __shfl_xor(ls, 32) + fexp2(sink2 - m));
      bf16_t* qrow = qrow0 + (size_t)sub * 32 * LDH;
#pragma unroll
      for (int d = 0; d < 2; ++d)
#pragma unroll
        for (int g = 0; g < 4; ++g) { u32x2 w; w.x = pk2(o[d][4 * g] * inv, o[d][4 * g + 1] * inv); w.y = pk2(o[d][4 * g + 2] * inv, o[d][4 * g + 3] * inv);
          bf16_t* dst_ = dummy ? (bf16_t*)(p->ws + O_Q) + (tokb + t0 + 32 * sub + c) * 1024 + hq * 64 : qrow; *(u32x2*)(dst_ + 32 * d + 8 * g + 4 * hh) = w; }
    }
    __syncthreads();
  }
}

__device__ __forceinline__ void sgu_phase(KP p, int l, LAS unsigned char* lds, int wv0, int dummy = 0) {
  constexpr int STR = 272;
  bf16_t* h = (bf16_t*)(p->ws + O_H); const f32x4* st = (const f32x4*)(p->ws + O_ST);
  LAS unsigned char* Wl = lds; LAS unsigned char* Vl = lds + 128 * STR;
  const int tid = otid(wv0), wid = __builtin_amdgcn_readfirstlane(tid >> 6), lane = tid & 63, c = lane & 31, hh = lane >> 5;
  const int bid_ = obid(), grd_ = ogrid();
  int gprev = -1;
  for (int it = bid_; it < 1024; it += grd_) {
    const int cidx = it >> 3, g = it & 7, tb0 = cidx * 128;
    if (g != gprev) {
      gprev = g;
      const float* wg = p->sgu_w + ((size_t)l * 8 + g) * 128 * 128;
#pragma unroll
      for (int i = 0; i < 8; ++i) { const int idx = tid + 512 * i, t = idx >> 5, s4 = (idx & 31) * 4;
        const f32x4 v = *(const f32x4*)(wg + t * 128 + s4);
        u32x2 w; w.x = pk2(s4 <= t ? v[0] : 0.f, s4 + 1 <= t ? v[1] : 0.f); w.y = pk2(s4 + 2 <= t ? v[2] : 0.f, s4 + 3 <= t ? v[3] : 0.f);
        *(LAS u32x2*)(Wl + t * STR + s4 * 2) = w; }
    }
#pragma unroll
    for (int i = 0; i < 4; ++i) { const int cid = tid + 512 * i, s = cid >> 4, ch = cid & 15;
      const u32x4 hv = *(const u32x4*)(h + (size_t)(tb0 + s) * LDH + C_HV + g * 128 + ch * 8);
      const f32x4 sv = st[tb0 + s]; const float mu = sv.z, rstd = sv.w;
      const float* lg = p->sgu_ln_g + l * 1024 + g * 128 + ch * 8; const float* lb = p->sgu_ln_b + l * 1024 + g * 128 + ch * 8;
      const f32x4 g0 = *(const f32x4*)lg, g1 = *(const f32x4*)(lg + 4), b0 = *(const f32x4*)lb, b1 = *(const f32x4*)(lb + 4);
      u32x4 w;
      w.x = pk2((bf_lo(hv.x) - mu) * rstd * g0[0] + b0[0], (bf_hi(hv.x) - mu) * rstd * g0[1] + b0[1]);
      w.y = pk2((bf_lo(hv.y) - mu) * rstd * g0[2] + b0[2], (bf_hi(hv.y) - mu) * rstd * g0[3] + b0[3]);
      w.z = pk2((bf_lo(hv.z) - mu) * rstd * g1[0] + b1[0], (bf_hi(hv.z) - mu) * rstd * g1[1] + b1[1]);
      w.w = pk2((bf_lo(hv.w) - mu) * rstd * g1[2] + b1[2], (bf_hi(hv.w) - mu) * rstd * g1[3] + b1[3]);
      *(LAS u32x4*)(Vl + s * STR + ch * 16) = w; }
    __syncthreads();
    const int tblk = wid >> 1, cb0 = (wid & 1) * 2;
    f32x16 acc[2];
#pragma unroll
    for (int d = 0; d < 2; ++d)
#pragma unroll
      for (int r = 0; r < 16; ++r) acc[d][r] = 0.f;
    const int i16 = lane & 15, g16 = (lane >> 4) & 1;
    const LAS unsigned char* wa = Wl + (32 * tblk + c) * STR + hh * 16;
    const LAS unsigned char* va = Vl + (8 * hh + (i16 >> 2)) * STR + (32 * cb0 + 16 * g16 + 4 * (i16 & 3)) * 2;
#pragma unroll
    for (int s = 0; s < 8; ++s) {
      const bf16x8 a = *(const LAS bf16x8*)(wa + s * 32);
#pragma unroll
      for (int d = 0; d < 2; ++d) {
        const v4i16_t lo = vtr(va + (16 * s) * STR + d * 64);
        const v4i16_t hi = vtr(va + (16 * s + 4) * STR + d * 64);
        const bf16x8 bfr = __builtin_shufflevector(lo, hi, 0, 1, 2, 3, 4, 5, 6, 7);
        acc[d] = mfma32(a, bfr, acc[d]);
      }
    }
    const float* sb = p->sgu_b + ((size_t)l * 8 + g) * 128;
    float uu[2][16], sbv[16];
#pragma unroll
    for (int r = 0; r < 16; ++r) { const int t = 32 * tblk + (r & 3) + 8 * (r >> 2) + 4 * hh; sbv[r] = sb[t];
#pragma unroll
      for (int d = 0; d < 2; ++d) uu[d][r] = bf1(h[(size_t)(tb0 + t) * LDH + C_HU + g * 128 + 32 * (cb0 + d) + c]); }
    asm volatile("" ::: "memory");
#pragma unroll
    for (int d = 0; d < 2; ++d)
#pragma unroll
      for (int r = 0; r < 16; ++r) { const int t = 32 * tblk + (r & 3) + 8 * (r >> 2) + 4 * hh, cc = 32 * (cb0 + d) + c;
        bf16_t* up = h + (size_t)(tb0 + t) * LDH + C_HU + g * 128 + cc;
        const float y = uu[d][r] * (acc[d][r] + sbv[r]);
        bf16_t* dst_ = dummy ? (bf16_t*)p->out + (size_t)(tb0 + t) * 1024 + g * 128 + cc : up; *dst_ = (bf16_t)(pk2(y, 0.f) & 0xffffu); }
    __syncthreads();
  }
}

__device__ __forceinline__ void fixup_phase(KP p, int l, int wv0) {
  const bf16_t* side = (const bf16_t*)(p->ws + O_SIDE); bf16_t* act = (bf16_t*)(p->ws + O_ACT);
  const float* cw = p->conv_w + (size_t)l * 3 * NUP; const float* cb = p->conv_b + (size_t)l * NUP;
  const int ntask = 704 * 128;
  const int id0_ = obid() * 512 + otid(wv0), idst_ = ogrid() * 512;
  for (int id = id0_; id < ntask; id += idst_) {
    const int cgp = id % 704, rk = id / 704, k = rk >> 1, rr = rk & 1, c0 = cgp * 8, t = (k * 256 + rr) & (SEQ - 1);
    const bf16_t* s0p = side + ((size_t)k * 4 + rr) * NUP;
    const bf16_t* s1p = rr ? side + ((size_t)k * 4) * NUP : side + ((size_t)(k > 0 ? k - 1 : 0) * 4 + 3) * NUP;
    const bf16_t* s2p = side + ((size_t)(k > 0 ? k - 1 : 0) * 4 + (rr ? 3 : 2)) * NUP;
    const float m1 = (t >= 1) ? 1.f : 0.f, m2 = (t >= 2) ? 1.f : 0.f;
    float y[8];
#pragma unroll
    for (int hf = 0; hf < 2; ++hf) {
      const int c = c0 + 4 * hf;
      const u32x2 a0 = *(const u32x2*)(s0p + c), a1 = *(const u32x2*)(s1p + c), a2 = *(const u32x2*)(s2p + c);
      const u32x2 d0 = *(const u32x2*)(s0p + DFF + c), d1 = *(const u32x2*)(s1p + DFF + c), d2 = *(const u32x2*)(s2p + DFF + c);
      const f32x4 wg0 = *(const f32x4*)(cw + c), wg1 = *(const f32x4*)(cw + NUP + c), wg2 = *(const f32x4*)(cw + 2 * NUP + c), bg = *(const f32x4*)(cb + c);
      const f32x4 wv0_ = *(const f32x4*)(cw + DFF + c), wv1 = *(const f32x4*)(cw + NUP + DFF + c), wv2 = *(const f32x4*)(cw + 2 * NUP + DFF + c), bv = *(const f32x4*)(cb + DFF + c);
      const float g0[4] = {bf_lo(a0.x), bf_hi(a0.x), bf_lo(a0.y), bf_hi(a0.y)}, g1[4] = {bf_lo(a1.x), bf_hi(a1.x), bf_lo(a1.y), bf_hi(a1.y)}, g2[4] = {bf_lo(a2.x), bf_hi(a2.x), bf_lo(a2.y), bf_hi(a2.y)};
      const float v0[4] = {bf_lo(d0.x), bf_hi(d0.x), bf_lo(d0.y), bf_hi(d0.y)}, v1[4] = {bf_lo(d1.x), bf_hi(d1.x), bf_lo(d1.y), bf_hi(d1.y)}, v2[4] = {bf_lo(d2.x), bf_hi(d2.x), bf_lo(d2.y), bf_hi(d2.y)};
#pragma unroll
      for (int e = 0; e < 4; ++e) {
        const float cgv = bg[e] + wg0[e] * (g2[e] * m2) + wg1[e] * (g1[e] * m1) + wg2[e] * g0[e];
        const float cvv = bv[e] + wv0_[e] * (v2[e] * m2) + wv1[e] * (v1[e] * m1) + wv2[e] * v0[e];
        y[4 * hf + e] = silu_mul(cgv, cvv);
      }
    }
    store8bf(act + (size_t)(k * 256 + rr) * DFF + c0, y);
  }
}

#define XB_TMO      128
#define XB_XCNT(j)  (256  + 64 * (j))
#define XB_XSUB(j)  (1280 + 64 * (j))
#define XB_XGEN(j)  (2304 + 64 * (j))
#define XB_TOP      3328
#define XB_TOPGEN   3392
#define XCD_BAR_WORDS 3456
#define XB_SPIN_CAP (1u << 20)
__device__ __forceinline__ unsigned xb_ld(unsigned* p)              { return __hip_atomic_load(p, __ATOMIC_RELAXED, __HIP_MEMORY_SCOPE_AGENT); }
__device__ __forceinline__ unsigned xb_add(unsigned* p, unsigned v) { return __hip_atomic_fetch_add(p, v, __ATOMIC_RELAXED, __HIP_MEMORY_SCOPE_AGENT); }
__device__ __forceinline__ unsigned xb_xcc_id() { return (unsigned)__builtin_amdgcn_s_getreg((3 << 11) | 20) & 0xFu; }
#define XB_SPIN(cond, bar) do { unsigned _sp = 0; while (cond) { __builtin_amdgcn_s_sleep(1); \
    if ((++_sp & 255u) == 0u) { if (xb_ld(&(bar)[XB_TMO])) break; if (_sp > XB_SPIN_CAP) { atomicAdd(&(bar)[XB_TMO], 1u); break; } } } } while (0)
__device__ __forceinline__ void xcd_barrier_complete(unsigned* bar, unsigned x, unsigned& nloc, unsigned& nx) {
    const unsigned G = gridDim.x * gridDim.y * gridDim.z;
    unsigned sum, cnt, mine, sp = 0u;
    for (;;) {
        sum = 0u; cnt = 0u; mine = 0u;
#pragma unroll
        for (unsigned j = 0; j < 16; ++j) { const unsigned c = xb_ld(&bar[XB_XCNT(j)]); sum += c; cnt += (c > 0u) ? 1u : 0u; mine = (j == x) ? c : mine; }
        if (sum == G) break;
        __builtin_amdgcn_s_sleep(1);
        if ((++sp & 255u) == 0u) { if (xb_ld(&bar[XB_TMO])) break; if (sp > XB_SPIN_CAP) { atomicAdd(&bar[XB_TMO], 1u); break; } }
    }
    nloc = mine > 0u ? mine : 1u; nx = cnt > 0u ? cnt : 1u;
}
__device__ __forceinline__ void xcd_barrier(unsigned* bar, volatile LAS unsigned* st, int wv0) {
    asm volatile("s_waitcnt vmcnt(0)" ::: "memory");
    __syncthreads();
    if (otid(wv0) == 0) {
        const unsigned x = xb_xcc_id();
        __builtin_amdgcn_s_waitcnt(0);
        unsigned nloc = st[0], nx = st[1];
        if (nloc == 0u) { xcd_barrier_complete(bar, x, nloc, nx); st[0] = nloc; st[1] = nx; }
        const unsigned old = xb_add(&bar[XB_XSUB(x)], 1u);
        const unsigned gen = old / nloc;
        if (old + 1u == (gen + 1u) * nloc) {
            __builtin_amdgcn_fence(__ATOMIC_RELEASE, "agent");
            asm volatile("s_waitcnt vmcnt(0)" ::: "memory");
            const unsigned og = xb_add(&bar[XB_TOP], 1u);
            const unsigned tg = og / nx;
            if (og + 1u == (tg + 1u) * nx) xb_add(&bar[XB_TOPGEN], 1u);
            else XB_SPIN(xb_ld(&bar[XB_TOPGEN]) == tg, bar);
            __builtin_amdgcn_fence(__ATOMIC_ACQUIRE, "agent");
            xb_add(&bar[XB_XGEN(x)], 1u);
            asm volatile("s_waitcnt vmcnt(0)" ::: "memory");
        } else {
            XB_SPIN(xb_ld(&bar[XB_XGEN(x)]) == gen, bar);
            __builtin_amdgcn_fence(__ATOMIC_ACQUIRE, "agent");
            asm volatile("s_waitcnt vmcnt(0)" ::: "memory");
        }
    }
    __syncthreads();
}
#define GSYNC() xcd_barrier((unsigned*)(p->ws + O_BAR), (volatile LAS unsigned*)((LAS unsigned char*)shm + 131072), wv0)

#ifndef PH_MASK
#define PH_MASK 0xFFFFF
#endif
#ifndef REP_MASK
#define REP_MASK 0
#endif
#define PH(b) for (int rep_ = 0, nrep_ = (int)(((PH_MASK >> (b)) & 1) + ((REP_MASK >> (b)) & 1)); rep_ < nrep_; ++rep_)
#define LAUNDER() do { asm volatile("" : "+s"(p), "+s"(l), "+s"(wv0) :: "memory"); ws = p->ws; xb = (bf16_t*)(ws + O_XB); xa = (float*)(ws + O_XA); hbuf = (bf16_t*)(ws + O_H); qbuf = (bf16_t*)(ws + O_Q); kvbuf = (bf16_t*)(ws + O_KV); gbuf = qbuf; mb = xb; cs = (const float*)(ws + O_CS); st = (const float*)(ws + O_ST); } while (0)
__global__ void __launch_bounds__(512, 2) mega(Params p_unused) {
  KP p = (KP)__builtin_amdgcn_kernarg_segment_ptr();
  int wv0 = __builtin_amdgcn_readfirstlane((int)threadIdx.x >> 6);
  extern __shared__ __attribute__((aligned(16))) unsigned char shm[];
  LAS unsigned char* lds = (LAS unsigned char*)shm;
  cg::grid_group grid = cg::this_grid();
  unsigned char* ws;
  bf16_t* xb; float* xa; bf16_t* hbuf; bf16_t* qbuf; bf16_t* kvbuf;
  bf16_t* gbuf;
  bf16_t* mb;
  const float* cs; const float* st; int l = 0;
  LAUNDER();

  if (otid(wv0) == 0) { volatile LAS unsigned* bst = (volatile LAS unsigned*)(lds + 131072); bst[0] = 0u; bst[1] = 0u; }
  { unsigned* bar0 = (unsigned*)(p->ws + O_BAR); for (int i = obid() * 512 + otid(wv0); i < XCD_BAR_WORDS; i += ogrid() * 512) bar0[i] = 0u; }
  PH(0) cvt_mixer_a(p, 0, lds, wv0);
  PH(1) prologue(p, wv0);
  grid.sync(); LAUNDER();
  if (otid(wv0) == 0) (void)xb_add((unsigned*)(ws + O_BAR) + XB_XCNT(xb_xcc_id()), 1u);
  for (l = 0; l < 2; ++l) {
    LAUNDER();
    PH(2) { EpiP e{}; e.out = hbuf; e.f0 = cs; run_gemm<E_MAIN>(lds, xb, DM, (const bf16_t*)(ws + O_WMAIN), NTOK, NHP, DM, e, wv0); }
    PH(18) { const int G_ = ogrid(), b_ = obid(), extra = ((NTOK / 256) * (NHP / 256)) % G_;
      cvt_mixer_b(p, l, lds, wv0, extra ? b_ - extra : b_, extra ? G_ - extra : G_); }
    GSYNC(); LAUNDER();
    PH(3) stats_phase(p, wv0);
    PH(4) swa_phase(p, l, lds, wv0, rep_ + 1 < nrep_);
    GSYNC(); LAUNDER();
    PH(5) { EpiP e{}; e.out = qbuf; e.f0 = st; e.facc = (float*)cs; run_gemm<E_UQ>(lds, hbuf + C_CQ, LDH, (const bf16_t*)(ws + O_WUQ), NTOK, NQ, 512, e, wv0); }
    PH(6) { EpiP e{}; e.out = kvbuf; e.f0 = st; run_gemm<E_UKV>(lds, hbuf + C_CKV, LDH, (const bf16_t*)(ws + O_WUKV), NTOK, NKV, 512, e, wv0); }
    PH(7) sgu_phase(p, l, lds, wv0, rep_ + 1 < nrep_);
    GSYNC(); LAUNDER();
    PH(8) mla_phase(p, lds, wv0);
    GSYNC(); LAUNDER();
    PH(9) { EpiP e{}; e.out = gbuf; e.f0 = p->b_gate + (size_t)l * NG; run_gemm<E_GATE>(lds, xb, DM, (const bf16_t*)(ws + O_WG), NTOK, NG, DM, e, wv0); }
    GSYNC(); LAUNDER();
    PH(10) { EpiP e{}; e.out = mb; e.b0 = gbuf; e.facc = p->out; e.aux = 0; run_gemm<E_PROJ>(lds, hbuf + C_QA, LDH, (const bf16_t*)(ws + O_PA), NTOK, DM, 1024, e, wv0); }
    PH(10) { EpiP e{}; e.out = mb; e.b0 = gbuf; e.facc = p->out; e.aux = 1; run_gemm<E_PROJ>(lds, hbuf + C_CQ, LDH, (const bf16_t*)(ws + O_PB), NTOK, DM, 2048, e, wv0); }
    PH(10) { EpiP e{}; e.out = mb; e.b0 = gbuf; e.facc = p->out; e.aux = 2; run_gemm<E_PROJ>(lds, hbuf + C_HU, LDH, (const bf16_t*)(ws + O_PC), NTOK, DM, 1024, e, wv0); }
    GSYNC(); LAUNDER();
    PH(11) { EpiP e{}; e.out = xa; e.f0 = (l == 0) ? p->x : xa; run_gemm<E_RES>(lds, mb, DM, (const bf16_t*)(ws + O_WO), NTOK, DM, DM, e, wv0); }
    GSYNC(); LAUNDER();
    PH(12) ln_phase(xa, xa, xb, p->ln1_g + l * DM, p->ln1_b + l * DM, wv0);
    PH(13) cvt_ffn(p, l, lds, wv0);
    GSYNC(); LAUNDER();
    PH(14) { EpiP e{}; e.out = ws + O_ACT; e.b0 = (const bf16_t*)(ws + O_SIDE); e.f0 = p->conv_w + (size_t)l * 3 * NUP; e.f1 = p->conv_b + (size_t)l * NUP; e.ex = lds + 131072 + 64;
      run_gemm<E_UPC>(lds, xb, DM, (const bf16_t*)(ws + O_WUP), NTOK, NUP, DM, e, wv0); }
    GSYNC(); LAUNDER();
    PH(15) fixup_phase(p, l, wv0);
    GSYNC(); LAUNDER();
    PH(16) { EpiP e{}; e.out = xa; e.f0 = xa; run_gemm<E_RES>(lds, (const bf16_t*)(ws + O_ACT), DFF, (const bf16_t*)(ws + O_WDN), NTOK, DM, DFF, e, wv0); }
    GSYNC(); LAUNDER();
    PH(17) ln_phase(xa, (l == 1) ? p->out : xa, (l == 1) ? nullptr : xb, p->ln2_g + l * DM, p->ln2_b + l * DM, wv0);
    if (l == 0) { PH(0) cvt_mixer_a(p, 1, lds, wv0); GSYNC(); }
  }
}

extern "C" void kernel_launch(void* const* d_in, const int* in_sizes, int n_in, void* d_out, int out_size, void* d_ws, size_t ws_size, hipStream_t stream) {
  constexpr size_t kDynLds = 131072 + 64 + 16384;
  static int grid_blocks = 0;
  if (!grid_blocks) {
    (void)hipFuncSetAttribute((const void*)mega, hipFuncAttributeMaxDynamicSharedMemorySize, (int)kDynLds);
    int dev = 0, cus = 0, per_cu = 0;
    (void)hipGetDevice(&dev);
    (void)hipDeviceGetAttribute(&cus, hipDeviceAttributeMultiprocessorCount, dev);
    (void)hipOccupancyMaxActiveBlocksPerMultiprocessor(&per_cu, mega, 512, kDynLds);
    if (per_cu > 1) per_cu = 1;
    if (per_cu < 1) per_cu = 1;
    grid_blocks = cus * per_cu;
  }
  if (ws_size < WS_NEED) { fprintf(stderr, "workspace too small: %zu < %zu\n", ws_size, (size_t)WS_NEED); return; }
  Params p{};
  p.x = (const float*)d_in[0]; p.pos = (const int*)d_in[1]; p.w_in = (const float*)d_in[2]; p.b_gate = (const float*)d_in[3]; p.sinks = (const float*)d_in[4];
  p.q_norm_g = (const float*)d_in[5]; p.kv_norm_g = (const float*)d_in[6]; p.w_uq = (const float*)d_in[7]; p.w_ukv = (const float*)d_in[8];
  p.sgu_ln_g = (const float*)d_in[9]; p.sgu_ln_b = (const float*)d_in[10]; p.sgu_w = (const float*)d_in[11]; p.sgu_b = (const float*)d_in[12];
  p.w_proj_a = (const float*)d_in[13]; p.w_proj_b = (const float*)d_in[14]; p.w_proj_c = (const float*)d_in[15]; p.w_o = (const float*)d_in[16];
  p.ln1_g = (const float*)d_in[17]; p.ln1_b = (const float*)d_in[18]; p.w_up = (const float*)d_in[19]; p.conv_w = (const float*)d_in[20]; p.conv_b = (const float*)d_in[21];
  p.w_down = (const float*)d_in[22]; p.ln2_g = (const float*)d_in[23]; p.ln2_b = (const float*)d_in[24];
  p.out = (float*)d_out; p.ws = (unsigned char*)d_ws;
  void* args[] = {&p};
  hipError_t e = hipLaunchCooperativeKernel((void*)mega, dim3(grid_blocks), dim3(512), args, kDynLds, stream);
  if (e != hipSuccess) fprintf(stderr, "cooperative launch failed: %s (grid %d)\n", hipGetErrorString(e), grid_blocks);
}
```

```cpp
#include <hip/hip_runtime.h>
#include <hip/hip_cooperative_groups.h>
#include <cstdio>
namespace cg = cooperative_groups;

#define LAS __attribute__((address_space(3)))
typedef unsigned short bf16_t;
typedef short bf16x8 __attribute__((ext_vector_type(8)));
typedef short v4i16_t __attribute__((ext_vector_type(4)));
typedef float f32x4 __attribute__((ext_vector_type(4)));
typedef float f32x2 __attribute__((ext_vector_type(2)));
typedef float f32x16 __attribute__((ext_vector_type(16)));
typedef unsigned u32x4 __attribute__((ext_vector_type(4)));
typedef unsigned u32x2 __attribute__((ext_vector_type(2)));

constexpr int NTOK = 16384, SEQ = 4096, DM = 2048;
constexpr int LDH = 4416, NHP = 4608;
constexpr int C_QA = 0, C_KA = 1024, C_VA = 1152, C_KR = 1280, C_HU = 1344, C_CQ = 2368, C_CKV = 2880, C_HV = 3392;
constexpr int NG = 6144, NQ = 3072, NKV = 4096, NUP = 11264, DFF = 5632, NIN = 10560;
constexpr float LOG2E = 1.4426950408889634f;
constexpr float ALPHA = 1.4142135623730951f;
constexpr float EPS = 1e-5f;
constexpr float SWA_QSCALE = 0.125f * LOG2E;
constexpr float MLA_QSCALE = 0.07216878364870322f * LOG2E;

__device__ const float INV_FREQ[32] = {1.000000000e+00f, 7.498942018e-01f, 5.623413324e-01f, 4.216965139e-01f, 3.162277639e-01f, 2.371373773e-01f, 1.778279394e-01f, 1.333521456e-01f, 1.000000015e-01f, 7.498942316e-02f, 5.623413250e-02f, 4.216964915e-02f, 3.162277490e-02f, 2.371373773e-02f, 1.778279431e-02f, 1.333521400e-02f, 9.999999776e-03f, 7.498942316e-03f, 5.623413250e-03f, 4.216964822e-03f, 3.162277630e-03f, 2.371373819e-03f, 1.778279431e-03f, 1.333521446e-03f, 1.000000047e-03f, 7.498941850e-04f, 5.623413017e-04f, 4.216965172e-04f, 3.162277571e-04f, 2.371373703e-04f, 1.778279402e-04f, 1.333521504e-04f};

constexpr size_t SZ_W = 76546048;
constexpr size_t O_WMAIN = 0, O_WG = 18874368, O_WUQ = O_WG + 25165824, O_WUKV = O_WUQ + 3145728, O_PA = O_WUKV + 4194304, O_PB = O_PA + 4194304, O_PC = O_PB + 8388608, O_WO = O_PC + 4194304;
constexpr size_t O_WUP = 0, O_WDN = 46137344;
constexpr size_t O_XB = SZ_W;
constexpr size_t O_XA = O_XB + 67108864;
constexpr size_t O_BIG = O_XA + 134217728;
constexpr size_t O_H = O_BIG, O_Q = O_H + 144703488, O_KV = O_Q + 100663296;
constexpr size_t O_ACT = O_BIG, O_SIDE = O_BIG + 184549376;
constexpr size_t O_CS = O_BIG + 379584512;
constexpr size_t O_ST = O_CS + 4194304;
constexpr size_t O_BAR = O_ST + 262144;
constexpr size_t WS_NEED = O_BAR + 16384;

struct Params {
  const float* x; const int* pos; const float* w_in; const float* b_gate; const float* sinks; const float* q_norm_g; const float* kv_norm_g;
  const float* w_uq; const float* w_ukv; const float* sgu_ln_g; const float* sgu_ln_b; const float* sgu_w; const float* sgu_b;
  const float* w_proj_a; const float* w_proj_b; const float* w_proj_c; const float* w_o; const float* ln1_g; const float* ln1_b;
  const float* w_up; const float* conv_w; const float* conv_b; const float* w_down; const float* ln2_g; const float* ln2_b;
  float* out; unsigned char* ws;
};

typedef const Params __attribute__((address_space(4)))* KP;
__device__ __forceinline__ int olane() { unsigned m = ~0u; asm volatile("" : "+s"(m)); return (int)__builtin_amdgcn_mbcnt_hi(m, __builtin_amdgcn_mbcnt_lo(m, 0u)); }
__device__ __forceinline__ int otid(int wv0) { int t = (wv0 << 6) | olane(); asm volatile("" : "+v"(t)); return t; }
__device__ __forceinline__ int obid() { int b = blockIdx.x; asm volatile("" : "+s"(b)); return b; }
__device__ __forceinline__ int ogrid() { int g = gridDim.x; asm volatile("" : "+s"(g)); return g; }
__device__ __forceinline__ unsigned pk2(float lo, float hi) {
  typedef __bf16 b2 __attribute__((ext_vector_type(2)));
  b2 r = __builtin_convertvector((f32x2){lo, hi}, b2);
  return __builtin_bit_cast(unsigned, r);
}
__device__ __forceinline__ float bf_lo(unsigned u) { return __uint_as_float(u << 16); }
__device__ __forceinline__ float bf_hi(unsigned u) { return __uint_as_float(u & 0xffff0000u); }
__device__ __forceinline__ float bf1(bf16_t u) { return __uint_as_float(((unsigned)u) << 16); }
__device__ __forceinline__ float fexp2(float x) { return __builtin_amdgcn_exp2f(x); }
__device__ __forceinline__ float frcp(float x) { return __builtin_amdgcn_rcpf(x); }
__device__ __forceinline__ float wave_sum(float v) {
#pragma unroll
  for (int o = 32; o > 0; o >>= 1) v += __shfl_xor(v, o);
  return v;
}
__device__ __forceinline__ float gelu1(float v) {
  const float av = __builtin_fabsf(v), d = av * 0.2316418882f + 1.0f;
  const float t = frcp(d);
  float q = t * 0.5307027145f + (-0.7265760135f); q = q * t + 0.7107068705f; q = q * t + (-0.142248368f); q = q * t + 0.127414796f; q = q * t;
  const float s = (v * v) * (-0.72134752044f);
  const float e = fexp2(s);
  const float m = v * (q * e), r = v - m;
  return v < 0.f ? m : r;
}
__device__ __forceinline__ f32x16 mfma32(bf16x8 a, bf16x8 b, f32x16 c) { return __builtin_amdgcn_mfma_f32_32x32x16_bf16(a, b, c, 0, 0, 0); }
__device__ __forceinline__ v4i16_t vtr(const LAS unsigned char* p) { return __builtin_amdgcn_ds_read_tr16_b64_v4i16((LAS v4i16_t*)p); }

namespace pg8 {
constexpr int BM = 256, BK = 64, HALF = 128, HTB = HALF * BK * 2, STAGE_BYTES = 8 * HTB, NXCD = 8, WGM = 8;
__device__ __forceinline__ int lds_byte(int r, int c) { const int st = (r >> 4) * 2 + (c >> 5), rr = r & 15, cc = c & 31, ob = rr * 64 + cc * 2; return st * 1024 + (ob ^ (((ob >> 9) & 1) << 5)); }
__device__ __forceinline__ void stage_rc(int b, int& R, int& C) { const int st = b / 1024, sb = b % 1024, swz = sb ^ (((sb >> 9) & 1) << 5); R = (st >> 1) * 16 + swz / 64; C = (st & 1) * 32 + (swz % 64) / 2; }
__device__ __forceinline__ int perm32(int rho) { const int n = rho >> 4, i = rho & 15; return 8 * (i >> 2) + 4 * n + (i & 3); }
struct Unit { int pm, pn; };
struct Gemm { const bf16_t* A; const bf16_t* Bt; int M, N, K, lda; };
struct StaticOrder {
  int nM, nN, nwg, G, c;
  __device__ void init(int M, int N, int G_, int c_) { nM = M / BM; nN = N / BM; nwg = nM * nN; G = G_; c = c_; }
  __device__ bool next(int i, Unit& u) const {
    const long L = (long)i * G + c; if (L >= nwg) return false;
    int wgid = (int)L; { const int q = nwg / NXCD, r = nwg % NXCD, xcd = wgid % NXCD, off = wgid / NXCD; wgid = (xcd < r ? xcd * (q + 1) : r * (q + 1) + (xcd - r) * q) + off; }
    const int nig = WGM * nN, gid = wgid / nig, fm = gid * WGM, gsz = (nM - fm) < WGM ? (nM - fm) : WGM;
    u.pm = fm + ((wgid % nig) % gsz); u.pn = (wgid % nig) / gsz; return true;
  }
};

template <class Epi>
__device__ __forceinline__ void gemm_phase(LAS unsigned char* lds, const Gemm g, const StaticOrder& S, const Epi& E, int wv0) {
  const int tid = otid(wv0), wid = __builtin_amdgcn_readfirstlane(tid >> 6), lane = tid & 63, wr = wid >> 2, wc = wid & 3, fr = lane & 15, fq = lane >> 4;
  const int K = g.K, nt = K / BK, lda = g.lda;
  unsigned voffA[2], voffB[2];
#pragma unroll
  for (int i = 0; i < 2; ++i) { int R, C; stage_rc(tid * 16 + i * 8192, R, C); const int Rb = (R & ~31) + perm32(R & 31);
    voffA[i] = (unsigned)(R * lda + C) * 2u; voffB[i] = (unsigned)(Rb * K + C) * 2u; }
  const size_t kstep = (size_t)(BK * 2);
  const size_t hstepA = (size_t)HALF * lda * 2, hstepB = (size_t)HALF * K * 2;
  const size_t tstepA = 2 * hstepA, tstepB = 2 * hstepB;
  const unsigned ldsw = (unsigned)wid * 1024u;
  const int aoff = lds_byte(wr * 64 + fr, fq * 8), boff = lds_byte(wc * 32 + fr, fq * 8);
#define PG8_SA(b, h) (((b) * 2 + (h)) * HTB)
#define PG8_SB(b, h) ((4 + (b) * 2 + (h)) * HTB)
#define PG8_STAGE(bufoff, gbase, voff) do { _Pragma("unroll") for (int _i = 0; _i < 2; ++_i) \
    __builtin_amdgcn_global_load_lds((const unsigned*)((const char*)(gbase) + (voff)[_i]), (LAS unsigned*)(lds + (bufoff) + ldsw + _i * 8192), 16, 0, 0); } while (0)
#define PG8_LDA(dst, b, h) do { _Pragma("unroll") for (int m = 0; m < 4; ++m) _Pragma("unroll") for (int k = 0; k < 2; ++k) dst[m][k] = *(const LAS bf16x8*)(lds + PG8_SA(b, h) + aoff + m * 2048 + k * 1024); } while (0)
#define PG8_LDB(dst, b, h) do { _Pragma("unroll") for (int n = 0; n < 2; ++n) _Pragma("unroll") for (int k = 0; k < 2; ++k) dst[n][k] = *(const LAS bf16x8*)(lds + PG8_SB(b, h) + boff + n * 2048 + k * 1024); } while (0)
#define PG8_MMA(ai, bj, At, Bt) do { __builtin_amdgcn_s_setprio(1); _Pragma("unroll") for (int m = 0; m < 4; ++m) _Pragma("unroll") for (int n = 0; n < 2; ++n) _Pragma("unroll") for (int k = 0; k < 2; ++k) \
    acc[ai][bj][m][n] = __builtin_amdgcn_mfma_f32_16x16x32_bf16(Bt[n][k], At[m][k], acc[ai][bj][m][n], 0, 0, 0); __builtin_amdgcn_s_setprio(0); } while (0)
#define PG8_WAIT_V(n) asm volatile("s_waitcnt vmcnt(" #n ")" ::: "memory")
#define PG8_WAIT_L(n) asm volatile("s_waitcnt lgkmcnt(" #n ")" ::: "memory")
#define PG8_BAR __builtin_amdgcn_s_barrier()
#define PG8_SCHED __builtin_amdgcn_sched_barrier(0)
  Unit cur, nxt; int ui = 0;
  if (!S.next(0, cur)) return;
  f32x4 acc[2][2][4][2];
#pragma unroll
  for (int a = 0; a < 2; ++a)
#pragma unroll
    for (int b = 0; b < 2; ++b)
#pragma unroll
      for (int m = 0; m < 4; ++m)
#pragma unroll
        for (int n = 0; n < 2; ++n) acc[a][b][m][n] = (f32x4){0.f, 0.f, 0.f, 0.f};
  bf16x8 At[4][2], B0[2][2], B1[2][2];
  const char* cA = (const char*)g.A + (size_t)cur.pm * tstepA; const char* cB = (const char*)g.Bt + (size_t)cur.pn * tstepB;
  PG8_STAGE(PG8_SB(0, 0), cB, voffB); PG8_STAGE(PG8_SA(0, 0), cA, voffA); PG8_STAGE(PG8_SB(0, 1), cB + hstepB, voffB); PG8_STAGE(PG8_SA(0, 1), cA + hstepA, voffA);
  if (wr == 1) PG8_BAR;
  PG8_WAIT_V(4); PG8_BAR;
  PG8_STAGE(PG8_SB(1, 0), cB + kstep, voffB); PG8_STAGE(PG8_SA(1, 0), cA + kstep, voffA); PG8_STAGE(PG8_SB(1, 1), cB + hstepB + kstep, voffB);
  PG8_WAIT_V(6); PG8_BAR;
  for (;;) {
    const bool has_next = S.next(ui + 1, nxt);
    const char* nA = has_next ? (const char*)g.A + (size_t)nxt.pm * tstepA : cA; const char* nB = has_next ? (const char*)g.Bt + (size_t)nxt.pn * tstepB : cB;
    for (int t = 0; t < nt; t += 2) {
      const bool last = (t == nt - 2);
      const char* a1 = cA + (size_t)(t + 1) * kstep;
      const char* a2 = last ? nA : cA + (size_t)(t + 2) * kstep; const char* b2 = last ? nB : cB + (size_t)(t + 2) * kstep;
      const char* a3 = a2 + kstep; const char* b3 = b2 + kstep;
      PG8_LDB(B0, 0, 0); PG8_SCHED; PG8_LDA(At, 0, 0); PG8_STAGE(PG8_SA(1, 1), a1 + hstepA, voffA);
      PG8_WAIT_L(8); PG8_BAR; PG8_WAIT_L(0); PG8_MMA(0, 0, At, B0); PG8_BAR; PG8_SCHED;
      PG8_LDB(B1, 0, 1); PG8_STAGE(PG8_SB(0, 0), b2, voffB);
      PG8_BAR; PG8_WAIT_L(0); PG8_MMA(0, 1, At, B1); PG8_BAR;
      PG8_LDA(At, 0, 1); PG8_STAGE(PG8_SA(0, 0), a2, voffA);
      PG8_BAR; PG8_WAIT_L(0); PG8_MMA(1, 0, At, B0); PG8_BAR; PG8_SCHED;
      PG8_STAGE(PG8_SB(0, 1), b2 + hstepB, voffB);
      PG8_WAIT_V(6); PG8_BAR; PG8_MMA(1, 1, At, B1); PG8_BAR;
      PG8_LDB(B0, 1, 0); PG8_SCHED; PG8_LDA(At, 1, 0); PG8_STAGE(PG8_SA(0, 1), a2 + hstepA, voffA);
      PG8_WAIT_L(8); PG8_BAR; PG8_WAIT_L(0); PG8_MMA(0, 0, At, B0); PG8_BAR; PG8_SCHED;
      PG8_LDB(B1, 1, 1); PG8_STAGE(PG8_SB(1, 0), b3, voffB);
      PG8_BAR; PG8_WAIT_L(0); PG8_MMA(0, 1, At, B1); PG8_BAR;
      PG8_LDA(At, 1, 1); PG8_STAGE(PG8_SA(1, 0), a3, voffA);
      PG8_BAR; PG8_WAIT_L(0); PG8_MMA(1, 0, At, B0); PG8_BAR; PG8_SCHED;
      PG8_STAGE(PG8_SB(1, 1), b3 + hstepB, voffB);
      PG8_WAIT_V(6); PG8_BAR; PG8_MMA(1, 1, At, B1); PG8_BAR;
    }
    E(acc, cur, wr, wc, fr, fq);
    if (!has_next) break;
#pragma unroll
    for (int a = 0; a < 2; ++a)
#pragma unroll
      for (int b = 0; b < 2; ++b)
#pragma unroll
        for (int m = 0; m < 4; ++m)
#pragma unroll
          for (int n = 0; n < 2; ++n) acc[a][b][m][n] = (f32x4){0.f, 0.f, 0.f, 0.f};
    cur = nxt; cA = nA; cB = nB; ++ui;
  }
  PG8_WAIT_V(0);
  if (wr == 0) PG8_BAR;
  PG8_BAR;
#undef PG8_SA
#undef PG8_SB
#undef PG8_STAGE
#undef PG8_LDA
#undef PG8_LDB
#undef PG8_MMA
#undef PG8_WAIT_V
#undef PG8_WAIT_L
#undef PG8_BAR
#undef PG8_SCHED
}
}

struct EpiP { void* out; int ldo; const float* f0; const bf16_t* b0; float* facc; int aux; const float* f1; LAS unsigned char* ex; };
enum { E_MAIN = 0, E_GATE = 1, E_UQ = 2, E_UKV = 3, E_PROJ = 4, E_RES = 5, E_UP = 6, E_UPC = 7 };

__device__ __forceinline__ void rope8(float (&v)[8], const f32x2* cs) {
#pragma unroll
  for (int i = 0; i < 4; ++i) { const f32x2 c = cs[i]; const float x1 = v[2 * i], x2 = v[2 * i + 1]; v[2 * i] = x1 * c.x - x2 * c.y; v[2 * i + 1] = x2 * c.x + x1 * c.y; }
}
__device__ __forceinline__ void store8bf(bf16_t* dst, const float (&v)[8]) {
  u32x4 w; w.x = pk2(v[0], v[1]); w.y = pk2(v[2], v[3]); w.z = pk2(v[4], v[5]); w.w = pk2(v[6], v[7]);
  *(u32x4*)dst = w;
}


__device__ __forceinline__ float dpp_shr1(float x) { return __int_as_float(__builtin_amdgcn_update_dpp(0, __float_as_int(x), 0x111, 0xF, 0xF, true)); }
__device__ __forceinline__ float dpp_shr2(float x) { return __int_as_float(__builtin_amdgcn_update_dpp(0, __float_as_int(x), 0x112, 0xF, 0xF, true)); }
__device__ __forceinline__ float dpp_prev1(float prev, float cur) {
  const int t = __builtin_amdgcn_update_dpp(0, __float_as_int(prev), 0x121, 0xF, 0xF, false);
  return __int_as_float(__builtin_amdgcn_update_dpp(t, __float_as_int(cur), 0x111, 0xF, 0xF, false)); }
__device__ __forceinline__ float dpp_prev2(float prev, float cur) {
  const int t = __builtin_amdgcn_update_dpp(0, __float_as_int(prev), 0x122, 0xF, 0xF, false);
  return __int_as_float(__builtin_amdgcn_update_dpp(t, __float_as_int(cur), 0x112, 0xF, 0xF, false)); }
__device__ __forceinline__ float silu_mul(float g, float v) { return g * frcp(1.0f + fexp2(-g * LOG2E)) * v; }
__device__ __forceinline__ void epi_upc(const EpiP& e, const f32x4 (&acc)[2][2][4][2], const pg8::Unit& u, int wr, int wc, int fr, int fq) {
  LAS unsigned char* ex = e.ex;
  bf16_t* side = (bf16_t*)e.b0;
  const int lc0 = 32 * wc + 8 * fq;
#pragma unroll
  for (int ai = 0; ai < 2; ++ai)
#pragma unroll
    for (int m = 0; m < 4; ++m) {
      const int g = ai * 8 + wr * 4 + m;
#pragma unroll
      for (int bj = 0; bj < 2; ++bj) {
        u32x4 w; w.x = pk2(acc[ai][bj][m][0][0], acc[ai][bj][m][0][1]); w.y = pk2(acc[ai][bj][m][0][2], acc[ai][bj][m][0][3]);
        w.z = pk2(acc[ai][bj][m][1][0], acc[ai][bj][m][1][1]); w.w = pk2(acc[ai][bj][m][1][2], acc[ai][bj][m][1][3]);
        if (m == 3 && fr >= 14) *(LAS u32x4*)(ex + ((g * 2 + (fr - 14)) * 256 + bj * 128 + lc0) * 2) = w;
        const int ucol = bj * DFF + 128 * u.pn + lc0;
        if (g == 15 && fr >= 14) *(u32x4*)(side + ((size_t)u.pm * 4 + 2 + (fr - 14)) * NUP + ucol) = w;
        if (g == 0 && fr < 2) *(u32x4*)(side + ((size_t)u.pm * 4 + fr) * NUP + ucol) = w;
      }
    }
  asm volatile("s_waitcnt lgkmcnt(0)" ::: "memory");
  __builtin_amdgcn_s_barrier();
  __builtin_amdgcn_s_barrier();
  asm volatile("" ::: "memory");
  const float* cw = e.f0; const float* cb = e.f1;
  bf16_t* act = (bf16_t*)e.out;
#pragma unroll
  for (int n = 0; n < 2; ++n) {
    const int ch = 128 * u.pn + lc0 + 4 * n;
    const f32x4 wg0 = *(const f32x4*)(cw + ch), wg1 = *(const f32x4*)(cw + NUP + ch), wg2 = *(const f32x4*)(cw + 2 * NUP + ch), bg = *(const f32x4*)(cb + ch);
    const f32x4 wv0 = *(const f32x4*)(cw + DFF + ch), wv1 = *(const f32x4*)(cw + NUP + DFF + ch), wv2 = *(const f32x4*)(cw + 2 * NUP + DFF + ch), bv = *(const f32x4*)(cb + DFF + ch);
#pragma unroll
    for (int ai = 0; ai < 2; ++ai)
#pragma unroll
      for (int m = 0; m < 4; ++m) {
        const int g = ai * 8 + wr * 4 + m, gp = g > 0 ? g - 1 : 0;
        const f32x4 xg = acc[ai][0][m][n], xv = acc[ai][1][m][n];
        float y[4];
        if (m > 0) {
          const f32x4 pg = acc[ai][0][m - 1][n], pv = acc[ai][1][m - 1][n];
#pragma unroll
          for (int k = 0; k < 4; ++k) {
            const float g1 = dpp_prev1(pg[k], xg[k]), g2 = dpp_prev2(pg[k], xg[k]), v1 = dpp_prev1(pv[k], xv[k]), v2 = dpp_prev2(pv[k], xv[k]);
            const float cg = bg[k] + wg0[k] * g2 + wg1[k] * g1 + wg2[k] * xg[k];
            const float cv = bv[k] + wv0[k] * v2 + wv1[k] * v1 + wv2[k] * xv[k];
            y[k] = silu_mul(cg, cv);
          }
        } else {
          const LAS unsigned char* hp = ex + (gp * 2 * 256 + lc0 + 4 * n) * 2;
          const u32x2 hg14 = *(const LAS u32x2*)hp, hg15 = *(const LAS u32x2*)(hp + 512), hv14 = *(const LAS u32x2*)(hp + 256), hv15 = *(const LAS u32x2*)(hp + 512 + 256);
          const float h14g[4] = {bf_lo(hg14.x), bf_hi(hg14.x), bf_lo(hg14.y), bf_hi(hg14.y)}, h15g[4] = {bf_lo(hg15.x), bf_hi(hg15.x), bf_lo(hg15.y), bf_hi(hg15.y)};
          const float h14v[4] = {bf_lo(hv14.x), bf_hi(hv14.x), bf_lo(hv14.y), bf_hi(hv14.y)}, h15v[4] = {bf_lo(hv15.x), bf_hi(hv15.x), bf_lo(hv15.y), bf_hi(hv15.y)};
#pragma unroll
          for (int k = 0; k < 4; ++k) {
            float g1 = dpp_shr1(xg[k]), g2 = dpp_shr2(xg[k]), v1 = dpp_shr1(xv[k]), v2 = dpp_shr2(xv[k]);
            if (fr == 0) { g1 = h15g[k]; g2 = h14g[k]; v1 = h15v[k]; v2 = h14v[k]; }
            if (fr == 1) { g2 = h15g[k]; v2 = h15v[k]; }
            const float cg = bg[k] + wg0[k] * g2 + wg1[k] * g1 + wg2[k] * xg[k];
            const float cv = bv[k] + wv0[k] * v2 + wv1[k] * v1 + wv2[k] * xv[k];
            y[k] = silu_mul(cg, cv);
          }
        }
        const int row = u.pm * 256 + ai * 128 + wr * 64 + m * 16 + fr;
        if (!(g == 0 && fr < 2)) { u32x2 w; w.x = pk2(y[0], y[1]); w.y = pk2(y[2], y[3]); *(u32x2*)(act + (size_t)row * DFF + ch) = w; }
      }
    asm volatile("" ::: "memory");
  }
}
struct EpiPre { f32x4 a0, a1; u32x4 u0, u1; float s; };
__device__ __forceinline__ void rope8v(float (&v)[8], f32x4 c0, f32x4 c1) {
  const float cs[8] = {c0[0], c0[1], c0[2], c0[3], c1[0], c1[1], c1[2], c1[3]};
#pragma unroll
  for (int i = 0; i < 4; ++i) { const float x1 = v[2 * i], x2 = v[2 * i + 1]; v[2 * i] = x1 * cs[2 * i] - x2 * cs[2 * i + 1]; v[2 * i + 1] = x2 * cs[2 * i] + x1 * cs[2 * i + 1]; }
}
template <int MODE> struct Epi {
  EpiP e;
  __device__ __forceinline__ void preload(EpiPre& q, int row, int col) const {
    if (MODE == E_GATE || MODE == E_UKV) return;
    if (MODE == E_MAIN) {
      if (col >= C_KR && col < C_HU) { const float* cs = e.f0 + ((size_t)row * 32 + ((col - C_KR) >> 1)) * 2; q.a0 = *(const f32x4*)cs; q.a1 = *(const f32x4*)(cs + 4); }
    } else if (MODE == E_GATE) {
      q.a0 = *(const f32x4*)(e.f0 + col); q.a1 = *(const f32x4*)(e.f0 + col + 4);
    } else if (MODE == E_UQ) {
      const int c192 = col % 192;
      if (c192 >= 128) { const float* cs = e.facc + ((size_t)row * 32 + ((c192 - 128) >> 1)) * 2; q.a0 = *(const f32x4*)cs; q.a1 = *(const f32x4*)(cs + 4); }
    } else if (MODE == E_UKV) {
      q.s = ((const f32x4*)e.f0)[row].y;
    } else if (MODE == E_PROJ) {
      q.u0 = *(const u32x4*)(e.b0 + (size_t)row * NG + e.aux * DM + col);
      if (e.aux > 0) q.u1 = *(const u32x4*)((const bf16_t*)e.facc + (size_t)row * DM + col);
    } else if (MODE == E_RES) {
      const float* rs = e.f0 + (size_t)row * DM + col; q.a0 = *(const f32x4*)rs; q.a1 = *(const f32x4*)(rs + 4);
    }
  }
  __device__ __forceinline__ void emit(const EpiPre& q0, int row, int col, f32x4 a, f32x4 b, const f32x4 (&hb)[2][2], const float (&hs)[2][4], int ai_, int m_, int bj_) const {
    EpiPre q = q0;
    if (MODE == E_GATE) { q.a0 = hb[bj_][0]; q.a1 = hb[bj_][1]; }
    if (MODE == E_UQ || MODE == E_UKV) q.s = hs[ai_][m_];
    float v[8] = {a[0], a[1], a[2], a[3], b[0], b[1], b[2], b[3]};
    if (MODE == E_MAIN) {
      if (col >= LDH) return;
      if (col < C_KA) {
#pragma unroll
        for (int j = 0; j < 8; ++j) v[j] *= SWA_QSCALE;
      } else if (col >= C_KR && col < C_HU) {
        rope8v(v, q.a0, q.a1);
      } else if ((col >= C_HU && col < C_CQ) || col >= C_HV) {
#pragma unroll
        for (int j = 0; j < 8; ++j) v[j] = gelu1(v[j]);
      }
      store8bf((bf16_t*)e.out + (size_t)row * LDH + col, v);
    } else if (MODE == E_GATE) {
      const float bb[8] = {q.a0[0], q.a0[1], q.a0[2], q.a0[3], q.a1[0], q.a1[1], q.a1[2], q.a1[3]};
#pragma unroll
      for (int j = 0; j < 8; ++j) v[j] = frcp(1.0f + fexp2(__builtin_fmaf(v[j], -LOG2E, bb[j])));
      store8bf((bf16_t*)e.out + (size_t)row * NG + col, v);
    } else if (MODE == E_UQ) {
#pragma unroll
      for (int j = 0; j < 8; ++j) v[j] *= q.s;
      if (col % 192 >= 128) rope8v(v, q.a0, q.a1);
      store8bf((bf16_t*)e.out + (size_t)row * NQ + col, v);
    } else if (MODE == E_UKV) {
#pragma unroll
      for (int j = 0; j < 8; ++j) v[j] *= q.s;
      store8bf((bf16_t*)e.out + (size_t)row * NKV + col, v);
    } else if (MODE == E_PROJ) {
      const int br = e.aux; const u32x4 gw = q.u0;
      v[0] *= bf_lo(gw.x); v[1] *= bf_hi(gw.x); v[2] *= bf_lo(gw.y); v[3] *= bf_hi(gw.y);
      v[4] *= bf_lo(gw.z); v[5] *= bf_hi(gw.z); v[6] *= bf_lo(gw.w); v[7] *= bf_hi(gw.w);
      bf16_t* fa = (bf16_t*)e.facc + (size_t)row * DM + col;
      if (br > 0) { const u32x4 pw = q.u1;
        v[0] += bf_lo(pw.x); v[1] += bf_hi(pw.x); v[2] += bf_lo(pw.y); v[3] += bf_hi(pw.y); v[4] += bf_lo(pw.z); v[5] += bf_hi(pw.z); v[6] += bf_lo(pw.w); v[7] += bf_hi(pw.w); }
      if (br == 2) store8bf((bf16_t*)e.out + (size_t)row * DM + col, v);
      else store8bf(fa, v);
    } else if (MODE == E_RES) {
      const f32x4 r0 = q.a0, r1 = q.a1;
      float* o = (float*)e.out + (size_t)row * DM + col;
      *(f32x4*)o = (f32x4){ALPHA * r0[0] + v[0], ALPHA * r0[1] + v[1], ALPHA * r0[2] + v[2], ALPHA * r0[3] + v[3]};
      *(f32x4*)(o + 4) = (f32x4){ALPHA * r1[0] + v[4], ALPHA * r1[1] + v[5], ALPHA * r1[2] + v[6], ALPHA * r1[3] + v[7]};
    } else {
      store8bf((bf16_t*)e.out + (size_t)row * e.ldo + col, v);
    }
  }
  __device__ __forceinline__ void operator()(const f32x4 (&acc)[2][2][4][2], const pg8::Unit& u, int wr, int wc, int fr, int fq) const {
    if (MODE == E_UPC) { epi_upc(e, acc, u, wr, wc, fr, fq); return; }
    const int row0 = u.pm * 256 + wr * 64 + fr, col0 = u.pn * 256 + wc * 32 + 8 * fq;
    f32x4 hb[2][2]; float hs[2][4];
#pragma unroll
    for (int bj = 0; bj < 2; ++bj) { hb[bj][0] = (f32x4){0.f, 0.f, 0.f, 0.f}; hb[bj][1] = hb[bj][0];
      if (MODE == E_GATE) { hb[bj][0] = *(const f32x4*)(e.f0 + col0 + bj * 128) * (-LOG2E); hb[bj][1] = *(const f32x4*)(e.f0 + col0 + bj * 128 + 4) * (-LOG2E); } }
#pragma unroll
    for (int ai = 0; ai < 2; ++ai)
#pragma unroll
      for (int m = 0; m < 4; ++m) { hs[ai][m] = 0.f;
        if (MODE == E_UQ) hs[ai][m] = ((const f32x4*)e.f0)[row0 + ai * 128 + m * 16].x * MLA_QSCALE;
        if (MODE == E_UKV) hs[ai][m] = ((const f32x4*)e.f0)[row0 + ai * 128 + m * 16].y; }
    EpiPre q[2][4];
#pragma unroll
    for (int i = 0; i < 4; ++i) preload(q[0][i], row0 + (i >> 1) * 16, col0 + (i & 1) * 128);
#pragma unroll
    for (int gi = 0; gi < 4; ++gi) {
      const int ai = gi >> 1, mp = gi & 1;
      if (gi + 1 < 4) { const int ai2 = (gi + 1) >> 1, mp2 = (gi + 1) & 1;
#pragma unroll
        for (int i = 0; i < 4; ++i) preload(q[(gi + 1) & 1][i], row0 + ai2 * 128 + (2 * mp2 + (i >> 1)) * 16, col0 + (i & 1) * 128); }
      asm volatile("" ::: "memory");
#pragma unroll
      for (int i = 0; i < 4; ++i) { const int m = 2 * mp + (i >> 1), bj = i & 1; emit(q[gi & 1][i], row0 + ai * 128 + m * 16, col0 + bj * 128, acc[ai][bj][m][0], acc[ai][bj][m][1], hb, hs, ai, m, bj); }
      asm volatile("" ::: "memory");
    }
  }
};

template <int MODE>
__device__ __forceinline__ void run_gemm(LAS unsigned char* lds, const bf16_t* A, int lda, const bf16_t* Bt, int M, int N, int K, const EpiP& ep, int wv0) {
  pg8::Gemm g; g.A = A; g.Bt = Bt; g.M = M; g.N = N; g.K = K; g.lda = lda;
  pg8::StaticOrder S; S.init(M, N, ogrid(), obid());
  Epi<MODE> E; E.e = ep;
  pg8::gemm_phase(lds, g, S, E, wv0);
}

__device__ __forceinline__ int rope_src(int j) { return (j & 1) ? 32 + (j >> 1) : (j >> 1); }
__device__ __forceinline__ int srcmap(int kind, int n) {
  if (kind == 0) return n;
  if (kind == 1) {
    if (n < C_KR) return n;
    if (n < C_HU) return 2304 + rope_src(n - C_KR);
    if (n < C_CQ) return n - C_HU + 2368;
    if (n < C_CKV) return n - C_CQ + 1280;
    if (n < C_HV) return n - C_CKV + 1792;
    if (n < LDH) return n;
    return -1;
  }
  if (kind == 2) return 4416 + n;
  if (kind == 4) { const int pn = n >> 8, lc = n & 255; return lc < 128 ? 128 * pn + lc : DFF + 128 * pn + (lc - 128); }
  { const int hd = n / 192, c = n % 192; if (c < 128) return n; return hd * 192 + 128 + rope_src(c - 128); }
}
__device__ __forceinline__ void cvt_job(LAS unsigned char* lds, const float* src, bf16_t* dst, const float* kscale, int K, int Nsrc, int Ndst, int kind, int wv0, int bid_, int grd_) {
  LAS float* tile = (LAS float*)lds;
  const int tid = otid(wv0), nkt = K / 64, ntile = (Ndst / 64) * nkt;
  if (bid_ < 0) return;
  const int nl = tid & 63, kb = tid >> 6;
  float v[8];
#define CVT_LOAD(t_) do { const int k0_ = ((t_) % nkt) * 64, n0_ = ((t_) / nkt) * 64; const int sn = srcmap(kind, n0_ + nl); \
    _Pragma("unroll") for (int i = 0; i < 8; ++i) { const int kl = kb + 8 * i; v[i] = 0.f; \
      if (sn >= 0) { v[i] = src[(size_t)(k0_ + kl) * Nsrc + sn]; if (kscale) v[i] *= kscale[k0_ + kl]; } } } while (0)
  if (bid_ < ntile) CVT_LOAD(bid_);
  for (int t = bid_; t < ntile; t += grd_) {
    const int k0 = (t % nkt) * 64, n0 = (t / nkt) * 64;
#pragma unroll
    for (int i = 0; i < 8; ++i) tile[(kb + 8 * i) * 65 + nl] = v[i];
    __syncthreads();
    if (t + grd_ < ntile) CVT_LOAD(t + grd_);
    { const int nl2 = tid >> 3, kc = (tid & 7) * 8; float w[8];
#pragma unroll
      for (int j = 0; j < 8; ++j) w[j] = tile[(kc + j) * 65 + nl2];
      store8bf(dst + (size_t)(n0 + nl2) * K + k0 + kc, w); }
    __syncthreads();
  }
#undef CVT_LOAD
}
__device__ __forceinline__ void cvt_mixer_a(KP p, int l, LAS unsigned char* lds, int wv0) {
  unsigned char* W = p->ws; const int f = obid(), st = ogrid();
  cvt_job(lds, p->w_in + (size_t)l * DM * NIN, (bf16_t*)(W + O_WMAIN), nullptr, DM, NIN, NHP, 1, wv0, f, st);
  cvt_job(lds, p->w_in + (size_t)l * DM * NIN, (bf16_t*)(W + O_WG), nullptr, DM, NIN, NG, 2, wv0, f, st);
}
__device__ __forceinline__ void cvt_mixer_b(KP p, int l, LAS unsigned char* lds, int wv0, int f, int st) {
  unsigned char* W = p->ws;
  cvt_job(lds, p->w_uq + (size_t)l * 512 * NQ, (bf16_t*)(W + O_WUQ), p->q_norm_g + l * 512, 512, NQ, NQ, 3, wv0, f, st);
  cvt_job(lds, p->w_ukv + (size_t)l * 512 * NKV, (bf16_t*)(W + O_WUKV), p->kv_norm_g + l * 512, 512, NKV, NKV, 0, wv0, f, st);
  cvt_job(lds, p->w_proj_a + (size_t)l * 1024 * DM, (bf16_t*)(W + O_PA), nullptr, 1024, DM, DM, 0, wv0, f, st);
  cvt_job(lds, p->w_proj_b + (size_t)l * 2048 * DM, (bf16_t*)(W + O_PB), nullptr, 2048, DM, DM, 0, wv0, f, st);
  cvt_job(lds, p->w_proj_c + (size_t)l * 1024 * DM, (bf16_t*)(W + O_PC), nullptr, 1024, DM, DM, 0, wv0, f, st);
  cvt_job(lds, p->w_o + (size_t)l * DM * DM, (bf16_t*)(W + O_WO), nullptr, DM, DM, DM, 0, wv0, f, st);
}
__device__ __forceinline__ void cvt_ffn(KP p, int l, LAS unsigned char* lds, int wv0) {
  unsigned char* W = p->ws; const int f = obid(), st = ogrid();
  cvt_job(lds, p->w_up + (size_t)l * DM * NUP, (bf16_t*)(W + O_WUP), nullptr, DM, NUP, NUP, 4, wv0, f, st);
  cvt_job(lds, p->w_down + (size_t)l * DFF * DM, (bf16_t*)(W + O_WDN), nullptr, DFF, DM, DM, 0, wv0, f, st);
}

__device__ __forceinline__ void prologue(KP p, int wv0) {
  const size_t tid = (size_t)obid() * 512 + otid(wv0), nth = (size_t)ogrid() * 512;
  bf16_t* xb = (bf16_t*)(p->ws + O_XB);
  for (size_t i = tid; i < (size_t)NTOK * DM / 4; i += 4 * nth) {
    f32x4 v[4];
#pragma unroll
    for (int j = 0; j < 4; ++j) if (i + j * nth < (size_t)NTOK * DM / 4) v[j] = ((const f32x4*)p->x)[i + j * nth];
#pragma unroll
    for (int j = 0; j < 4; ++j) if (i + j * nth < (size_t)NTOK * DM / 4) { u32x2 w; w.x = pk2(v[j][0], v[j][1]); w.y = pk2(v[j][2], v[j][3]); ((u32x2*)xb)[i + j * nth] = w; } }
  f32x2* cs = (f32x2*)(p->ws + O_CS);
  for (size_t i = tid; i < (size_t)NTOK * 32; i += nth) {
    const int tok = (int)(i >> 5), f = (int)(i & 31);
    const float ang = (float)p->pos[tok] * INV_FREQ[f];
    double t = (double)ang * 0.15915494309189535; t -= __builtin_rint(t);
    const float tf = (float)t;
    cs[i] = (f32x2){__builtin_amdgcn_cosf(tf), __builtin_amdgcn_sinf(tf)};
  }
}

__device__ __forceinline__ void stats_phase(KP p, int wv0) {
  const bf16_t* h = (const bf16_t*)(p->ws + O_H); f32x4* st = (f32x4*)(p->ws + O_ST);
  const int tid_ = otid(wv0); const int lane = tid_ & 63, wv = obid() * 8 + (tid_ >> 6), nwv = ogrid() * 8;
  for (int row0 = wv; row0 < NTOK; row0 += 4 * nwv) {
    u32x4 a[4], b[4], v0[4], v1[4];
#pragma unroll
    for (int k = 0; k < 4; ++k) { const int row = row0 + k * nwv < NTOK ? row0 + k * nwv : row0; const bf16_t* hr = h + (size_t)row * LDH;
      a[k] = *(const u32x4*)(hr + C_CQ + lane * 8); b[k] = *(const u32x4*)(hr + C_CKV + lane * 8);
      v0[k] = *(const u32x4*)(hr + C_HV + lane * 16); v1[k] = *(const u32x4*)(hr + C_HV + lane * 16 + 8); }
    float sa[4], sb[4], sv[4], sq[4], mu[4];
#pragma unroll
    for (int k = 0; k < 4; ++k) { sa[k] = 0.f; sb[k] = 0.f; sv[k] = 0.f;
#pragma unroll
      for (int j = 0; j < 4; ++j) { float x0 = bf_lo(a[k][j]), x1 = bf_hi(a[k][j]); sa[k] += x0 * x0 + x1 * x1; x0 = bf_lo(b[k][j]); x1 = bf_hi(b[k][j]); sb[k] += x0 * x0 + x1 * x1;
        sv[k] += bf_lo(v0[k][j]) + bf_hi(v0[k][j]) + bf_lo(v1[k][j]) + bf_hi(v1[k][j]); } }
#pragma unroll
    for (int o = 32; o > 0; o >>= 1)
#pragma unroll
      for (int k = 0; k < 4; ++k) { sa[k] += __shfl_xor(sa[k], o); sb[k] += __shfl_xor(sb[k], o); sv[k] += __shfl_xor(sv[k], o); }
#pragma unroll
    for (int k = 0; k < 4; ++k) { mu[k] = sv[k] * (1.0f / 1024.0f); sq[k] = 0.f;
#pragma unroll
      for (int j = 0; j < 4; ++j) { float d;
        d = bf_lo(v0[k][j]) - mu[k]; sq[k] += d * d; d = bf_hi(v0[k][j]) - mu[k]; sq[k] += d * d; d = bf_lo(v1[k][j]) - mu[k]; sq[k] += d * d; d = bf_hi(v1[k][j]) - mu[k]; sq[k] += d * d; } }
#pragma unroll
    for (int o = 32; o > 0; o >>= 1)
#pragma unroll
      for (int k = 0; k < 4; ++k) sq[k] += __shfl_xor(sq[k], o);
#pragma unroll
    for (int k = 0; k < 4; ++k) if (lane == 0 && row0 + k * nwv < NTOK)
      st[row0 + k * nwv] = (f32x4){__builtin_amdgcn_rsqf(sa[k] * (1.0f / 512.0f) + EPS), __builtin_amdgcn_rsqf(sb[k] * (1.0f / 512.0f) + EPS), mu[k], __builtin_amdgcn_rsqf(sq[k] * (1.0f / 1024.0f) + EPS)};
  }
}

__device__ __forceinline__ void ln_phase(const float* in, float* outf, bf16_t* outb, const float* g, const float* b, int wv0) {
  const int tid_ = otid(wv0); const int lane = tid_ & 63, wv = obid() * 8 + (tid_ >> 6), nwv = ogrid() * 8;
  f32x4 gg[8], bb[8];
#pragma unroll
  for (int i = 0; i < 8; ++i) { gg[i] = ((const f32x4*)g)[i * 64 + lane]; bb[i] = ((const f32x4*)b)[i * 64 + lane]; }
  f32x4 vn[8];
  if (wv < NTOK) { const f32x4* ir = (const f32x4*)(in + (size_t)wv * DM);
#pragma unroll
    for (int i = 0; i < 8; ++i) vn[i] = ir[i * 64 + lane]; }
  for (int row = wv; row < NTOK; row += nwv) {
    f32x4 v[8]; float s = 0.f;
#pragma unroll
    for (int i = 0; i < 8; ++i) v[i] = vn[i];
    if (row + nwv < NTOK) { const f32x4* ir = (const f32x4*)(in + (size_t)(row + nwv) * DM);
#pragma unroll
      for (int i = 0; i < 8; ++i) vn[i] = ir[i * 64 + lane]; }
#pragma unroll
    for (int i = 0; i < 8; ++i) s += v[i][0] + v[i][1] + v[i][2] + v[i][3];
    s = wave_sum(s); const float mu = s * (1.0f / 2048.0f);
    float sq = 0.f;
#pragma unroll
    for (int i = 0; i < 8; ++i) { v[i] -= mu; sq += v[i][0] * v[i][0] + v[i][1] * v[i][1] + v[i][2] * v[i][2] + v[i][3] * v[i][3]; }
    sq = wave_sum(sq); const float rstd = __builtin_amdgcn_rsqf(sq * (1.0f / 2048.0f) + EPS);
#pragma unroll
    for (int i = 0; i < 8; ++i) {
      const f32x4 y = v[i] * rstd * gg[i] + bb[i];
      ((f32x4*)(outf + (size_t)row * DM))[i * 64 + lane] = y;
      if (outb) { u32x2 w; w.x = pk2(y[0], y[1]); w.y = pk2(y[2], y[3]); ((u32x2*)(outb + (size_t)row * DM))[i * 64 + lane] = w; } }
  }
}

template <int NQK, int NDV, int KSTR, int VSTR>
__device__ __forceinline__ void attn_tile(const bf16x8 (&qf)[NQK], f32x16 (&o)[NDV], float& m, float& l, const LAS unsigned char* Kt, const LAS unsigned char* Vt,
                                          int lane, int qpos, int kpos0, int window, bool domask) {
  const int c = lane & 31, h = lane >> 5;
  f32x16 s0, s1;
#pragma unroll
  for (int r = 0; r < 16; ++r) { s0[r] = 0.f; s1[r] = 0.f; }
  const LAS unsigned char* ka = Kt + c * KSTR + h * 16;
  bf16x8 kc0 = *(const LAS bf16x8*)(ka), kc1 = *(const LAS bf16x8*)(ka + 32 * KSTR);
#pragma unroll
  for (int st = 0; st < NQK; ++st) {
    bf16x8 kn0 = kc0, kn1 = kc1;
    if (st + 1 < NQK) { kn0 = *(const LAS bf16x8*)(ka + (st + 1) * 32); kn1 = *(const LAS bf16x8*)(ka + 32 * KSTR + (st + 1) * 32); }
    s0 = mfma32(kc0, qf[st], s0);
    s1 = mfma32(kc1, qf[st], s1);
    if (st + 1 < NQK) __builtin_amdgcn_sched_group_barrier(0x100, 2, 0);
    __builtin_amdgcn_sched_group_barrier(0x008, 2, 0);
    __builtin_amdgcn_sched_barrier(0);
    kc0 = kn0; kc1 = kn1;
  }
  __builtin_amdgcn_sched_barrier(0);
  if (domask) {
#pragma unroll
    for (int r = 0; r < 16; ++r) { const int kp = kpos0 + (r & 3) + 8 * (r >> 2) + 4 * h;
      const bool v0 = (kp <= qpos) && (kp > qpos - window) && (kp >= 0);
      const bool v1 = (kp + 32 <= qpos) && (kp + 32 > qpos - window) && (kp + 32 >= 0);
      s0[r] = v0 ? s0[r] : -1e30f; s1[r] = v1 ? s1[r] : -1e30f; }
  }
  float mx = fmaxf(s0[0], s1[0]);
#pragma unroll
  for (int r = 1; r < 16; ++r) mx = fmaxf(mx, fmaxf(s0[r], s1[r]));
  mx = fmaxf(mx, __shfl_xor(mx, 32));
  if (__builtin_amdgcn_ballot_w64(mx > m + 8.0f) != 0ull) {
    const float mn = fmaxf(m, mx), alpha = fexp2(m - mn);
    m = mn; l *= alpha;
#pragma unroll
    for (int d = 0; d < NDV; ++d) o[d] *= alpha;
  }
  float ps = 0.f;
#pragma unroll
  for (int r = 0; r < 16; ++r) { s0[r] = fexp2(s0[r] - m); s1[r] = fexp2(s1[r] - m); ps += s0[r] + s1[r]; }
  l += ps;
  bf16x8 pf[4];
#pragma unroll
  for (int s = 0; s < 2; ++s) {
    u32x4 w0, w1;
    w0.x = pk2(s0[8 * s + 0], s0[8 * s + 1]); w0.y = pk2(s0[8 * s + 2], s0[8 * s + 3]); w0.z = pk2(s0[8 * s + 4], s0[8 * s + 5]); w0.w = pk2(s0[8 * s + 6], s0[8 * s + 7]);
    w1.x = pk2(s1[8 * s + 0], s1[8 * s + 1]); w1.y = pk2(s1[8 * s + 2], s1[8 * s + 3]); w1.z = pk2(s1[8 * s + 4], s1[8 * s + 5]); w1.w = pk2(s1[8 * s + 6], s1[8 * s + 7]);
    pf[s] = __builtin_bit_cast(bf16x8, w0); pf[2 + s] = __builtin_bit_cast(bf16x8, w1);
  }
  __builtin_amdgcn_sched_barrier(0);
  const int i16 = lane & 15, g16 = (lane >> 4) & 1;
  const LAS unsigned char* va = Vt + (4 * h + (i16 >> 2)) * VSTR + (16 * g16 + 4 * (i16 & 3)) * 2;
  bf16x8 vc[NDV];
#pragma unroll
  for (int d = 0; d < NDV; ++d) { const v4i16_t lo = vtr(va + d * 64), hi = vtr(va + 8 * VSTR + d * 64); vc[d] = __builtin_shufflevector(lo, hi, 0, 1, 2, 3, 4, 5, 6, 7); }
#pragma unroll
  for (int ks = 0; ks < 4; ++ks) {
    bf16x8 vn[NDV];
#pragma unroll
    for (int d = 0; d < NDV; ++d) { vn[d] = vc[d];
      if (ks + 1 < 4) { const v4i16_t lo = vtr(va + (16 * (ks + 1)) * VSTR + d * 64), hi = vtr(va + (16 * (ks + 1) + 8) * VSTR + d * 64); vn[d] = __builtin_shufflevector(lo, hi, 0, 1, 2, 3, 4, 5, 6, 7); } }
#pragma unroll
    for (int d = 0; d < NDV; ++d) o[d] = mfma32(vc[d], pf[ks], o[d]);
    if (ks + 1 < 4) __builtin_amdgcn_sched_group_barrier(0x100, 2 * NDV, 0);
    __builtin_amdgcn_sched_group_barrier(0x008, NDV, 0);
    __builtin_amdgcn_sched_barrier(0);
#pragma unroll
    for (int d = 0; d < NDV; ++d) vc[d] = vn[d];
  }
}

__device__ __forceinline__ void mla_phase(KP p, LAS unsigned char* lds, int wv0) {
  constexpr int KSTR = 400, VSTR = 320, KB = 64 * KSTR, VB = 64 * VSTR;
  const bf16_t* q = (const bf16_t*)(p->ws + O_Q); const bf16_t* kv = (const bf16_t*)(p->ws + O_KV);
  bf16_t* h = (bf16_t*)(p->ws + O_H);
  const int tid = otid(wv0), wid = __builtin_amdgcn_readfirstlane(tid >> 6), lane = tid & 63, c = lane & 31, hh = lane >> 5;
  const int G = ogrid(), bid = obid();
  for (int k = 0; k * G < 1024; ++k) {
    const int idx = (k & 1) ? (G - 1 - bid) : bid, rank = k * G + idx;
    if (rank >= 1024) continue;
    const int qb = 15 - rank / 64, bh = rank % 64, b = bh >> 4, hd = bh & 15;
    const int tok0 = b * SEQ, q0 = qb * 256 + 32 * wid;
    bf16x8 qf[12];
    { const bf16_t* qrow = q + (size_t)(tok0 + q0 + c) * NQ + hd * 192 + 8 * hh;
#pragma unroll
      for (int st = 0; st < 12; ++st) qf[st] = *(const bf16x8*)(qrow + 16 * st); }
    f32x16 o[4];
#pragma unroll
    for (int d = 0; d < 4; ++d)
#pragma unroll
      for (int r = 0; r < 16; ++r) o[d][r] = 0.f;
    float m = -1e30f, l = 0.f;
    const int ntiles = qb * 4 + 4;
    unsigned ksrc[3]; int kdst[3];
    const unsigned char* wsb = p->ws;
#pragma unroll
    for (int i = 0; i < 3; ++i) { const int cid = tid + 512 * i, key = cid / 24, ch = cid % 24;
      ksrc[i] = (ch < 16) ? (unsigned)(O_KV + ((size_t)(tok0 + key) * NKV + hd * 256 + ch * 8) * 2) : (unsigned)(O_H + ((size_t)(tok0 + key) * LDH + C_KR + (ch - 16) * 8) * 2);
      kdst[i] = key * KSTR + ch * 16; }
    const unsigned kinc0 = 64u * NKV * 2u, kinc1 = 64u * LDH * 2u;
    const bool k2rope = ((tid + 1024) % 24) >= 16, k1rope = ((tid + 512) % 24) >= 16, k0rope = (tid % 24) >= 16;
    unsigned vsrc[2]; int vdst[2];
#pragma unroll
    for (int i = 0; i < 2; ++i) { const int cid = tid + 512 * i, key = cid >> 4, ch = cid & 15;
      vsrc[i] = (unsigned)(O_KV + ((size_t)(tok0 + key) * NKV + hd * 256 + 128 + ch * 8) * 2); vdst[i] = key * VSTR + ch * 16; }
    u32x4 kr0 = *(const u32x4*)(wsb + ksrc[0]), kr1 = *(const u32x4*)(wsb + ksrc[1]), kr2 = *(const u32x4*)(wsb + ksrc[2]), vr0 = *(const u32x4*)(wsb + vsrc[0]), vr1 = *(const u32x4*)(wsb + vsrc[1]);
    for (int kt = 0; kt < ntiles; ++kt) {
      LAS unsigned char* Kb = lds + (kt & 1) * KB; LAS unsigned char* Vb = lds + 2 * KB + (kt & 1) * VB;
      *(LAS u32x4*)(Kb + kdst[0]) = kr0; *(LAS u32x4*)(Kb + kdst[1]) = kr1; *(LAS u32x4*)(Kb + kdst[2]) = kr2;
      *(LAS u32x4*)(Vb + vdst[0]) = vr0; *(LAS u32x4*)(Vb + vdst[1]) = vr1;
      __syncthreads();
      if (kt + 1 < ntiles) {
        ksrc[0] += k0rope ? kinc1 : kinc0; ksrc[1] += k1rope ? kinc1 : kinc0; ksrc[2] += k2rope ? kinc1 : kinc0; vsrc[0] += kinc0; vsrc[1] += kinc0;
        kr0 = *(const u32x4*)(wsb + ksrc[0]); kr1 = *(const u32x4*)(wsb + ksrc[1]); kr2 = *(const u32x4*)(wsb + ksrc[2]); vr0 = *(const u32x4*)(wsb + vsrc[0]); vr1 = *(const u32x4*)(wsb + vsrc[1]);
      }
      const int k0 = kt * 64;
      if (k0 <= q0 + 31) attn_tile<12, 4, KSTR, VSTR>(qf, o, m, l, Kb, Vb, lane, q0 + c, k0, 1 << 30, k0 + 63 > q0);
    }
    const float inv = frcp(l + __shfl_xor(l, 32));
    bf16_t* yrow = h + (size_t)(tok0 + q0 + c) * LDH + C_CQ + hd * 128 + 4 * hh;
#pragma unroll
    for (int d = 0; d < 4; ++d)
#pragma unroll
      for (int g = 0; g < 4; ++g) { u32x2 w; w.x = pk2(o[d][4 * g] * inv, o[d][4 * g + 1] * inv); w.y = pk2(o[d][4 * g + 2] * inv, o[d][4 * g + 3] * inv);
        *(u32x2*)(yrow + 32 * d + 8 * g) = w; }
    __syncthreads();
  }
}

__device__ __forceinline__ void swa_phase(KP p, int l, LAS unsigned char* lds, int wv0, int dummy = 0) {
  constexpr int STR = 144, VST = 192, TB = 64 * VST;
  bf16_t* h = (bf16_t*)(p->ws + O_H);
  const int tid = otid(wv0), wid = __builtin_amdgcn_readfirstlane(tid >> 6), lane = tid & 63, c = lane & 31, hh = lane >> 5;
  const int bid_ = obid(), grd_ = ogrid();
  for (int it = bid_; it < 512; it += grd_) {
    const int b = it >> 7, r = it & 127, kvh = r >> 6, qblk = r & 63, t0 = qblk * 64, hq = kvh * 8 + wid;
    const size_t tokb = (size_t)b * SEQ;
    bf16x8 qf[2][4];
    bf16_t* qrow0 = h + (tokb + t0 + c) * LDH + C_QA + hq * 64;
#pragma unroll
    for (int sub = 0; sub < 2; ++sub)
#pragma unroll
      for (int st = 0; st < 4; ++st) qf[sub][st] = *(const bf16x8*)(qrow0 + (size_t)sub * 32 * LDH + 16 * st + 8 * hh);
    { const int key = tid >> 3, ch = tid & 7;
#pragma unroll
      for (int j = 0; j < 3; ++j) { int kp = t0 - 128 + 64 * j + key; kp = kp < 0 ? 0 : kp;
        const bf16_t* src = h + (tokb + kp) * LDH + C_KA + kvh * 64 + ch * 8;
        *(LAS u32x4*)(lds + j * 2 * TB + key * STR + ch * 16) = *(const u32x4*)src;
        *(LAS u32x4*)(lds + j * 2 * TB + TB + key * VST + ch * 16) = *(const u32x4*)(src + (C_VA - C_KA)); } }
    __syncthreads();
    const float sink2 = p->sinks[l * 16 + hq] * LOG2E;
#pragma unroll
    for (int sub = 0; sub < 2; ++sub) {
      float m = sink2, ls = 0.f;
      f32x16 o[2];
#pragma unroll
      for (int d = 0; d < 2; ++d)
#pragma unroll
        for (int rr = 0; rr < 16; ++rr) o[d][rr] = 0.f;
      const int qpos = t0 + 32 * sub + c;
#pragma unroll
      for (int j = 0; j < 3; ++j) { const int k0 = t0 - 128 + 64 * j;
        if (k0 + 63 >= 0 && k0 + 63 >= t0 + 32 * sub - 127 && k0 <= t0 + 32 * sub + 31)
          attn_tile<4, 2, STR, VST>(qf[sub], o, m, ls, lds + j * 2 * TB, lds + j * 2 * TB + TB, lane, qpos, k0, 128, true); }
      const float inv = frcp(ls + __shfl_xor(ls, 32) + fexp2(sink2 - m));
      bf16_t* qrow = qrow0 + (size_t)sub * 32 * LDH;
#pragma unroll
      for (int d = 0; d < 2; ++d)
#pragma unroll
        for (int g = 0; g < 4; ++g) { u32x2 w; w.x = pk2(o[d][4 * g] * inv, o[d][4 * g + 1] * inv); w.y = pk2(o[d][4 * g + 2] * inv, o[d][4 * g + 3] * inv);
          bf16_t* dst_ = dummy ? (bf16_t*)(p->ws + O_Q) + (tokb + t0 + 32 * sub + c) * 1024 + hq * 64 : qrow; *(u32x2*)(dst_ + 32 * d + 8 * g + 4 * hh) = w; }
    }
    __syncthreads();
  }
}

__device__ __forceinline__ void sgu_phase(KP p, int l, LAS unsigned char* lds, int wv0, int dummy = 0) {
  constexpr int STR = 272;
  bf16_t* h = (bf16_t*)(p->ws + O_H); const f32x4* st = (const f32x4*)(p->ws + O_ST);
  LAS unsigned char* Wl = lds; LAS unsigned char* Vl = lds + 128 * STR;
  const int tid = otid(wv0), wid = __builtin_amdgcn_readfirstlane(tid >> 6), lane = tid & 63, c = lane & 31, hh = lane >> 5;
  const int bid_ = obid(), grd_ = ogrid();
  int gprev = -1;
  for (int it = bid_; it < 1024; it += grd_) {
    const int cidx = it >> 3, g = it & 7, tb0 = cidx * 128;
    if (g != gprev) {
      gprev = g;
      const float* wg = p->sgu_w + ((size_t)l * 8 + g) * 128 * 128;
#pragma unroll
      for (int i = 0; i < 8; ++i) { const int idx = tid + 512 * i, t = idx >> 5, s4 = (idx & 31) * 4;
        const f32x4 v = *(const f32x4*)(wg + t * 128 + s4);
        u32x2 w; w.x = pk2(s4 <= t ? v[0] : 0.f, s4 + 1 <= t ? v[1] : 0.f); w.y = pk2(s4 + 2 <= t ? v[2] : 0.f, s4 + 3 <= t ? v[3] : 0.f);
        *(LAS u32x2*)(Wl + t * STR + s4 * 2) = w; }
    }
#pragma unroll
    for (int i = 0; i < 4; ++i) { const int cid = tid + 512 * i, s = cid >> 4, ch = cid & 15;
      const u32x4 hv = *(const u32x4*)(h + (size_t)(tb0 + s) * LDH + C_HV + g * 128 + ch * 8);
      const f32x4 sv = st[tb0 + s]; const float mu = sv.z, rstd = sv.w;
      const float* lg = p->sgu_ln_g + l * 1024 + g * 128 + ch * 8; const float* lb = p->sgu_ln_b + l * 1024 + g * 128 + ch * 8;
      const f32x4 g0 = *(const f32x4*)lg, g1 = *(const f32x4*)(lg + 4), b0 = *(const f32x4*)lb, b1 = *(const f32x4*)(lb + 4);
      u32x4 w;
      w.x = pk2((bf_lo(hv.x) - mu) * rstd * g0[0] + b0[0], (bf_hi(hv.x) - mu) * rstd * g0[1] + b0[1]);
      w.y = pk2((bf_lo(hv.y) - mu) * rstd * g0[2] + b0[2], (bf_hi(hv.y) - mu) * rstd * g0[3] + b0[3]);
      w.z = pk2((bf_lo(hv.z) - mu) * rstd * g1[0] + b1[0], (bf_hi(hv.z) - mu) * rstd * g1[1] + b1[1]);
      w.w = pk2((bf_lo(hv.w) - mu) * rstd * g1[2] + b1[2], (bf_hi(hv.w) - mu) * rstd * g1[3] + b1[3]);
      *(LAS u32x4*)(Vl + s * STR + ch * 16) = w; }
    __syncthreads();
    const int tblk = wid >> 1, cb0 = (wid & 1) * 2;
    f32x16 acc[2];
#pragma unroll
    for (int d = 0; d < 2; ++d)
#pragma unroll
      for (int r = 0; r < 16; ++r) acc[d][r] = 0.f;
    const int i16 = lane & 15, g16 = (lane >> 4) & 1;
    const LAS unsigned char* wa = Wl + (32 * tblk + c) * STR + hh * 16;
    const LAS unsigned char* va = Vl + (8 * hh + (i16 >> 2)) * STR + (32 * cb0 + 16 * g16 + 4 * (i16 & 3)) * 2;
#pragma unroll
    for (int s = 0; s < 8; ++s) {
      const bf16x8 a = *(const LAS bf16x8*)(wa + s * 32);
#pragma unroll
      for (int d = 0; d < 2; ++d) {
        const v4i16_t lo = vtr(va + (16 * s) * STR + d * 64);
        const v4i16_t hi = vtr(va + (16 * s + 4) * STR + d * 64);
        const bf16x8 bfr = __builtin_shufflevector(lo, hi, 0, 1, 2, 3, 4, 5, 6, 7);
        acc[d] = mfma32(a, bfr, acc[d]);
      }
    }
    const float* sb = p->sgu_b + ((size_t)l * 8 + g) * 128;
    float uu[2][16], sbv[16];
#pragma unroll
    for (int r = 0; r < 16; ++r) { const int t = 32 * tblk + (r & 3) + 8 * (r >> 2) + 4 * hh; sbv[r] = sb[t];
#pragma unroll
      for (int d = 0; d < 2; ++d) uu[d][r] = bf1(h[(size_t)(tb0 + t) * LDH + C_HU + g * 128 + 32 * (cb0 + d) + c]); }
    asm volatile("" ::: "memory");
#pragma unroll
    for (int d = 0; d < 2; ++d)
#pragma unroll
      for (int r = 0; r < 16; ++r) { const int t = 32 * tblk + (r & 3) + 8 * (r >> 2) + 4 * hh, cc = 32 * (cb0 + d) + c;
        bf16_t* up = h + (size_t)(tb0 + t) * LDH + C_HU + g * 128 + cc;
        const float y = uu[d][r] * (acc[d][r] + sbv[r]);
        bf16_t* dst_ = dummy ? (bf16_t*)p->out + (size_t)(tb0 + t) * 1024 + g * 128 + cc : up; *dst_ = (bf16_t)(pk2(y, 0.f) & 0xffffu); }
    __syncthreads();
  }
}

__device__ __forceinline__ void fixup_phase(KP p, int l, int wv0) {
  const bf16_t* side = (const bf16_t*)(p->ws + O_SIDE); bf16_t* act = (bf16_t*)(p->ws + O_ACT);
  const float* cw = p->conv_w + (size_t)l * 3 * NUP; const float* cb = p->conv_b + (size_t)l * NUP;
  const int ntask = 704 * 128;
  const int id0_ = obid() * 512 + otid(wv0), idst_ = ogrid() * 512;
  for (int id = id0_; id < ntask; id += idst_) {
    const int cgp = id % 704, rk = id / 704, k = rk >> 1, rr = rk & 1, c0 = cgp * 8, t = (k * 256 + rr) & (SEQ - 1);
    const bf16_t* s0p = side + ((size_t)k * 4 + rr) * NUP;
    const bf16_t* s1p = rr ? side + ((size_t)k * 4) * NUP : side + ((size_t)(k > 0 ? k - 1 : 0) * 4 + 3) * NUP;
    const bf16_t* s2p = side + ((size_t)(k > 0 ? k - 1 : 0) * 4 + (rr ? 3 : 2)) * NUP;
    const float m1 = (t >= 1) ? 1.f : 0.f, m2 = (t >= 2) ? 1.f : 0.f;
    float y[8];
#pragma unroll
    for (int hf = 0; hf < 2; ++hf) {
      const int c = c0 + 4 * hf;
      const u32x2 a0 = *(const u32x2*)(s0p + c), a1 = *(const u32x2*)(s1p + c), a2 = *(const u32x2*)(s2p + c);
      const u32x2 d0 = *(const u32x2*)(s0p + DFF + c), d1 = *(const u32x2*)(s1p + DFF + c), d2 = *(const u32x2*)(s2p + DFF + c);
      const f32x4 wg0 = *(const f32x4*)(cw + c), wg1 = *(const f32x4*)(cw + NUP + c), wg2 = *(const f32x4*)(cw + 2 * NUP + c), bg = *(const f32x4*)(cb + c);
      const f32x4 wv0_ = *(const f32x4*)(cw + DFF + c), wv1 = *(const f32x4*)(cw + NUP + DFF + c), wv2 = *(const f32x4*)(cw + 2 * NUP + DFF + c), bv = *(const f32x4*)(cb + DFF + c);
      const float g0[4] = {bf_lo(a0.x), bf_hi(a0.x), bf_lo(a0.y), bf_hi(a0.y)}, g1[4] = {bf_lo(a1.x), bf_hi(a1.x), bf_lo(a1.y), bf_hi(a1.y)}, g2[4] = {bf_lo(a2.x), bf_hi(a2.x), bf_lo(a2.y), bf_hi(a2.y)};
      const float v0[4] = {bf_lo(d0.x), bf_hi(d0.x), bf_lo(d0.y), bf_hi(d0.y)}, v1[4] = {bf_lo(d1.x), bf_hi(d1.x), bf_lo(d1.y), bf_hi(d1.y)}, v2[4] = {bf_lo(d2.x), bf_hi(d2.x), bf_lo(d2.y), bf_hi(d2.y)};
#pragma unroll
      for (int e = 0; e < 4; ++e) {
        const float cgv = bg[e] + wg0[e] * (g2[e] * m2) + wg1[e] * (g1[e] * m1) + wg2[e] * g0[e];
        const float cvv = bv[e] + wv0_[e] * (v2[e] * m2) + wv1[e] * (v1[e] * m1) + wv2[e] * v0[e];
        y[4 * hf + e] = silu_mul(cgv, cvv);
      }
    }
    store8bf(act + (size_t)(k * 256 + rr) * DFF + c0, y);
  }
}

#define XB_TMO      128
#define XB_XCNT(j)  (256  + 64 * (j))
#define XB_XSUB(j)  (1280 + 64 * (j))
#define XB_XGEN(j)  (2304 + 64 * (j))
#define XB_TOP      3328
#define XB_TOPGEN   3392
#define XCD_BAR_WORDS 3456
#define XB_SPIN_CAP (1u << 20)
__device__ __forceinline__ unsigned xb_ld(unsigned* p)              { return __hip_atomic_load(p, __ATOMIC_RELAXED, __HIP_MEMORY_SCOPE_AGENT); }
__device__ __forceinline__ unsigned xb_add(unsigned* p, unsigned v) { return __hip_atomic_fetch_add(p, v, __ATOMIC_RELAXED, __HIP_MEMORY_SCOPE_AGENT); }
__device__ __forceinline__ unsigned xb_xcc_id() { return (unsigned)__builtin_amdgcn_s_getreg((3 << 11) | 20) & 0xFu; }
#define XB_SPIN(cond, bar) do { unsigned _sp = 0; while (cond) { __builtin_amdgcn_s_sleep(1); \
    if ((++_sp & 255u) == 0u) { if (xb_ld(&(bar)[XB_TMO])) break; if (_sp > XB_SPIN_CAP) { atomicAdd(&(bar)[XB_TMO], 1u); break; } } } } while (0)
__device__ __forceinline__ void xcd_barrier_complete(unsigned* bar, unsigned x, unsigned& nloc, unsigned& nx) {
    const unsigned G = gridDim.x * gridDim.y * gridDim.z;
    unsigned sum, cnt, mine, sp = 0u;
    for (;;) {
        sum = 0u; cnt = 0u; mine = 0u;
#pragma unroll
        for (unsigned j = 0; j < 16; ++j) { const unsigned c = xb_ld(&bar[XB_XCNT(j)]); sum += c; cnt += (c > 0u) ? 1u : 0u; mine = (j == x) ? c : mine; }
        if (sum == G) break;
        __builtin_amdgcn_s_sleep(1);
        if ((++sp & 255u) == 0u) { if (xb_ld(&bar[XB_TMO])) break; if (sp > XB_SPIN_CAP) { atomicAdd(&bar[XB_TMO], 1u); break; } }
    }
    nloc = mine > 0u ? mine : 1u; nx = cnt > 0u ? cnt : 1u;
}
__device__ __forceinline__ void xcd_barrier(unsigned* bar, volatile LAS unsigned* st, int wv0) {
    asm volatile("s_waitcnt vmcnt(0)" ::: "memory");
    __syncthreads();
    if (otid(wv0) == 0) {
        const unsigned x = xb_xcc_id();
        __builtin_amdgcn_s_waitcnt(0);
        unsigned nloc = st[0], nx = st[1];
        if (nloc == 0u) { xcd_barrier_complete(bar, x, nloc, nx); st[0] = nloc; st[1] = nx; }
        const unsigned old = xb_add(&bar[XB_XSUB(x)], 1u);
        const unsigned gen = old / nloc;
        if (old + 1u == (gen + 1u) * nloc) {
            __builtin_amdgcn_fence(__ATOMIC_RELEASE, "agent");
            asm volatile("s_waitcnt vmcnt(0)" ::: "memory");
            const unsigned og = xb_add(&bar[XB_TOP], 1u);
            const unsigned tg = og / nx;
            if (og + 1u == (tg + 1u) * nx) xb_add(&bar[XB_TOPGEN], 1u);
            else XB_SPIN(xb_ld(&bar[XB_TOPGEN]) == tg, bar);
            __builtin_amdgcn_fence(__ATOMIC_ACQUIRE, "agent");
            xb_add(&bar[XB_XGEN(x)], 1u);
            asm volatile("s_waitcnt vmcnt(0)" ::: "memory");
        } else {
            XB_SPIN(xb_ld(&bar[XB_XGEN(x)]) == gen, bar);
            __builtin_amdgcn_fence(__ATOMIC_ACQUIRE, "agent");
            asm volatile("s_waitcnt vmcnt(0)" ::: "memory");
        }
    }
    __syncthreads();
}
#define GSYNC() xcd_barrier((unsigned*)(p->ws + O_BAR), (volatile LAS unsigned*)((LAS unsigned char*)shm + 131072), wv0)

#ifndef PH_MASK
#define PH_MASK 0xFFFFF
#endif
#ifndef REP_MASK
#define REP_MASK 0
#endif
#define PH(b) for (int rep_ = 0, nrep_ = (int)(((PH_MASK >> (b)) & 1) + ((REP_MASK >> (b)) & 1)); rep_ < nrep_; ++rep_)
#define LAUNDER() do { asm volatile("" : "+s"(p), "+s"(l), "+s"(wv0) :: "memory"); ws = p->ws; xb = (bf16_t*)(ws + O_XB); xa = (float*)(ws + O_XA); hbuf = (bf16_t*)(ws + O_H); qbuf = (bf16_t*)(ws + O_Q); kvbuf = (bf16_t*)(ws + O_KV); gbuf = qbuf; mb = xb; cs = (const float*)(ws + O_CS); st = (const float*)(ws + O_ST); } while (0)
__global__ void __launch_bounds__(512, 2) mega(Params p_unused) {
  KP p = (KP)__builtin_amdgcn_kernarg_segment_ptr();
  int wv0 = __builtin_amdgcn_readfirstlane((int)threadIdx.x >> 6);
  extern __shared__ __attribute__((aligned(16))) unsigned char shm[];
  LAS unsigned char* lds = (LAS unsigned char*)shm;
  cg::grid_group grid = cg::this_grid();
  unsigned char* ws;
  bf16_t* xb; float* xa; bf16_t* hbuf; bf16_t* qbuf; bf16_t* kvbuf;
  bf16_t* gbuf;
  bf16_t* mb;
  const float* cs; const float* st; int l = 0;
  LAUNDER();

  if (otid(wv0) == 0) { volatile LAS unsigned* bst = (volatile LAS unsigned*)(lds + 131072); bst[0] = 0u; bst[1] = 0u; }
  { unsigned* bar0 = (unsigned*)(p->ws + O_BAR); for (int i = obid() * 512 + otid(wv0); i < XCD_BAR_WORDS; i += ogrid() * 512) bar0[i] = 0u; }
  PH(0) cvt_mixer_a(p, 0, lds, wv0);
  PH(1) prologue(p, wv0);
  grid.sync(); LAUNDER();
  if (otid(wv0) == 0) (void)xb_add((unsigned*)(ws + O_BAR) + XB_XCNT(xb_xcc_id()), 1u);
  for (l = 0; l < 2; ++l) {
    LAUNDER();
    PH(2) { EpiP e{}; e.out = hbuf; e.f0 = cs; run_gemm<E_MAIN>(lds, xb, DM, (const bf16_t*)(ws + O_WMAIN), NTOK, NHP, DM, e, wv0); }
    PH(18) { const int G_ = ogrid(), b_ = obid(), extra = ((NTOK / 256) * (NHP / 256)) % G_;
      cvt_mixer_b(p, l, lds, wv0, extra ? b_ - extra : b_, extra ? G_ - extra : G_); }
    GSYNC(); LAUNDER();
    PH(3) stats_phase(p, wv0);
    PH(4) swa_phase(p, l, lds, wv0, rep_ + 1 < nrep_);
    GSYNC(); LAUNDER();
    PH(5) { EpiP e{}; e.out = qbuf; e.f0 = st; e.facc = (float*)cs; run_gemm<E_UQ>(lds, hbuf + C_CQ, LDH, (const bf16_t*)(ws + O_WUQ), NTOK, NQ, 512, e, wv0); }
    PH(6) { EpiP e{}; e.out = kvbuf; e.f0 = st; run_gemm<E_UKV>(lds, hbuf + C_CKV, LDH, (const bf16_t*)(ws + O_WUKV), NTOK, NKV, 512, e, wv0); }
    PH(7) sgu_phase(p, l, lds, wv0, rep_ + 1 < nrep_);
    GSYNC(); LAUNDER();
    PH(8) mla_phase(p, lds, wv0);
    GSYNC(); LAUNDER();
    PH(9) { EpiP e{}; e.out = gbuf; e.f0 = p->b_gate + (size_t)l * NG; run_gemm<E_GATE>(lds, xb, DM, (const bf16_t*)(ws + O_WG), NTOK, NG, DM, e, wv0); }
    GSYNC(); LAUNDER();
    PH(10) { EpiP e{}; e.out = mb; e.b0 = gbuf; e.facc = p->out; e.aux = 0; run_gemm<E_PROJ>(lds, hbuf + C_QA, LDH, (const bf16_t*)(ws + O_PA), NTOK, DM, 1024, e, wv0); }
    PH(10) { EpiP e{}; e.out = mb; e.b0 = gbuf; e.facc = p->out; e.aux = 1; run_gemm<E_PROJ>(lds, hbuf + C_CQ, LDH, (const bf16_t*)(ws + O_PB), NTOK, DM, 2048, e, wv0); }
    PH(10) { EpiP e{}; e.out = mb; e.b0 = gbuf; e.facc = p->out; e.aux = 2; run_gemm<E_PROJ>(lds, hbuf + C_HU, LDH, (const bf16_t*)(ws + O_PC), NTOK, DM, 1024, e, wv0); }
    GSYNC(); LAUNDER();
    PH(11) { EpiP e{}; e.out = xa; e.f0 = (l == 0) ? p->x : xa; run_gemm<E_RES>(lds, mb, DM, (const bf16_t*)(ws + O_WO), NTOK, DM, DM, e, wv0); }
    GSYNC(); LAUNDER();
    PH(12) ln_phase(xa, xa, xb, p->ln1_g + l * DM, p->ln1_b + l * DM, wv0);
    PH(13) cvt_ffn(p, l, lds, wv0);
    GSYNC(); LAUNDER();
    PH(14) { EpiP e{}; e.out = ws + O_ACT; e.b0 = (const bf16_t*)(ws + O_SIDE); e.f0 = p->conv_w + (size_t)l * 3 * NUP; e.f1 = p->conv_b + (size_t)l * NUP; e.ex = lds + 131072 + 64;
      run_gemm<E_UPC>(lds, xb, DM, (const bf16_t*)(ws + O_WUP), NTOK, NUP, DM, e, wv0); }
    GSYNC(); LAUNDER();
    PH(15) fixup_phase(p, l, wv0);
    GSYNC(); LAUNDER();
    PH(16) { EpiP e{}; e.out = xa; e.f0 = xa; run_gemm<E_RES>(lds, (const bf16_t*)(ws + O_ACT), DFF, (const bf16_t*)(ws + O_WDN), NTOK, DM, DFF, e, wv0); }
    GSYNC(); LAUNDER();
    PH(17) ln_phase(xa, (l == 1) ? p->out : xa, (l == 1) ? nullptr : xb, p->ln2_g + l * DM, p->ln2_b + l * DM, wv0);
    if (l == 0) { PH(0) cvt_mixer_a(p, 1, lds, wv0); GSYNC(); }
  }
}

extern "C" void kernel_launch(void* const* d_in, const int* in_sizes, int n_in, void* d_out, int out_size, void* d_ws, size_t ws_size, hipStream_t stream) {
  constexpr size_t kDynLds = 131072 + 64 + 16384;
  static int grid_blocks = 0;
  if (!grid_blocks) {
    (void)hipFuncSetAttribute((const void*)mega, hipFuncAttributeMaxDynamicSharedMemorySize, (int)kDynLds);
    int dev = 0, cus = 0, per_cu = 0;
    (void)hipGetDevice(&dev);
    (void)hipDeviceGetAttribute(&cus, hipDeviceAttributeMultiprocessorCount, dev);
    (void)hipOccupancyMaxActiveBlocksPerMultiprocessor(&per_cu, mega, 512, kDynLds);
    if (per_cu > 1) per_cu = 1;
    if (per_cu < 1) per_cu = 1;
    grid_blocks = cus * per_cu;
  }
  if (ws_size < WS_NEED) { fprintf(stderr, "workspace too small: %zu < %zu\n", ws_size, (size_t)WS_NEED); return; }
  Params p{};
  p.x = (const float*)d_in[0]; p.pos = (const int*)d_in[1]; p.w_in = (const float*)d_in[2]; p.b_gate = (const float*)d_in[3]; p.sinks = (const float*)d_in[4];
  p.q_norm_g = (const float*)d_in[5]; p.kv_norm_g = (const float*)d_in[6]; p.w_uq = (const float*)d_in[7]; p.w_ukv = (const float*)d_in[8];
  p.sgu_ln_g = (const float*)d_in[9]; p.sgu_ln_b = (const float*)d_in[10]; p.sgu_w = (const float*)d_in[11]; p.sgu_b = (const float*)d_in[12];
  p.w_proj_a = (const float*)d_in[13]; p.w_proj_b = (const float*)d_in[14]; p.w_proj_c = (const float*)d_in[15]; p.w_o = (const float*)d_in[16];
  p.ln1_g = (const float*)d_in[17]; p.ln1_b = (const float*)d_in[18]; p.w_up = (const float*)d_in[19]; p.conv_w = (const float*)d_in[20]; p.conv_b = (const float*)d_in[21];
  p.w_down = (const float*)d_in[22]; p.ln2_g = (const float*)d_in[23]; p.ln2_b = (const float*)d_in[24];
  p.out = (float*)d_out; p.ws = (unsigned char*)d_ws;
  void* args[] = {&p};
  hipError_t e = hipLaunchCooperativeKernel((void*)mega, dim3(grid_blocks), dim3(512), args, kDynLds, stream);
  if (e != hipSuccess) fprintf(stderr, "cooperative launch failed: %s (grid %d)\n", hipGetErrorString(e), grid_blocks);
}
```

```cpp
#include <hip/hip_runtime.h>
#include <hip/hip_cooperative_groups.h>
#include <cstdio>
namespace cg = cooperative_groups;

#define LAS __attribute__((address_space(3)))
typedef unsigned short bf16_t;
typedef short bf16x8 __attribute__((ext_vector_type(8)));
typedef short v4i16_t __attribute__((ext_vector_type(4)));
typedef float f32x4 __attribute__((ext_vector_type(4)));
typedef float f32x2 __attribute__((ext_vector_type(2)));
typedef float f32x16 __attribute__((ext_vector_type(16)));
typedef unsigned u32x4 __attribute__((ext_vector_type(4)));
typedef unsigned u32x2 __attribute__((ext_vector_type(2)));

constexpr int NTOK = 16384, SEQ = 4096, DM = 2048;
constexpr int LDH = 4416, NHP = 4608;
constexpr int C_QA = 0, C_KA = 1024, C_VA = 1152, C_KR = 1280, C_HU = 1344, C_CQ = 2368, C_CKV = 2880, C_HV = 3392;
constexpr int NG = 6144, NQ = 3072, NKV = 4096, NUP = 11264, DFF = 5632, NIN = 10560;
constexpr float LOG2E = 1.4426950408889634f;
constexpr float ALPHA = 1.4142135623730951f;
constexpr float EPS = 1e-5f;
constexpr float SWA_QSCALE = 0.125f * LOG2E;
constexpr float MLA_QSCALE = 0.07216878364870322f * LOG2E;

__device__ const float INV_FREQ[32] = {1.000000000e+00f, 7.498942018e-01f, 5.623413324e-01f, 4.216965139e-01f, 3.162277639e-01f, 2.371373773e-01f, 1.778279394e-01f, 1.333521456e-01f, 1.000000015e-01f, 7.498942316e-02f, 5.623413250e-02f, 4.216964915e-02f, 3.162277490e-02f, 2.371373773e-02f, 1.778279431e-02f, 1.333521400e-02f, 9.999999776e-03f, 7.498942316e-03f, 5.623413250e-03f, 4.216964822e-03f, 3.162277630e-03f, 2.371373819e-03f, 1.778279431e-03f, 1.333521446e-03f, 1.000000047e-03f, 7.498941850e-04f, 5.623413017e-04f, 4.216965172e-04f, 3.162277571e-04f, 2.371373703e-04f, 1.778279402e-04f, 1.333521504e-04f};

constexpr size_t SZ_W = 76546048;
constexpr size_t O_WMAIN = 0, O_WG = 18874368, O_WUQ = O_WG + 25165824, O_WUKV = O_WUQ + 3145728, O_PA = O_WUKV + 4194304, O_PB = O_PA + 4194304, O_PC = O_PB + 8388608, O_WO = O_PC + 4194304;
constexpr size_t O_WUP = 0, O_WDN = 46137344;
constexpr size_t O_XB = SZ_W;
constexpr size_t O_XA = O_XB + 67108864;
constexpr size_t O_BIG = O_XA + 134217728;
constexpr size_t O_H = O_BIG, O_Q = O_H + 144703488, O_KV = O_Q + 100663296;
constexpr size_t O_ACT = O_BIG, O_SIDE = O_BIG + 184549376;
constexpr size_t O_CS = O_BIG + 379584512;
constexpr size_t O_ST = O_CS + 4194304;
constexpr size_t O_BAR = O_ST + 262144;
constexpr size_t WS_NEED = O_BAR + 16384;

struct Params {
  const float* x; const int* pos; const float* w_in; const float* b_gate; const float* sinks; const float* q_norm_g; const float* kv_norm_g;
  const float* w_uq; const float* w_ukv; const float* sgu_ln_g; const float* sgu_ln_b; const float* sgu_w; const float* sgu_b;
  const float* w_proj_a; const float* w_proj_b; const float* w_proj_c; const float* w_o; const float* ln1_g; const float* ln1_b;
  const float* w_up; const float* conv_w; const float* conv_b; const float* w_down; const float* ln2_g; const float* ln2_b;
  float* out; unsigned char* ws;
};

typedef const Params __attribute__((address_space(4)))* KP;
__device__ __forceinline__ int olane() { unsigned m = ~0u; asm volatile("" : "+s"(m)); return (int)__builtin_amdgcn_mbcnt_hi(m, __builtin_amdgcn_mbcnt_lo(m, 0u)); }
__device__ __forceinline__ int otid(int wv0) { int t = (wv0 << 6) | olane(); asm volatile("" : "+v"(t)); return t; }
__device__ __forceinline__ int obid() { int b = blockIdx.x; asm volatile("" : "+s"(b)); return b; }
__device__ __forceinline__ int ogrid() { int g = gridDim.x; asm volatile("" : "+s"(g)); return g; }
__device__ __forceinline__ unsigned pk2(float lo, float hi) {
  typedef __bf16 b2 __attribute__((ext_vector_type(2)));
  b2 r = __builtin_convertvector((f32x2){lo, hi}, b2);
  return __builtin_bit_cast(unsigned, r);
}
__device__ __forceinline__ float bf_lo(unsigned u) { return __uint_as_float(u << 16); }
__device__ __forceinline__ float bf_hi(unsigned u) { return __uint_as_float(u & 0xffff0000u); }
__device__ __forceinline__ float bf1(bf16_t u) { return __uint_as_float(((unsigned)u) << 16); }
__device__ __forceinline__ float fexp2(float x) { return __builtin_amdgcn_exp2f(x); }
__device__ __forceinline__ float frcp(float x) { return __builtin_amdgcn_rcpf(x); }
__device__ __forceinline__ float wave_sum(float v) {
#pragma unroll
  for (int o = 32; o > 0; o >>= 1) v += __shfl_xor(v, o);
  return v;
}
__device__ __forceinline__ float gelu1(float v) {
  const float av = __builtin_fabsf(v), d = av * 0.2316418882f + 1.0f;
  const float t = frcp(d);
  float q = t * 0.5307027145f + (-0.7265760135f); q = q * t + 0.7107068705f; q = q * t + (-0.142248368f); q = q * t + 0.127414796f; q = q * t;
  const float s = (v * v) * (-0.72134752044f);
  const float e = fexp2(s);
  const float m = v * (q * e), r = v - m;
  return v < 0.f ? m : r;
}
__device__ __forceinline__ f32x16 mfma32(bf16x8 a, bf16x8 b, f32x16 c) { return __builtin_amdgcn_mfma_f32_32x32x16_bf16(a, b, c, 0, 0, 0); }
__device__ __forceinline__ v4i16_t vtr(const LAS unsigned char* p) { return __builtin_amdgcn_ds_read_tr16_b64_v4i16((LAS v4i16_t*)p); }

namespace pg8 {
constexpr int BM = 256, BK = 64, HALF = 128, HTB = HALF * BK * 2, STAGE_BYTES = 8 * HTB, NXCD = 8, WGM = 8;
__device__ __forceinline__ int lds_byte(int r, int c) { const int st = (r >> 4) * 2 + (c >> 5), rr = r & 15, cc = c & 31, ob = rr * 64 + cc * 2; return st * 1024 + (ob ^ (((ob >> 9) & 1) << 5)); }
__device__ __forceinline__ void stage_rc(int b, int& R, int& C) { const int st = b / 1024, sb = b % 1024, swz = sb ^ (((sb >> 9) & 1) << 5); R = (st >> 1) * 16 + swz / 64; C = (st & 1) * 32 + (swz % 64) / 2; }
__device__ __forceinline__ int perm32(int rho) { const int n = rho >> 4, i = rho & 15; return 8 * (i >> 2) + 4 * n + (i & 3); }
struct Unit { int pm, pn; };
struct Gemm { const bf16_t* A; const bf16_t* Bt; int M, N, K, lda; };
struct StaticOrder {
  int nM, nN, nwg, G, c;
  __device__ void init(int M, int N, int G_, int c_) { nM = M / BM; nN = N / BM; nwg = nM * nN; G = G_; c = c_; }
  __device__ bool next(int i, Unit& u) const {
    const long L = (long)i * G + c; if (L >= nwg) return false;
    int wgid = (int)L; { const int q = nwg / NXCD, r = nwg % NXCD, xcd = wgid % NXCD, off = wgid / NXCD; wgid = (xcd < r ? xcd * (q + 1) : r * (q + 1) + (xcd - r) * q) + off; }
    const int nig = WGM * nN, gid = wgid / nig, fm = gid * WGM, gsz = (nM - fm) < WGM ? (nM - fm) : WGM;
    u.pm = fm + ((wgid % nig) % gsz); u.pn = (wgid % nig) / gsz; return true;
  }
};

template <class Epi>
__device__ __forceinline__ void gemm_phase(LAS unsigned char* lds, const Gemm g, const StaticOrder& S, const Epi& E, int wv0) {
  const int tid = otid(wv0), wid = __builtin_amdgcn_readfirstlane(tid >> 6), lane = tid & 63, wr = wid >> 2, wc = wid & 3, fr = lane & 15, fq = lane >> 4;
  const int K = g.K, nt = K / BK, lda = g.lda;
  unsigned voffA[2], voffB[2];
#pragma unroll
  for (int i = 0; i < 2; ++i) { int R, C; stage_rc(tid * 16 + i * 8192, R, C); const int Rb = (R & ~31) + perm32(R & 31);
    voffA[i] = (unsigned)(R * lda + C) * 2u; voffB[i] = (unsigned)(Rb * K + C) * 2u; }
  const size_t kstep = (size_t)(BK * 2);
  const size_t hstepA = (size_t)HALF * lda * 2, hstepB = (size_t)HALF * K * 2;
  const size_t tstepA = 2 * hstepA, tstepB = 2 * hstepB;
  const unsigned ldsw = (unsigned)wid * 1024u;
  const int aoff = lds_byte(wr * 64 + fr, fq * 8), boff = lds_byte(wc * 32 + fr, fq * 8);
#define PG8_SA(b, h) (((b) * 2 + (h)) * HTB)
#define PG8_SB(b, h) ((4 + (b) * 2 + (h)) * HTB)
#define PG8_STAGE(bufoff, gbase, voff) do { _Pragma("unroll") for (int _i = 0; _i < 2; ++_i) \
    __builtin_amdgcn_global_load_lds((const unsigned*)((const char*)(gbase) + (voff)[_i]), (LAS unsigned*)(lds + (bufoff) + ldsw + _i * 8192), 16, 0, 0); } while (0)
#define PG8_LDA(dst, b, h) do { _Pragma("unroll") for (int m = 0; m < 4; ++m) _Pragma("unroll") for (int k = 0; k < 2; ++k) dst[m][k] = *(const LAS bf16x8*)(lds + PG8_SA(b, h) + aoff + m * 2048 + k * 1024); } while (0)
#define PG8_LDB(dst, b, h) do { _Pragma("unroll") for (int n = 0; n < 2; ++n) _Pragma("unroll") for (int k = 0; k < 2; ++k) dst[n][k] = *(const LAS bf16x8*)(lds + PG8_SB(b, h) + boff + n * 2048 + k * 1024); } while (0)
#define PG8_MMA(ai, bj, At, Bt) do { __builtin_amdgcn_s_setprio(1); _Pragma("unroll") for (int m = 0; m < 4; ++m) _Pragma("unroll") for (int n = 0; n < 2; ++n) _Pragma("unroll") for (int k = 0; k < 2; ++k) \
    acc[ai][bj][m][n] = __builtin_amdgcn_mfma_f32_16x16x32_bf16(Bt[n][k], At[m][k], acc[ai][bj][m][n], 0, 0, 0); __builtin_amdgcn_s_setprio(0); } while (0)
#define PG8_WAIT_V(n) asm volatile("s_waitcnt vmcnt(" #n ")" ::: "memory")
#define PG8_WAIT_L(n) asm volatile("s_waitcnt lgkmcnt(" #n ")" ::: "memory")
#define PG8_BAR __builtin_amdgcn_s_barrier()
#define PG8_SCHED __builtin_amdgcn_sched_barrier(0)
  Unit cur, nxt; int ui = 0;
  if (!S.next(0, cur)) return;
  f32x4 acc[2][2][4][2];
#pragma unroll
  for (int a = 0; a < 2; ++a)
#pragma unroll
    for (int b = 0; b < 2; ++b)
#pragma unroll
      for (int m = 0; m < 4; ++m)
#pragma unroll
        for (int n = 0; n < 2; ++n) acc[a][b][m][n] = (f32x4){0.f, 0.f, 0.f, 0.f};
  bf16x8 At[4][2], B0[2][2], B1[2][2];
  const char* cA = (const char*)g.A + (size_t)cur.pm * tstepA; const char* cB = (const char*)g.Bt + (size_t)cur.pn * tstepB;
  PG8_STAGE(PG8_SB(0, 0), cB, voffB); PG8_STAGE(PG8_SA(0, 0), cA, voffA); PG8_STAGE(PG8_SB(0, 1), cB + hstepB, voffB); PG8_STAGE(PG8_SA(0, 1), cA + hstepA, voffA);
  if (wr == 1) PG8_BAR;
  PG8_WAIT_V(4); PG8_BAR;
  PG8_STAGE(PG8_SB(1, 0), cB + kstep, voffB); PG8_STAGE(PG8_SA(1, 0), cA + kstep, voffA); PG8_STAGE(PG8_SB(1, 1), cB + hstepB + kstep, voffB);
  PG8_WAIT_V(6); PG8_BAR;
  for (;;) {
    const bool has_next = S.next(ui + 1, nxt);
    const char* nA = has_next ? (const char*)g.A + (size_t)nxt.pm * tstepA : cA; const char* nB = has_next ? (const char*)g.Bt + (size_t)nxt.pn * tstepB : cB;
    for (int t = 0; t < nt; t += 2) {
      const bool last = (t == nt - 2);
      const char* a1 = cA + (size_t)(t + 1) * kstep;
      const char* a2 = last ? nA : cA + (size_t)(t + 2) * kstep; const char* b2 = last ? nB : cB + (size_t)(t + 2) * kstep;
      const char* a3 = a2 + kstep; const char* b3 = b2 + kstep;
      PG8_LDB(B0, 0, 0); PG8_SCHED; PG8_LDA(At, 0, 0); PG8_STAGE(PG8_SA(1, 1), a1 + hstepA, voffA);
      PG8_WAIT_L(8); PG8_BAR; PG8_WAIT_L(0); PG8_MMA(0, 0, At, B0); PG8_BAR; PG8_SCHED;
      PG8_LDB(B1, 0, 1); PG8_STAGE(PG8_SB(0, 0), b2, voffB);
      PG8_BAR; PG8_WAIT_L(0); PG8_MMA(0, 1, At, B1); PG8_BAR;
      PG8_LDA(At, 0, 1); PG8_STAGE(PG8_SA(0, 0), a2, voffA);
      PG8_BAR; PG8_WAIT_L(0); PG8_MMA(1, 0, At, B0); PG8_BAR; PG8_SCHED;
      PG8_STAGE(PG8_SB(0, 1), b2 + hstepB, voffB);
      PG8_WAIT_V(6); PG8_BAR; PG8_MMA(1, 1, At, B1); PG8_BAR;
      PG8_LDB(B0, 1, 0); PG8_SCHED; PG8_LDA(At, 1, 0); PG8_STAGE(PG8_SA(0, 1), a2 + hstepA, voffA);
      PG8_WAIT_L(8); PG8_BAR; PG8_WAIT_L(0); PG8_MMA(0, 0, At, B0); PG8_BAR; PG8_SCHED;
      PG8_LDB(B1, 1, 1); PG8_STAGE(PG8_SB(1, 0), b3, voffB);
      PG8_BAR; PG8_WAIT_L(0); PG8_MMA(0, 1, At, B1); PG8_BAR;
      PG8_LDA(At, 1, 1); PG8_STAGE(PG8_SA(1, 0), a3, voffA);
      PG8_BAR; PG8_WAIT_L(0); PG8_MMA(1, 0, At, B0); PG8_BAR; PG8_SCHED;
      PG8_STAGE(PG8_SB(1, 1), b3 + hstepB, voffB);
      PG8_WAIT_V(6); PG8_BAR; PG8_MMA(1, 1, At, B1); PG8_BAR;
    }
    E(acc, cur, wr, wc, fr, fq);
    if (!has_next) break;
#pragma unroll
    for (int a = 0; a < 2; ++a)
#pragma unroll
      for (int b = 0; b < 2; ++b)
#pragma unroll
        for (int m = 0; m < 4; ++m)
#pragma unroll
          for (int n = 0; n < 2; ++n) acc[a][b][m][n] = (f32x4){0.f, 0.f, 0.f, 0.f};
    cur = nxt; cA = nA; cB = nB; ++ui;
  }
  PG8_WAIT_V(0);
  if (wr == 0) PG8_BAR;
  PG8_BAR;
#undef PG8_SA
#undef PG8_SB
#undef PG8_STAGE
#undef PG8_LDA
#undef PG8_LDB
#undef PG8_MMA
#undef PG8_WAIT_V
#undef PG8_WAIT_L
#undef PG8_BAR
#undef PG8_SCHED
}
}

struct EpiP { void* out; int ldo; const float* f0; const bf16_t* b0; float* facc; int aux; const float* f1; LAS unsigned char* ex; };
enum { E_MAIN = 0, E_GATE = 1, E_UQ = 2, E_UKV = 3, E_PROJ = 4, E_RES = 5, E_UP = 6, E_UPC = 7 };

__device__ __forceinline__ void rope8(float (&v)[8], const f32x2* cs) {
#pragma unroll
  for (int i = 0; i < 4; ++i) { const f32x2 c = cs[i]; const float x1 = v[2 * i], x2 = v[2 * i + 1]; v[2 * i] = x1 * c.x - x2 * c.y; v[2 * i + 1] = x2 * c.x + x1 * c.y; }
}
__device__ __forceinline__ void store8bf(bf16_t* dst, const float (&v)[8]) {
  u32x4 w; w.x = pk2(v[0], v[1]); w.y = pk2(v[2], v[3]); w.z = pk2(v[4], v[5]); w.w = pk2(v[6], v[7]);
  *(u32x4*)dst = w;
}


__device__ __forceinline__ float dpp_shr1(float x) { return __int_as_float(__builtin_amdgcn_update_dpp(0, __float_as_int(x), 0x111, 0xF, 0xF, true)); }
__device__ __forceinline__ float dpp_shr2(float x) { return __int_as_float(__builtin_amdgcn_update_dpp(0, __float_as_int(x), 0x112, 0xF, 0xF, true)); }
__device__ __forceinline__ float dpp_prev1(float prev, float cur) {
  const int t = __builtin_amdgcn_update_dpp(0, __float_as_int(prev), 0x121, 0xF, 0xF, false);
  return __int_as_float(__builtin_amdgcn_update_dpp(t, __float_as_int(cur), 0x111, 0xF, 0xF, false)); }
__device__ __forceinline__ float dpp_prev2(float prev, float cur) {
  const int t = __builtin_amdgcn_update_dpp(0, __float_as_int(prev), 0x122, 0xF, 0xF, false);
  return __int_as_float(__builtin_amdgcn_update_dpp(t, __float_as_int(cur), 0x112, 0xF, 0xF, false)); }
__device__ __forceinline__ float silu_mul(float g, float v) { return g * frcp(1.0f + fexp2(-g * LOG2E)) * v; }
__device__ __forceinline__ void epi_upc(const EpiP& e, const f32x4 (&acc)[2][2][4][2], const pg8::Unit& u, int wr, int wc, int fr, int fq) {
  LAS unsigned char* ex = e.ex;
  bf16_t* side = (bf16_t*)e.b0;
  const int lc0 = 32 * wc + 8 * fq;
#pragma unroll
  for (int ai = 0; ai < 2; ++ai)
#pragma unroll
    for (int m = 0; m < 4; ++m) {
      const int g = ai * 8 + wr * 4 + m;
#pragma unroll
      for (int bj = 0; bj < 2; ++bj) {
        u32x4 w; w.x = pk2(acc[ai][bj][m][0][0], acc[ai][bj][m][0][1]); w.y = pk2(acc[ai][bj][m][0][2], acc[ai][bj][m][0][3]);
        w.z = pk2(acc[ai][bj][m][1][0], acc[ai][bj][m][1][1]); w.w = pk2(acc[ai][bj][m][1][2], acc[ai][bj][m][1][3]);
        if (m == 3 && fr >= 14) *(LAS u32x4*)(ex + ((g * 2 + (fr - 14)) * 256 + bj * 128 + lc0) * 2) = w;
        const int ucol = bj * DFF + 128 * u.pn + lc0;
        if (g == 15 && fr >= 14) *(u32x4*)(side + ((size_t)u.pm * 4 + 2 + (fr - 14)) * NUP + ucol) = w;
        if (g == 0 && fr < 2) *(u32x4*)(side + ((size_t)u.pm * 4 + fr) * NUP + ucol) = w;
      }
    }
  asm volatile("s_waitcnt lgkmcnt(0)" ::: "memory");
  __builtin_amdgcn_s_barrier();
  __builtin_amdgcn_s_barrier();
  asm volatile("" ::: "memory");
  const float* cw = e.f0; const float* cb = e.f1;
  bf16_t* act = (bf16_t*)e.out;
#pragma unroll
  for (int n = 0; n < 2; ++n) {
    const int ch = 128 * u.pn + lc0 + 4 * n;
    const f32x4 wg0 = *(const f32x4*)(cw + ch), wg1 = *(const f32x4*)(cw + NUP + ch), wg2 = *(const f32x4*)(cw + 2 * NUP + ch), bg = *(const f32x4*)(cb + ch);
    const f32x4 wv0 = *(const f32x4*)(cw + DFF + ch), wv1 = *(const f32x4*)(cw + NUP + DFF + ch), wv2 = *(const f32x4*)(cw + 2 * NUP + DFF + ch), bv = *(const f32x4*)(cb + DFF + ch);
#pragma unroll
    for (int ai = 0; ai < 2; ++ai)
#pragma unroll
      for (int m = 0; m < 4; ++m) {
        const int g = ai * 8 + wr * 4 + m, gp = g > 0 ? g - 1 : 0;
        const f32x4 xg = acc[ai][0][m][n], xv = acc[ai][1][m][n];
        float y[4];
        if (m > 0) {
          const f32x4 pg = acc[ai][0][m - 1][n], pv = acc[ai][1][m - 1][n];
#pragma unroll
          for (int k = 0; k < 4; ++k) {
            const float g1 = dpp_prev1(pg[k], xg[k]), g2 = dpp_prev2(pg[k], xg[k]), v1 = dpp_prev1(pv[k], xv[k]), v2 = dpp_prev2(pv[k], xv[k]);
            const float cg = bg[k] + wg0[k] * g2 + wg1[k] * g1 + wg2[k] * xg[k];
            const float cv = bv[k] + wv0[k] * v2 + wv1[k] * v1 + wv2[k] * xv[k];
            y[k] = silu_mul(cg, cv);
          }
        } else {
          const LAS unsigned char* hp = ex + (gp * 2 * 256 + lc0 + 4 * n) * 2;
          const u32x2 hg14 = *(const LAS u32x2*)hp, hg15 = *(const LAS u32x2*)(hp + 512), hv14 = *(const LAS u32x2*)(hp + 256), hv15 = *(const LAS u32x2*)(hp + 512 + 256);
          const float h14g[4] = {bf_lo(hg14.x), bf_hi(hg14.x), bf_lo(hg14.y), bf_hi(hg14.y)}, h15g[4] = {bf_lo(hg15.x), bf_hi(hg15.x), bf_lo(hg15.y), bf_hi(hg15.y)};
          const float h14v[4] = {bf_lo(hv14.x), bf_hi(hv14.x), bf_lo(hv14.y), bf_hi(hv14.y)}, h15v[4] = {bf_lo(hv15.x), bf_hi(hv15.x), bf_lo(hv15.y), bf_hi(hv15.y)};
#pragma unroll
          for (int k = 0; k < 4; ++k) {
            float g1 = dpp_shr1(xg[k]), g2 = dpp_shr2(xg[k]), v1 = dpp_shr1(xv[k]), v2 = dpp_shr2(xv[k]);
            if (fr == 0) { g1 = h15g[k]; g2 = h14g[k]; v1 = h15v[k]; v2 = h14v[k]; }
            if (fr == 1) { g2 = h15g[k]; v2 = h15v[k]; }
            const float cg = bg[k] + wg0[k] * g2 + wg1[k] * g1 + wg2[k] * xg[k];
            const float cv = bv[k] + wv0[k] * v2 + wv1[k] * v1 + wv2[k] * xv[k];
            y[k] = silu_mul(cg, cv);
          }
        }
        const int row = u.pm * 256 + ai * 128 + wr * 64 + m * 16 + fr;
        if (!(g == 0 && fr < 2)) { u32x2 w; w.x = pk2(y[0], y[1]); w.y = pk2(y[2], y[3]); *(u32x2*)(act + (size_t)row * DFF + ch) = w; }
      }
    asm volatile("" ::: "memory");
  }
}
struct EpiPre { f32x4 a0, a1; u32x4 u0, u1; float s; };
__device__ __forceinline__ void rope8v(float (&v)[8], f32x4 c0, f32x4 c1) {
  const float cs[8] = {c0[0], c0[1], c0[2], c0[3], c1[0], c1[1], c1[2], c1[3]};
#pragma unroll
  for (int i = 0; i < 4; ++i) { const float x1 = v[2 * i], x2 = v[2 * i + 1]; v[2 * i] = x1 * cs[2 * i] - x2 * cs[2 * i + 1]; v[2 * i + 1] = x2 * cs[2 * i] + x1 * cs[2 * i + 1]; }
}
template <int MODE> struct Epi {
  EpiP e;
  __device__ __forceinline__ void preload(EpiPre& q, int row, int col) const {
    if (MODE == E_GATE || MODE == E_UKV) return;
    if (MODE == E_MAIN) {
      if (col >= C_KR && col < C_HU) { const float* cs = e.f0 + ((size_t)row * 32 + ((col - C_KR) >> 1)) * 2; q.a0 = *(const f32x4*)cs; q.a1 = *(const f32x4*)(cs + 4); }
    } else if (MODE == E_GATE) {
      q.a0 = *(const f32x4*)(e.f0 + col); q.a1 = *(const f32x4*)(e.f0 + col + 4);
    } else if (MODE == E_UQ) {
      const int c192 = col % 192;
      if (c192 >= 128) { const float* cs = e.facc + ((size_t)row * 32 + ((c192 - 128) >> 1)) * 2; q.a0 = *(const f32x4*)cs; q.a1 = *(const f32x4*)(cs + 4); }
    } else if (MODE == E_UKV) {
      q.s = ((const f32x4*)e.f0)[row].y;
    } else if (MODE == E_PROJ) {
      q.u0 = *(const u32x4*)(e.b0 + (size_t)row * NG + e.aux * DM + col);
      if (e.aux > 0) q.u1 = *(const u32x4*)((const bf16_t*)e.facc + (size_t)row * DM + col);
    } else if (MODE == E_RES) {
      const float* rs = e.f0 + (size_t)row * DM + col; q.a0 = *(const f32x4*)rs; q.a1 = *(const f32x4*)(rs + 4);
    }
  }
  __device__ __forceinline__ void emit(const EpiPre& q0, int row, int col, f32x4 a, f32x4 b, const f32x4 (&hb)[2][2], const float (&hs)[2][4], int ai_, int m_, int bj_) const {
    EpiPre q = q0;
    if (MODE == E_GATE) { q.a0 = hb[bj_][0]; q.a1 = hb[bj_][1]; }
    if (MODE == E_UQ || MODE == E_UKV) q.s = hs[ai_][m_];
    float v[8] = {a[0], a[1], a[2], a[3], b[0], b[1], b[2], b[3]};
    if (MODE == E_MAIN) {
      if (col >= LDH) return;
      if (col < C_KA) {
#pragma unroll
        for (int j = 0; j < 8; ++j) v[j] *= SWA_QSCALE;
      } else if (col >= C_KR && col < C_HU) {
        rope8v(v, q.a0, q.a1);
      } else if ((col >= C_HU && col < C_CQ) || col >= C_HV) {
#pragma unroll
        for (int j = 0; j < 8; ++j) v[j] = gelu1(v[j]);
      }
      store8bf((bf16_t*)e.out + (size_t)row * LDH + col, v);
    } else if (MODE == E_GATE) {
      const float bb[8] = {q.a0[0], q.a0[1], q.a0[2], q.a0[3], q.a1[0], q.a1[1], q.a1[2], q.a1[3]};
#pragma unroll
      for (int j = 0; j < 8; ++j) v[j] = frcp(1.0f + fexp2(__builtin_fmaf(v[j], -LOG2E, bb[j])));
      store8bf((bf16_t*)e.out + (size_t)row * NG + col, v);
    } else if (MODE == E_UQ) {
#pragma unroll
      for (int j = 0; j < 8; ++j) v[j] *= q.s;
      if (col % 192 >= 128) rope8v(v, q.a0, q.a1);
      store8bf((bf16_t*)e.out + (size_t)row * NQ + col, v);
    } else if (MODE == E_UKV) {
#pragma unroll
      for (int j = 0; j < 8; ++j) v[j] *= q.s;
      store8bf((bf16_t*)e.out + (size_t)row * NKV + col, v);
    } else if (MODE == E_PROJ) {
      const int br = e.aux; const u32x4 gw = q.u0;
      v[0] *= bf_lo(gw.x); v[1] *= bf_hi(gw.x); v[2] *= bf_lo(gw.y); v[3] *= bf_hi(gw.y);
      v[4] *= bf_lo(gw.z); v[5] *= bf_hi(gw.z); v[6] *= bf_lo(gw.w); v[7] *= bf_hi(gw.w);
      bf16_t* fa = (bf16_t*)e.facc + (size_t)row * DM + col;
      if (br > 0) { const u32x4 pw = q.u1;
        v[0] += bf_lo(pw.x); v[1] += bf_hi(pw.x); v[2] += bf_lo(pw.y); v[3] += bf_hi(pw.y); v[4] += bf_lo(pw.z); v[5] += bf_hi(pw.z); v[6] += bf_lo(pw.w); v[7] += bf_hi(pw.w); }
      if (br == 2) store8bf((bf16_t*)e.out + (size_t)row * DM + col, v);
      else store8bf(fa, v);
    } else if (MODE == E_RES) {
      const f32x4 r0 = q.a0, r1 = q.a1;
      float* o = (float*)e.out + (size_t)row * DM + col;
      *(f32x4*)o = (f32x4){ALPHA * r0[0] + v[0], ALPHA * r0[1] + v[1], ALPHA * r0[2] + v[2], ALPHA * r0[3] + v[3]};
      *(f32x4*)(o + 4) = (f32x4){ALPHA * r1[0] + v[4], ALPHA * r1[1] + v[5], ALPHA * r1[2] + v[6], ALPHA * r1[3] + v[7]};
    } else {
      store8bf((bf16_t*)e.out + (size_t)row * e.ldo + col, v);
    }
  }
  __device__ __forceinline__ void operator()(const f32x4 (&acc)[2][2][4][2], const pg8::Unit& u, int wr, int wc, int fr, int fq) const {
    if (MODE == E_UPC) { epi_upc(e, acc, u, wr, wc, fr, fq); return; }
    const int row0 = u.pm * 256 + wr * 64 + fr, col0 = u.pn * 256 + wc * 32 + 8 * fq;
    f32x4 hb[2][2]; float hs[2][4];
#pragma unroll
    for (int bj = 0; bj < 2; ++bj) { hb[bj][0] = (f32x4){0.f, 0.f, 0.f, 0.f}; hb[bj][1] = hb[bj][0];
      if (MODE == E_GATE) { hb[bj][0] = *(const f32x4*)(e.f0 + col0 + bj * 128) * (-LOG2E); hb[bj][1] = *(const f32x4*)(e.f0 + col0 + bj * 128 + 4) * (-LOG2E); } }
#pragma unroll
    for (int ai = 0; ai < 2; ++ai)
#pragma unroll
      for (int m = 0; m < 4; ++m) { hs[ai][m] = 0.f;
        if (MODE == E_UQ) hs[ai][m] = ((const f32x4*)e.f0)[row0 + ai * 128 + m * 16].x * MLA_QSCALE;
        if (MODE == E_UKV) hs[ai][m] = ((const f32x4*)e.f0)[row0 + ai * 128 + m * 16].y; }
    EpiPre q[2][4];
#pragma unroll
    for (int i = 0; i < 4; ++i) preload(q[0][i], row0 + (i >> 1) * 16, col0 + (i & 1) * 128);
#pragma unroll
    for (int gi = 0; gi < 4; ++gi) {
      const int ai = gi >> 1, mp = gi & 1;
      if (gi + 1 < 4) { const int ai2 = (gi + 1) >> 1, mp2 = (gi + 1) & 1;
#pragma unroll
        for (int i = 0; i < 4; ++i) preload(q[(gi + 1) & 1][i], row0 + ai2 * 128 + (2 * mp2 + (i >> 1)) * 16, col0 + (i & 1) * 128); }
      asm volatile("" ::: "memory");
#pragma unroll
      for (int i = 0; i < 4; ++i) { const int m = 2 * mp + (i >> 1), bj = i & 1; emit(q[gi & 1][i], row0 + ai * 128 + m * 16, col0 + bj * 128, acc[ai][bj][m][0], acc[ai][bj][m][1], hb, hs, ai, m, bj); }
      asm volatile("" ::: "memory");
    }
  }
};

template <int MODE>
__device__ __forceinline__ void run_gemm(LAS unsigned char* lds, const bf16_t* A, int lda, const bf16_t* Bt, int M, int N, int K, const EpiP& ep, int wv0) {
  pg8::Gemm g; g.A = A; g.Bt = Bt; g.M = M; g.N = N; g.K = K; g.lda = lda;
  pg8::StaticOrder S; S.init(M, N, ogrid(), obid());
  Epi<MODE> E; E.e = ep;
  pg8::gemm_phase(lds, g, S, E, wv0);
}

__device__ __forceinline__ int rope_src(int j) { return (j & 1) ? 32 + (j >> 1) : (j >> 1); }
__device__ __forceinline__ int srcmap(int kind, int n) {
  if (kind == 0) return n;
  if (kind == 1) {
    if (n < C_KR) return n;
    if (n < C_HU) return 2304 + rope_src(n - C_KR);
    if (n < C_CQ) return n - C_HU + 2368;
    if (n < C_CKV) return n - C_CQ + 1280;
    if (n < C_HV) return n - C_CKV + 1792;
    if (n < LDH) return n;
    return -1;
  }
  if (kind == 2) return 4416 + n;
  if (kind == 4) { const int pn = n >> 8, lc = n & 255; return lc < 128 ? 128 * pn + lc : DFF + 128 * pn + (lc - 128); }
  { const int hd = n / 192, c = n % 192; if (c < 128) return n; return hd * 192 + 128 + rope_src(c - 128); }
}
__device__ __forceinline__ void cvt_job(LAS unsigned char* lds, const float* src, bf16_t* dst, const float* kscale, int K, int Nsrc, int Ndst, int kind, int wv0, int bid_, int grd_) {
  LAS float* tile = (LAS float*)lds;
  const int tid = otid(wv0), nkt = K / 64, ntile = (Ndst / 64) * nkt;
  if (bid_ < 0) return;
  const int nl = tid & 63, kb = tid >> 6;
  float v[8];
#define CVT_LOAD(t_) do { const int k0_ = ((t_) % nkt) * 64, n0_ = ((t_) / nkt) * 64; const int sn = srcmap(kind, n0_ + nl); \
    _Pragma("unroll") for (int i = 0; i < 8; ++i) { const int kl = kb + 8 * i; v[i] = 0.f; \
      if (sn >= 0) { v[i] = src[(size_t)(k0_ + kl) * Nsrc + sn]; if (kscale) v[i] *= kscale[k0_ + kl]; } } } while (0)
  if (bid_ < ntile) CVT_LOAD(bid_);
  for (int t = bid_; t < ntile; t += grd_) {
    const int k0 = (t % nkt) * 64, n0 = (t / nkt) * 64;
#pragma unroll
    for (int i = 0; i < 8; ++i) tile[(kb + 8 * i) * 65 + nl] = v[i];
    __syncthreads();
    if (t + grd_ < ntile) CVT_LOAD(t + grd_);
    { const int nl2 = tid >> 3, kc = (tid & 7) * 8; float w[8];
#pragma unroll
      for (int j = 0; j < 8; ++j) w[j] = tile[(kc + j) * 65 + nl2];
      store8bf(dst + (size_t)(n0 + nl2) * K + k0 + kc, w); }
    __syncthreads();
  }
#undef CVT_LOAD
}
__device__ __forceinline__ void cvt_mixer_a(KP p, int l, LAS unsigned char* lds, int wv0) {
  unsigned char* W = p->ws; const int f = obid(), st = ogrid();
  cvt_job(lds, p->w_in + (size_t)l * DM * NIN, (bf16_t*)(W + O_WMAIN), nullptr, DM, NIN, NHP, 1, wv0, f, st);
  cvt_job(lds, p->w_in + (size_t)l * DM * NIN, (bf16_t*)(W + O_WG), nullptr, DM, NIN, NG, 2, wv0, f, st);
}
__device__ __forceinline__ void cvt_mixer_b(KP p, int l, LAS unsigned char* lds, int wv0, int f, int st) {
  unsigned char* W = p->ws;
  cvt_job(lds, p->w_uq + (size_t)l * 512 * NQ, (bf16_t*)(W + O_WUQ), p->q_norm_g + l * 512, 512, NQ, NQ, 3, wv0, f, st);
  cvt_job(lds, p->w_ukv + (size_t)l * 512 * NKV, (bf16_t*)(W + O_WUKV), p->kv_norm_g + l * 512, 512, NKV, NKV, 0, wv0, f, st);
  cvt_job(lds, p->w_proj_a + (size_t)l * 1024 * DM, (bf16_t*)(W + O_PA), nullptr, 1024, DM, DM, 0, wv0, f, st);
  cvt_job(lds, p->w_proj_b + (size_t)l * 2048 * DM, (bf16_t*)(W + O_PB), nullptr, 2048, DM, DM, 0, wv0, f, st);
  cvt_job(lds, p->w_proj_c + (size_t)l * 1024 * DM, (bf16_t*)(W + O_PC), nullptr, 1024, DM, DM, 0, wv0, f, st);
  cvt_job(lds, p->w_o + (size_t)l * DM * DM, (bf16_t*)(W + O_WO), nullptr, DM, DM, DM, 0, wv0, f, st);
}
__device__ __forceinline__ void cvt_ffn(KP p, int l, LAS unsigned char* lds, int wv0) {
  unsigned char* W = p->ws; const int f = obid(), st = ogrid();
  cvt_job(lds, p->w_up + (size_t)l * DM * NUP, (bf16_t*)(W + O_WUP), nullptr, DM, NUP, NUP, 4, wv0, f, st);
  cvt_job(lds, p->w_down + (size_t)l * DFF * DM, (bf16_t*)(W + O_WDN), nullptr, DFF, DM, DM, 0, wv0, f, st);
}

__device__ __forceinline__ void prologue(KP p, int wv0) {
  const size_t tid = (size_t)obid() * 512 + otid(wv0), nth = (size_t)ogrid() * 512;
  bf16_t* xb = (bf16_t*)(p->ws + O_XB);
  for (size_t i = tid; i < (size_t)NTOK * DM / 4; i += 4 * nth) {
    f32x4 v[4];
#pragma unroll
    for (int j = 0; j < 4; ++j) if (i + j * nth < (size_t)NTOK * DM / 4) v[j] = ((const f32x4*)p->x)[i + j * nth];
#pragma unroll
    for (int j = 0; j < 4; ++j) if (i + j * nth < (size_t)NTOK * DM / 4) { u32x2 w; w.x = pk2(v[j][0], v[j][1]); w.y = pk2(v[j][2], v[j][3]); ((u32x2*)xb)[i + j * nth] = w; } }
  f32x2* cs = (f32x2*)(p->ws + O_CS);
  for (size_t i = tid; i < (size_t)NTOK * 32; i += nth) {
    const int tok = (int)(i >> 5), f = (int)(i & 31);
    const float ang = (float)p->pos[tok] * INV_FREQ[f];
    double t = (double)ang * 0.15915494309189535; t -= __builtin_rint(t);
    const float tf = (float)t;
    cs[i] = (f32x2){__builtin_amdgcn_cosf(tf), __builtin_amdgcn_sinf(tf)};
  }
}

__device__ __forceinline__ void stats_phase(KP p, int wv0) {
  const bf16_t* h = (const bf16_t*)(p->ws + O_H); f32x4* st = (f32x4*)(p->ws + O_ST);
  const int tid_ = otid(wv0); const int lane = tid_ & 63, wv = obid() * 8 + (tid_ >> 6), nwv = ogrid() * 8;
  for (int row0 = wv; row0 < NTOK; row0 += 4 * nwv) {
    u32x4 a[4], b[4], v0[4], v1[4];
#pragma unroll
    for (int k = 0; k < 4; ++k) { const int row = row0 + k * nwv < NTOK ? row0 + k * nwv : row0; const bf16_t* hr = h + (size_t)row * LDH;
      a[k] = *(const u32x4*)(hr + C_CQ + lane * 8); b[k] = *(const u32x4*)(hr + C_CKV + lane * 8);
      v0[k] = *(const u32x4*)(hr + C_HV + lane * 16); v1[k] = *(const u32x4*)(hr + C_HV + lane * 16 + 8); }
    float sa[4], sb[4], sv[4], sq[4], mu[4];
#pragma unroll
    for (int k = 0; k < 4; ++k) { sa[k] = 0.f; sb[k] = 0.f; sv[k] = 0.f;
#pragma unroll
      for (int j = 0; j < 4; ++j) { float x0 = bf_lo(a[k][j]), x1 = bf_hi(a[k][j]); sa[k] += x0 * x0 + x1 * x1; x0 = bf_lo(b[k][j]); x1 = bf_hi(b[k][j]); sb[k] += x0 * x0 + x1 * x1;
        sv[k] += bf_lo(v0[k][j]) + bf_hi(v0[k][j]) + bf_lo(v1[k][j]) + bf_hi(v1[k][j]); } }
#pragma unroll
    for (int o = 32; o > 0; o >>= 1)
#pragma unroll
      for (int k = 0; k < 4; ++k) { sa[k] += __shfl_xor(sa[k], o); sb[k] += __shfl_xor(sb[k], o); sv[k] += __shfl_xor(sv[k], o); }
#pragma unroll
    for (int k = 0; k < 4; ++k) { mu[k] = sv[k] * (1.0f / 1024.0f); sq[k] = 0.f;
#pragma unroll
      for (int j = 0; j < 4; ++j) { float d;
        d = bf_lo(v0[k][j]) - mu[k]; sq[k] += d * d; d = bf_hi(v0[k][j]) - mu[k]; sq[k] += d * d; d = bf_lo(v1[k][j]) - mu[k]; sq[k] += d * d; d = bf_hi(v1[k][j]) - mu[k]; sq[k] += d * d; } }
#pragma unroll
    for (int o = 32; o > 0; o >>= 1)
#pragma unroll
      for (int k = 0; k < 4; ++k) sq[k] += __shfl_xor(sq[k], o);
#pragma unroll
    for (int k = 0; k < 4; ++k) if (lane == 0 && row0 + k * nwv < NTOK)
      st[row0 + k * nwv] = (f32x4){__builtin_amdgcn_rsqf(sa[k] * (1.0f / 512.0f) + EPS), __builtin_amdgcn_rsqf(sb[k] * (1.0f / 512.0f) + EPS), mu[k], __builtin_amdgcn_rsqf(sq[k] * (1.0f / 1024.0f) + EPS)};
  }
}

__device__ __forceinline__ void ln_phase(const float* in, float* outf, bf16_t* outb, const float* g, const float* b, int wv0) {
  const int tid_ = otid(wv0); const int lane = tid_ & 63, wv = obid() * 8 + (tid_ >> 6), nwv = ogrid() * 8;
  f32x4 gg[8], bb[8];
#pragma unroll
  for (int i = 0; i < 8; ++i) { gg[i] = ((const f32x4*)g)[i * 64 + lane]; bb[i] = ((const f32x4*)b)[i * 64 + lane]; }
  f32x4 vn[8];
  if (wv < NTOK) { const f32x4* ir = (const f32x4*)(in + (size_t)wv * DM);
#pragma unroll
    for (int i = 0; i < 8; ++i) vn[i] = ir[i * 64 + lane]; }
  for (int row = wv; row < NTOK; row += nwv) {
    f32x4 v[8]; float s = 0.f;
#pragma unroll
    for (int i = 0; i < 8; ++i) v[i] = vn[i];
    if (row + nwv < NTOK) { const f32x4* ir = (const f32x4*)(in + (size_t)(row + nwv) * DM);
#pragma unroll
      for (int i = 0; i < 8; ++i) vn[i] = ir[i * 64 + lane]; }
#pragma unroll
    for (int i = 0; i < 8; ++i) s += v[i][0] + v[i][1] + v[i][2] + v[i][3];
    s = wave_sum(s); const float mu = s * (1.0f / 2048.0f);
    float sq = 0.f;
#pragma unroll
    for (int i = 0; i < 8; ++i) { v[i] -= mu; sq += v[i][0] * v[i][0] + v[i][1] * v[i][1] + v[i][2] * v[i][2] + v[i][3] * v[i][3]; }
    sq = wave_sum(sq); const float rstd = __builtin_amdgcn_rsqf(sq * (1.0f / 2048.0f) + EPS);
#pragma unroll
    for (int i = 0; i < 8; ++i) {
      const f32x4 y = v[i] * rstd * gg[i] + bb[i];
      ((f32x4*)(outf + (size_t)row * DM))[i * 64 + lane] = y;
      if (outb) { u32x2 w; w.x = pk2(y[0], y[1]); w.y = pk2(y[2], y[3]); ((u32x2*)(outb + (size_t)row * DM))[i * 64 + lane] = w; } }
  }
}

template <int NQK, int NDV, int KSTR, int VSTR>
__device__ __forceinline__ void attn_tile(const bf16x8 (&qf)[NQK], f32x16 (&o)[NDV], float& m, float& l, const LAS unsigned char* Kt, const LAS unsigned char* Vt,
                                          int lane, int qpos, int kpos0, int window, bool domask) {
  const int c = lane & 31, h = lane >> 5;
  f32x16 s0, s1;
#pragma unroll
  for (int r = 0; r < 16; ++r) { s0[r] = 0.f; s1[r] = 0.f; }
  const LAS unsigned char* ka = Kt + c * KSTR + h * 16;
  bf16x8 kc0 = *(const LAS bf16x8*)(ka), kc1 = *(const LAS bf16x8*)(ka + 32 * KSTR);
#pragma unroll
  for (int st = 0; st < NQK; ++st) {
    bf16x8 kn0 = kc0, kn1 = kc1;
    if (st + 1 < NQK) { kn0 = *(const LAS bf16x8*)(ka + (st + 1) * 32); kn1 = *(const LAS bf16x8*)(ka + 32 * KSTR + (st + 1) * 32); }
    s0 = mfma32(kc0, qf[st], s0);
    s1 = mfma32(kc1, qf[st], s1);
    if (st + 1 < NQK) __builtin_amdgcn_sched_group_barrier(0x100, 2, 0);
    __builtin_amdgcn_sched_group_barrier(0x008, 2, 0);
    __builtin_amdgcn_sched_barrier(0);
    kc0 = kn0; kc1 = kn1;
  }
  if (domask) {
#pragma unroll
    for (int r = 0; r < 16; ++r) { const int kp = kpos0 + (r & 3) + 8 * (r >> 2) + 4 * h;
      const bool v0 = (kp <= qpos) && (kp > qpos - window) && (kp >= 0);
      const bool v1 = (kp + 32 <= qpos) && (kp + 32 > qpos - window) && (kp + 32 >= 0);
      s0[r] = v0 ? s0[r] : -1e30f; s1[r] = v1 ? s1[r] : -1e30f; }
  }
  float mx = fmaxf(s0[0], s1[0]);
#pragma unroll
  for (int r = 1; r < 16; ++r) mx = fmaxf(mx, fmaxf(s0[r], s1[r]));
  mx = fmaxf(mx, __shfl_xor(mx, 32));
  if (__builtin_amdgcn_ballot_w64(mx > m + 8.0f) != 0ull) {
    const float mn = fmaxf(m, mx), alpha = fexp2(m - mn);
    m = mn; l *= alpha;
#pragma unroll
    for (int d = 0; d < NDV; ++d) o[d] *= alpha;
  }
  float ps = 0.f;
#pragma unroll
  for (int r = 0; r < 16; ++r) { s0[r] = fexp2(s0[r] - m); s1[r] = fexp2(s1[r] - m); ps += s0[r] + s1[r]; }
  l += ps;
  bf16x8 pf[4];
#pragma unroll
  for (int s = 0; s < 2; ++s) {
    u32x4 w0, w1;
    w0.x = pk2(s0[8 * s + 0], s0[8 * s + 1]); w0.y = pk2(s0[8 * s + 2], s0[8 * s + 3]); w0.z = pk2(s0[8 * s + 4], s0[8 * s + 5]); w0.w = pk2(s0[8 * s + 6], s0[8 * s + 7]);
    w1.x = pk2(s1[8 * s + 0], s1[8 * s + 1]); w1.y = pk2(s1[8 * s + 2], s1[8 * s + 3]); w1.z = pk2(s1[8 * s + 4], s1[8 * s + 5]); w1.w = pk2(s1[8 * s + 6], s1[8 * s + 7]);
    pf[s] = __builtin_bit_cast(bf16x8, w0); pf[2 + s] = __builtin_bit_cast(bf16x8, w1);
  }
  const int i16 = lane & 15, g16 = (lane >> 4) & 1;
  const LAS unsigned char* va = Vt + (4 * h + (i16 >> 2)) * VSTR + (16 * g16 + 4 * (i16 & 3)) * 2;
  bf16x8 vc[NDV];
#pragma unroll
  for (int d = 0; d < NDV; ++d) { const v4i16_t lo = vtr(va + d * 64), hi = vtr(va + 8 * VSTR + d * 64); vc[d] = __builtin_shufflevector(lo, hi, 0, 1, 2, 3, 4, 5, 6, 7); }
#pragma unroll
  for (int ks = 0; ks < 4; ++ks) {
    bf16x8 vn[NDV];
#pragma unroll
    for (int d = 0; d < NDV; ++d) { vn[d] = vc[d];
      if (ks + 1 < 4) { const v4i16_t lo = vtr(va + (16 * (ks + 1)) * VSTR + d * 64), hi = vtr(va + (16 * (ks + 1) + 8) * VSTR + d * 64); vn[d] = __builtin_shufflevector(lo, hi, 0, 1, 2, 3, 4, 5, 6, 7); } }
#pragma unroll
    for (int d = 0; d < NDV; ++d) o[d] = mfma32(vc[d], pf[ks], o[d]);
    if (ks + 1 < 4) __builtin_amdgcn_sched_group_barrier(0x100, 2 * NDV, 0);
    __builtin_amdgcn_sched_group_barrier(0x008, NDV, 0);
    __builtin_amdgcn_sched_barrier(0);
#pragma unroll
    for (int d = 0; d < NDV; ++d) vc[d] = vn[d];
  }
}

__device__ __forceinline__ void mla_phase(KP p, LAS unsigned char* lds, int wv0) {
  constexpr int KSTR = 400, VSTR = 320, KB = 64 * KSTR, VB = 64 * VSTR;
  const bf16_t* q = (const bf16_t*)(p->ws + O_Q); const bf16_t* kv = (const bf16_t*)(p->ws + O_KV);
  bf16_t* h = (bf16_t*)(p->ws + O_H);
  const int tid = otid(wv0), wid = __builtin_amdgcn_readfirstlane(tid >> 6), lane = tid & 63, c = lane & 31, hh = lane >> 5;
  const int G = ogrid(), bid = obid();
  for (int k = 0; k * G < 1024; ++k) {
    const int idx = (k & 1) ? (G - 1 - bid) : bid, rank = k * G + idx;
    if (rank >= 1024) continue;
    const int qb = 15 - rank / 64, bh = rank % 64, b = bh >> 4, hd = bh & 15;
    const int tok0 = b * SEQ, q0 = qb * 256 + 32 * wid;
    bf16x8 qf[12];
    { const bf16_t* qrow = q + (size_t)(tok0 + q0 + c) * NQ + hd * 192 + 8 * hh;
#pragma unroll
      for (int st = 0; st < 12; ++st) qf[st] = *(const bf16x8*)(qrow + 16 * st); }
    f32x16 o[4];
#pragma unroll
    for (int d = 0; d < 4; ++d)
#pragma unroll
      for (int r = 0; r < 16; ++r) o[d][r] = 0.f;
    float m = -1e30f, l = 0.f;
    const int ntiles = qb * 4 + 4;
    unsigned ksrc[3]; int kdst[3];
    const unsigned char* wsb = p->ws;
#pragma unroll
    for (int i = 0; i < 3; ++i) { const int cid = tid + 512 * i, key = cid / 24, ch = cid % 24;
      ksrc[i] = (ch < 16) ? (unsigned)(O_KV + ((size_t)(tok0 + key) * NKV + hd * 256 + ch * 8) * 2) : (unsigned)(O_H + ((size_t)(tok0 + key) * LDH + C_KR + (ch - 16) * 8) * 2);
      kdst[i] = key * KSTR + ch * 16; }
    const unsigned kinc0 = 64u * NKV * 2u, kinc1 = 64u * LDH * 2u;
    const bool k2rope = ((tid + 1024) % 24) >= 16, k1rope = ((tid + 512) % 24) >= 16, k0rope = (tid % 24) >= 16;
    unsigned vsrc[2]; int vdst[2];
#pragma unroll
    for (int i = 0; i < 2; ++i) { const int cid = tid + 512 * i, key = cid >> 4, ch = cid & 15;
      vsrc[i] = (unsigned)(O_KV + ((size_t)(tok0 + key) * NKV + hd * 256 + 128 + ch * 8) * 2); vdst[i] = key * VSTR + ch * 16; }
    u32x4 kr0 = *(const u32x4*)(wsb + ksrc[0]), kr1 = *(const u32x4*)(wsb + ksrc[1]), kr2 = *(const u32x4*)(wsb + ksrc[2]), vr0 = *(const u32x4*)(wsb + vsrc[0]), vr1 = *(const u32x4*)(wsb + vsrc[1]);
    for (int kt = 0; kt < ntiles; ++kt) {
      LAS unsigned char* Kb = lds + (kt & 1) * KB; LAS unsigned char* Vb = lds + 2 * KB + (kt & 1) * VB;
      *(LAS u32x4*)(Kb + kdst[0]) = kr0; *(LAS u32x4*)(Kb + kdst[1]) = kr1; *(LAS u32x4*)(Kb + kdst[2]) = kr2;
      *(LAS u32x4*)(Vb + vdst[0]) = vr0; *(LAS u32x4*)(Vb + vdst[1]) = vr1;
      __syncthreads();
      if (kt + 1 < ntiles) {
        ksrc[0] += k0rope ? kinc1 : kinc0; ksrc[1] += k1rope ? kinc1 : kinc0; ksrc[2] += k2rope ? kinc1 : kinc0; vsrc[0] += kinc0; vsrc[1] += kinc0;
        kr0 = *(const u32x4*)(wsb + ksrc[0]); kr1 = *(const u32x4*)(wsb + ksrc[1]); kr2 = *(const u32x4*)(wsb + ksrc[2]); vr0 = *(const u32x4*)(wsb + vsrc[0]); vr1 = *(const u32x4*)(wsb + vsrc[1]);
      }
      const int k0 = kt * 64;
      if (k0 <= q0 + 31) attn_tile<12, 4, KSTR, VSTR>(qf, o, m, l, Kb, Vb, lane, q0 + c, k0, 1 << 30, k0 + 63 > q0);
    }
    const float inv = frcp(l + __shfl_xor(l, 32));
    bf16_t* yrow = h + (size_t)(tok0 + q0 + c) * LDH + C_CQ + hd * 128 + 4 * hh;
#pragma unroll
    for (int d = 0; d < 4; ++d)
#pragma unroll
      for (int g = 0; g < 4; ++g) { u32x2 w; w.x = pk2(o[d][4 * g] * inv, o[d][4 * g + 1] * inv); w.y = pk2(o[d][4 * g + 2] * inv, o[d][4 * g + 3] * inv);
        *(u32x2*)(yrow + 32 * d + 8 * g) = w; }
    __syncthreads();
  }
}

__device__ __forceinline__ void swa_phase(KP p, int l, LAS unsigned char* lds, int wv0, int dummy = 0) {
  constexpr int STR = 144, VST = 192, TB = 64 * VST;
  bf16_t* h = (bf16_t*)(p->ws + O_H);
  const int tid = otid(wv0), wid = __builtin_amdgcn_readfirstlane(tid >> 6), lane = tid & 63, c = lane & 31, hh = lane >> 5;
  const int bid_ = obid(), grd_ = ogrid();
  for (int it = bid_; it < 512; it += grd_) {
    const int b = it >> 7, r = it & 127, kvh = r >> 6, qblk = r & 63, t0 = qblk * 64, hq = kvh * 8 + wid;
    const size_t tokb = (size_t)b * SEQ;
    bf16x8 qf[2][4];
    bf16_t* qrow0 = h + (tokb + t0 + c) * LDH + C_QA + hq * 64;
#pragma unroll
    for (int sub = 0; sub < 2; ++sub)
#pragma unroll
      for (int st = 0; st < 4; ++st) qf[sub][st] = *(const bf16x8*)(qrow0 + (size_t)sub * 32 * LDH + 16 * st + 8 * hh);
    { const int key = tid >> 3, ch = tid & 7;
#pragma unroll
      for (int j = 0; j < 3; ++j) { int kp = t0 - 128 + 64 * j + key; kp = kp < 0 ? 0 : kp;
        const bf16_t* src = h + (tokb + kp) * LDH + C_KA + kvh * 64 + ch * 8;
        *(LAS u32x4*)(lds + j * 2 * TB + key * STR + ch * 16) = *(const u32x4*)src;
        *(LAS u32x4*)(lds + j * 2 * TB + TB + key * VST + ch * 16) = *(const u32x4*)(src + (C_VA - C_KA)); } }
    __syncthreads();
    const float sink2 = p->sinks[l * 16 + hq] * LOG2E;
#pragma unroll
    for (int sub = 0; sub < 2; ++sub) {
      float m = sink2, ls = 0.f;
      f32x16 o[2];
#pragma unroll
      for (int d = 0; d < 2; ++d)
#pragma unroll
        for (int rr = 0; rr < 16; ++rr) o[d][rr] = 0.f;
      const int qpos = t0 + 32 * sub + c;
#pragma unroll
      for (int j = 0; j < 3; ++j) { const int k0 = t0 - 128 + 64 * j;
        if (k0 + 63 >= 0 && k0 + 63 >= t0 + 32 * sub - 127 && k0 <= t0 + 32 * sub + 31)
          attn_tile<4, 2, STR, VST>(qf[sub], o, m, ls, lds + j * 2 * TB, lds + j * 2 * TB + TB, lane, qpos, k0, 128, true); }
      const float inv = frcp(ls + __shfl_xor(ls, 32) + fexp2(sink2 - m));
      bf16_t* qrow = qrow0 + (size_t)sub * 32 * LDH;
#pragma unroll
      for (int d = 0; d < 2; ++d)
#pragma unroll
        for (int g = 0; g < 4; ++g) { u32x2 w; w.x = pk2(o[d][4 * g] * inv, o[d][4 * g + 1] * inv); w.y = pk2(o[d][4 * g + 2] * inv, o[d][4 * g + 3] * inv);
          bf16_t* dst_ = dummy ? (bf16_t*)(p->ws + O_Q) + (tokb + t0 + 32 * sub + c) * 1024 + hq * 64 : qrow; *(u32x2*)(dst_ + 32 * d + 8 * g + 4 * hh) = w; }
    }
    __syncthreads();
  }
}

__device__ __forceinline__ void sgu_phase(KP p, int l, LAS unsigned char* lds, int wv0, int dummy = 0) {
  constexpr int STR = 272;
  bf16_t* h = (bf16_t*)(p->ws + O_H); const f32x4* st = (const f32x4*)(p->ws + O_ST);
  LAS unsigned char* Wl = lds; LAS unsigned char* Vl = lds + 128 * STR;
  const int tid = otid(wv0), wid = __builtin_amdgcn_readfirstlane(tid >> 6), lane = tid & 63, c = lane & 31, hh = lane >> 5;
  const int bid_ = obid(), grd_ = ogrid();
  int gprev = -1;
  for (int it = bid_; it < 1024; it += grd_) {
    const int cidx = it >> 3, g = it & 7, tb0 = cidx * 128;
    if (g != gprev) {
      gprev = g;
      const float* wg = p->sgu_w + ((size_t)l * 8 + g) * 128 * 128;
#pragma unroll
      for (int i = 0; i < 8; ++i) { const int idx = tid + 512 * i, t = idx >> 5, s4 = (idx & 31) * 4;
        const f32x4 v = *(const f32x4*)(wg + t * 128 + s4);
        u32x2 w; w.x = pk2(s4 <= t ? v[0] : 0.f, s4 + 1 <= t ? v[1] : 0.f); w.y = pk2(s4 + 2 <= t ? v[2] : 0.f, s4 + 3 <= t ? v[3] : 0.f);
        *(LAS u32x2*)(Wl + t * STR + s4 * 2) = w; }
    }
#pragma unroll
    for (int i = 0; i < 4; ++i) { const int cid = tid + 512 * i, s = cid >> 4, ch = cid & 15;
      const u32x4 hv = *(const u32x4*)(h + (size_t)(tb0 + s) * LDH + C_HV + g * 128 + ch * 8);
      const f32x4 sv = st[tb0 + s]; const float mu = sv.z, rstd = sv.w;
      const float* lg = p->sgu_ln_g + l * 1024 + g * 128 + ch * 8; const float* lb = p->sgu_ln_b + l * 1024 + g * 128 + ch * 8;
      const f32x4 g0 = *(const f32x4*)lg, g1 = *(const f32x4*)(lg + 4), b0 = *(const f32x4*)lb, b1 = *(const f32x4*)(lb + 4);
      u32x4 w;
      w.x = pk2((bf_lo(hv.x) - mu) * rstd * g0[0] + b0[0], (bf_hi(hv.x) - mu) * rstd * g0[1] + b0[1]);
      w.y = pk2((bf_lo(hv.y) - mu) * rstd * g0[2] + b0[2], (bf_hi(hv.y) - mu) * rstd * g0[3] + b0[3]);
      w.z = pk2((bf_lo(hv.z) - mu) * rstd * g1[0] + b1[0], (bf_hi(hv.z) - mu) * rstd * g1[1] + b1[1]);
      w.w = pk2((bf_lo(hv.w) - mu) * rstd * g1[2] + b1[2], (bf_hi(hv.w) - mu) * rstd * g1[3] + b1[3]);
      *(LAS u32x4*)(Vl + s * STR + ch * 16) = w; }
    __syncthreads();
    const int tblk = wid >> 1, cb0 = (wid & 1) * 2;
    f32x16 acc[2];
#pragma unroll
    for (int d = 0; d < 2; ++d)
#pragma unroll
      for (int r = 0; r < 16; ++r) acc[d][r] = 0.f;
    const int i16 = lane & 15, g16 = (lane >> 4) & 1;
    const LAS unsigned char* wa = Wl + (32 * tblk + c) * STR + hh * 16;
    const LAS unsigned char* va = Vl + (8 * hh + (i16 >> 2)) * STR + (32 * cb0 + 16 * g16 + 4 * (i16 & 3)) * 2;
#pragma unroll
    for (int s = 0; s < 8; ++s) {
      const bf16x8 a = *(const LAS bf16x8*)(wa + s * 32);
#pragma unroll
      for (int d = 0; d < 2; ++d) {
        const v4i16_t lo = vtr(va + (16 * s) * STR + d * 64);
        const v4i16_t hi = vtr(va + (16 * s + 4) * STR + d * 64);
        const bf16x8 bfr = __builtin_shufflevector(lo, hi, 0, 1, 2, 3, 4, 5, 6, 7);
        acc[d] = mfma32(a, bfr, acc[d]);
      }
    }
    const float* sb = p->sgu_b + ((size_t)l * 8 + g) * 128;
    float uu[2][16], sbv[16];
#pragma unroll
    for (int r = 0; r < 16; ++r) { const int t = 32 * tblk + (r & 3) + 8 * (r >> 2) + 4 * hh; sbv[r] = sb[t];
#pragma unroll
      for (int d = 0; d < 2; ++d) uu[d][r] = bf1(h[(size_t)(tb0 + t) * LDH + C_HU + g * 128 + 32 * (cb0 + d) + c]); }
    asm volatile("" ::: "memory");
#pragma unroll
    for (int d = 0; d < 2; ++d)
#pragma unroll
      for (int r = 0; r < 16; ++r) { const int t = 32 * tblk + (r & 3) + 8 * (r >> 2) + 4 * hh, cc = 32 * (cb0 + d) + c;
        bf16_t* up = h + (size_t)(tb0 + t) * LDH + C_HU + g * 128 + cc;
        const float y = uu[d][r] * (acc[d][r] + sbv[r]);
        bf16_t* dst_ = dummy ? (bf16_t*)p->out + (size_t)(tb0 + t) * 1024 + g * 128 + cc : up; *dst_ = (bf16_t)(pk2(y, 0.f) & 0xffffu); }
    __syncthreads();
  }
}

__device__ __forceinline__ void fixup_phase(KP p, int l, int wv0) {
  const bf16_t* side = (const bf16_t*)(p->ws + O_SIDE); bf16_t* act = (bf16_t*)(p->ws + O_ACT);
  const float* cw = p->conv_w + (size_t)l * 3 * NUP; const float* cb = p->conv_b + (size_t)l * NUP;
  const int ntask = 704 * 128;
  const int id0_ = obid() * 512 + otid(wv0), idst_ = ogrid() * 512;
  for (int id = id0_; id < ntask; id += idst_) {
    const int cgp = id % 704, rk = id / 704, k = rk >> 1, rr = rk & 1, c0 = cgp * 8, t = (k * 256 + rr) & (SEQ - 1);
    const bf16_t* s0p = side + ((size_t)k * 4 + rr) * NUP;
    const bf16_t* s1p = rr ? side + ((size_t)k * 4) * NUP : side + ((size_t)(k > 0 ? k - 1 : 0) * 4 + 3) * NUP;
    const bf16_t* s2p = side + ((size_t)(k > 0 ? k - 1 : 0) * 4 + (rr ? 3 : 2)) * NUP;
    const float m1 = (t >= 1) ? 1.f : 0.f, m2 = (t >= 2) ? 1.f : 0.f;
    float y[8];
#pragma unroll
    for (int hf = 0; hf < 2; ++hf) {
      const int c = c0 + 4 * hf;
      const u32x2 a0 = *(const u32x2*)(s0p + c), a1 = *(const u32x2*)(s1p + c), a2 = *(const u32x2*)(s2p + c);
      const u32x2 d0 = *(const u32x2*)(s0p + DFF + c), d1 = *(const u32x2*)(s1p + DFF + c), d2 = *(const u32x2*)(s2p + DFF + c);
      const f32x4 wg0 = *(const f32x4*)(cw + c), wg1 = *(const f32x4*)(cw + NUP + c), wg2 = *(const f32x4*)(cw + 2 * NUP + c), bg = *(const f32x4*)(cb + c);
      const f32x4 wv0_ = *(const f32x4*)(cw + DFF + c), wv1 = *(const f32x4*)(cw + NUP + DFF + c), wv2 = *(const f32x4*)(cw + 2 * NUP + DFF + c), bv = *(const f32x4*)(cb + DFF + c);
      const float g0[4] = {bf_lo(a0.x), bf_hi(a0.x), bf_lo(a0.y), bf_hi(a0.y)}, g1[4] = {bf_lo(a1.x), bf_hi(a1.x), bf_lo(a1.y), bf_hi(a1.y)}, g2[4] = {bf_lo(a2.x), bf_hi(a2.x), bf_lo(a2.y), bf_hi(a2.y)};
      const float v0[4] = {bf_lo(d0.x), bf_hi(d0.x), bf_lo(d0.y), bf_hi(d0.y)}, v1[4] = {bf_lo(d1.x), bf_hi(d1.x), bf_lo(d1.y), bf_hi(d1.y)}, v2[4] = {bf_lo(d2.x), bf_hi(d2.x), bf_lo(d2.y), bf_hi(d2.y)};
#pragma unroll
      for (int e = 0; e < 4; ++e) {
        const float cgv = bg[e] + wg0[e] * (g2[e] * m2) + wg1[e] * (g1[e] * m1) + wg2[e] * g0[e];
        const float cvv = bv[e] + wv0_[e] * (v2[e] * m2) + wv1[e] * (v1[e] * m1) + wv2[e] * v0[e];
        y[4 * hf + e] = silu_mul(cgv, cvv);
      }
    }
    store8bf(act + (size_t)(k * 256 + rr) * DFF + c0, y);
  }
}

#define XB_TMO      128
#define XB_XCNT(j)  (256  + 64 * (j))
#define XB_XSUB(j)  (1280 + 64 * (j))
#define XB_XGEN(j)  (2304 + 64 * (j))
#define XB_TOP      3328
#define XB_TOPGEN   3392
#define XCD_BAR_WORDS 3456
#define XB_SPIN_CAP (1u << 20)
__device__ __forceinline__ unsigned xb_ld(unsigned* p)              { return __hip_atomic_load(p, __ATOMIC_RELAXED, __HIP_MEMORY_SCOPE_AGENT); }
__device__ __forceinline__ unsigned xb_add(unsigned* p, unsigned v) { return __hip_atomic_fetch_add(p, v, __ATOMIC_RELAXED, __HIP_MEMORY_SCOPE_AGENT); }
__device__ __forceinline__ unsigned xb_xcc_id() { return (unsigned)__builtin_amdgcn_s_getreg((3 << 11) | 20) & 0xFu; }
#define XB_SPIN(cond, bar) do { unsigned _sp = 0; while (cond) { __builtin_amdgcn_s_sleep(1); \
    if ((++_sp & 255u) == 0u) { if (xb_ld(&(bar)[XB_TMO])) break; if (_sp > XB_SPIN_CAP) { atomicAdd(&(bar)[XB_TMO], 1u); break; } } } } while (0)
__device__ __forceinline__ void xcd_barrier_complete(unsigned* bar, unsigned x, unsigned& nloc, unsigned& nx) {
    const unsigned G = gridDim.x * gridDim.y * gridDim.z;
    unsigned sum, cnt, mine, sp = 0u;
    for (;;) {
        sum = 0u; cnt = 0u; mine = 0u;
#pragma unroll
        for (unsigned j = 0; j < 16; ++j) { const unsigned c = xb_ld(&bar[XB_XCNT(j)]); sum += c; cnt += (c > 0u) ? 1u : 0u; mine = (j == x) ? c : mine; }
        if (sum == G) break;
        __builtin_amdgcn_s_sleep(1);
        if ((++sp & 255u) == 0u) { if (xb_ld(&bar[XB_TMO])) break; if (sp > XB_SPIN_CAP) { atomicAdd(&bar[XB_TMO], 1u); break; } }
    }
    nloc = mine > 0u ? mine : 1u; nx = cnt > 0u ? cnt : 1u;
}
__device__ __forceinline__ void xcd_barrier(unsigned* bar, volatile LAS unsigned* st, int wv0) {
    asm volatile("s_waitcnt vmcnt(0)" ::: "memory");
    __syncthreads();
    if (otid(wv0) == 0) {
        const unsigned x = xb_xcc_id();
        __builtin_amdgcn_s_waitcnt(0);
        unsigned nloc = st[0], nx = st[1];
        if (nloc == 0u) { xcd_barrier_complete(bar, x, nloc, nx); st[0] = nloc; st[1] = nx; }
        const unsigned old = xb_add(&bar[XB_XSUB(x)], 1u);
        const unsigned gen = old / nloc;
        if (old + 1u == (gen + 1u) * nloc) {
            __builtin_amdgcn_fence(__ATOMIC_RELEASE, "agent");
            asm volatile("s_waitcnt vmcnt(0)" ::: "memory");
            const unsigned og = xb_add(&bar[XB_TOP], 1u);
            const unsigned tg = og / nx;
            if (og + 1u == (tg + 1u) * nx) xb_add(&bar[XB_TOPGEN], 1u);
            else XB_SPIN(xb_ld(&bar[XB_TOPGEN]) == tg, bar);
            __builtin_amdgcn_fence(__ATOMIC_ACQUIRE, "agent");
            xb_add(&bar[XB_XGEN(x)], 1u);
            asm volatile("s_waitcnt vmcnt(0)" ::: "memory");
        } else {
            XB_SPIN(xb_ld(&bar[XB_XGEN(x)]) == gen, bar);
            __builtin_amdgcn_fence(__ATOMIC_ACQUIRE, "agent");
            asm volatile("s_waitcnt vmcnt(0)" ::: "memory");
        }
    }
    __syncthreads();
}
#define GSYNC() xcd_barrier((unsigned*)(p->ws + O_BAR), (volatile LAS unsigned*)((LAS unsigned char*)shm + 131072), wv0)

#ifndef PH_MASK
#define PH_MASK 0xFFFFF
#endif
#ifndef REP_MASK
#define REP_MASK 0
#endif
#define PH(b) for (int rep_ = 0, nrep_ = (int)(((PH_MASK >> (b)) & 1) + ((REP_MASK >> (b)) & 1)); rep_ < nrep_; ++rep_)
#define LAUNDER() do { asm volatile("" : "+s"(p), "+s"(l), "+s"(wv0) :: "memory"); ws = p->ws; xb = (bf16_t*)(ws + O_XB); xa = (float*)(ws + O_XA); hbuf = (bf16_t*)(ws + O_H); qbuf = (bf16_t*)(ws + O_Q); kvbuf = (bf16_t*)(ws + O_KV); gbuf = qbuf; mb = xb; cs = (const float*)(ws + O_CS); st = (const float*)(ws + O_ST); } while (0)
__global__ void __launch_bounds__(512, 2) mega(Params p_unused) {
  KP p = (KP)__builtin_amdgcn_kernarg_segment_ptr();
  int wv0 = __builtin_amdgcn_readfirstlane((int)threadIdx.x >> 6);
  extern __shared__ __attribute__((aligned(16))) unsigned char shm[];
  LAS unsigned char* lds = (LAS unsigned char*)shm;
  cg::grid_group grid = cg::this_grid();
  unsigned char* ws;
  bf16_t* xb; float* xa; bf16_t* hbuf; bf16_t* qbuf; bf16_t* kvbuf;
  bf16_t* gbuf;
  bf16_t* mb;
  const float* cs; const float* st; int l = 0;
  LAUNDER();

  if (otid(wv0) == 0) { volatile LAS unsigned* bst = (volatile LAS unsigned*)(lds + 131072); bst[0] = 0u; bst[1] = 0u; }
  { unsigned* bar0 = (unsigned*)(p->ws + O_BAR); for (int i = obid() * 512 + otid(wv0); i < XCD_BAR_WORDS; i += ogrid() * 512) bar0[i] = 0u; }
  PH(0) cvt_mixer_a(p, 0, lds, wv0);
  PH(1) prologue(p, wv0);
  grid.sync(); LAUNDER();
  if (otid(wv0) == 0) (void)xb_add((unsigned*)(ws + O_BAR) + XB_XCNT(xb_xcc_id()), 1u);
  for (l = 0; l < 2; ++l) {
    LAUNDER();
    PH(2) { EpiP e{}; e.out = hbuf; e.f0 = cs; run_gemm<E_MAIN>(lds, xb, DM, (const bf16_t*)(ws + O_WMAIN), NTOK, NHP, DM, e, wv0); }
    PH(18) { const int G_ = ogrid(), b_ = obid(), extra = ((NTOK / 256) * (NHP / 256)) % G_;
      cvt_mixer_b(p, l, lds, wv0, extra ? b_ - extra : b_, extra ? G_ - extra : G_); }
    GSYNC(); LAUNDER();
    PH(3) stats_phase(p, wv0);
    PH(4) swa_phase(p, l, lds, wv0, rep_ + 1 < nrep_);
    GSYNC(); LAUNDER();
    PH(5) { EpiP e{}; e.out = qbuf; e.f0 = st; e.facc = (float*)cs; run_gemm<E_UQ>(lds, hbuf + C_CQ, LDH, (const bf16_t*)(ws + O_WUQ), NTOK, NQ, 512, e, wv0); }
    PH(6) { EpiP e{}; e.out = kvbuf; e.f0 = st; run_gemm<E_UKV>(lds, hbuf + C_CKV, LDH, (const bf16_t*)(ws + O_WUKV), NTOK, NKV, 512, e, wv0); }
    PH(7) sgu_phase(p, l, lds, wv0, rep_ + 1 < nrep_);
    GSYNC(); LAUNDER();
    PH(8) mla_phase(p, lds, wv0);
    GSYNC(); LAUNDER();
    PH(9) { EpiP e{}; e.out = gbuf; e.f0 = p->b_gate + (size_t)l * NG; run_gemm<E_GATE>(lds, xb, DM, (const bf16_t*)(ws + O_WG), NTOK, NG, DM, e, wv0); }
    GSYNC(); LAUNDER();
    PH(10) { EpiP e{}; e.out = mb; e.b0 = gbuf; e.facc = p->out; e.aux = 0; run_gemm<E_PROJ>(lds, hbuf + C_QA, LDH, (const bf16_t*)(ws + O_PA), NTOK, DM, 1024, e, wv0); }
    PH(10) { EpiP e{}; e.out = mb; e.b0 = gbuf; e.facc = p->out; e.aux = 1; run_gemm<E_PROJ>(lds, hbuf + C_CQ, LDH, (const bf16_t*)(ws + O_PB), NTOK, DM, 2048, e, wv0); }
    PH(10) { EpiP e{}; e.out = mb; e.b0 = gbuf; e.facc = p->out; e.aux = 2; run_gemm<E_PROJ>(lds, hbuf + C_HU, LDH, (const bf16_t*)(ws + O_PC), NTOK, DM, 1024, e, wv0); }
    GSYNC(); LAUNDER();
    PH(11) { EpiP e{}; e.out = xa; e.f0 = (l == 0) ? p->x : xa; run_gemm<E_RES>(lds, mb, DM, (const bf16_t*)(ws + O_WO), NTOK, DM, DM, e, wv0); }
    GSYNC(); LAUNDER();
    PH(12) ln_phase(xa, xa, xb, p->ln1_g + l * DM, p->ln1_b + l * DM, wv0);
    PH(13) cvt_ffn(p, l, lds, wv0);
    GSYNC(); LAUNDER();
    PH(14) { EpiP e{}; e.out = ws + O_ACT; e.b0 = (const bf16_t*)(ws + O_SIDE); e.f0 = p->conv_w + (size_t)l * 3 * NUP; e.f1 = p->conv_b + (size_t)l * NUP; e.ex = lds + 131072 + 64;
      run_gemm<E_UPC>(lds, xb, DM, (const bf16_t*)(ws + O_WUP), NTOK, NUP, DM, e, wv0); }
    GSYNC(); LAUNDER();
    PH(15) fixup_phase(p, l, wv0);
    GSYNC(); LAUNDER();
    PH(16) { EpiP e{}; e.out = xa; e.f0 = xa; run_gemm<E_RES>(lds, (const bf16_t*)(ws + O_ACT), DFF, (const bf16_t*)(ws + O_WDN), NTOK, DM, DFF, e, wv0); }
    GSYNC(); LAUNDER();
    PH(17) ln_phase(xa, (l == 1) ? p->out : xa, (l == 1) ? nullptr : xb, p->ln2_g + l * DM, p->ln2_b + l * DM, wv0);
    if (l == 0) { PH(0) cvt_mixer_a(p, 1, lds, wv0); GSYNC(); }
  }
}

extern "C" void kernel_launch(void* const* d_in, const int* in_sizes, int n_in, void* d_out, int out_size, void* d_ws, size_t ws_size, hipStream_t stream) {
  constexpr size_t kDynLds = 131072 + 64 + 16384;
  static int grid_blocks = 0;
  if (!grid_blocks) {
    (void)hipFuncSetAttribute((const void*)mega, hipFuncAttributeMaxDynamicSharedMemorySize, (int)kDynLds);
    int dev = 0, cus = 0, per_cu = 0;
    (void)hipGetDevice(&dev);
    (void)hipDeviceGetAttribute(&cus, hipDeviceAttributeMultiprocessorCount, dev);
    (void)hipOccupancyMaxActiveBlocksPerMultiprocessor(&per_cu, mega, 512, kDynLds);
    if (per_cu > 1) per_cu = 1;
    if (per_cu < 1) per_cu = 1;
    grid_blocks = cus * per_cu;
  }
  if (ws_size < WS_NEED) { fprintf(stderr, "workspace too small: %zu < %zu\n", ws_size, (size_t)WS_NEED); return; }
  Params p{};
  p.x = (const float*)d_in[0]; p.pos = (const int*)d_in[1]; p.w_in = (const float*)d_in[2]; p.b_gate = (const float*)d_in[3]; p.sinks = (const float*)d_in[4];
  p.q_norm_g = (const float*)d_in[5]; p.kv_norm_g = (const float*)d_in[6]; p.w_uq = (const float*)d_in[7]; p.w_ukv = (const float*)d_in[8];
  p.sgu_ln_g = (const float*)d_in[9]; p.sgu_ln_b = (const float*)d_in[10]; p.sgu_w = (const float*)d_in[11]; p.sgu_b = (const float*)d_in[12];
  p.w_proj_a = (const float*)d_in[13]; p.w_proj_b = (const float*)d_in[14]; p.w_proj_c = (const float*)d_in[15]; p.w_o = (const float*)d_in[16];
  p.ln1_g = (const float*)d_in[17]; p.ln1_b = (const float*)d_in[18]; p.w_up = (const float*)d_in[19]; p.conv_w = (const float*)d_in[20]; p.conv_b = (const float*)d_in[21];
  p.w_down = (const float*)d_in[22]; p.ln2_g = (const float*)d_in[23]; p.ln2_b = (const float*)d_in[24];
  p.out = (float*)d_out; p.ws = (unsigned char*)d_ws;
  void* args[] = {&p};
  hipError_t e = hipLaunchCooperativeKernel((void*)mega, dim3(grid_blocks), dim3(512), args, kDynLds, stream);
  if (e != hipSuccess) fprintf(stderr, "cooperative launch failed: %s (grid %d)\n", hipGetErrorString(e), grid_blocks);
}
```
